# Optimizing an MI355X kernel written in HIP

```python
import math
import jax
import jax.numpy as jnp
from jax import lax
import numpy as np

D_MODEL = 2048
BATCH = 8
SEQ = 2048
DEPTH = 1

HEAD_DIM = 64
N_HEADS_TOTAL = D_MODEL // HEAD_DIM
MIX_WIDTH = N_HEADS_TOTAL * HEAD_DIM
N_NSA_HEADS = N_HEADS_TOTAL // 2
N_FOX_HEADS = N_HEADS_TOTAL - N_NSA_HEADS
NSA_GQA = 4
N_NSA_KV = N_NSA_HEADS // NSA_GQA
CMP_BLOCK = 32
CMP_STRIDE = 16
CMP_HIDDEN = 2 * HEAD_DIM
SLC_BLOCK = 64
SLC_TOP_N = 16
WINDOW = 512
Q_BLOCK = 128
SLC_Q_BLOCK = 64
REL_BUCKETS = 32
REL_MAX_DIST = 128
N_GROUPS = 4
EXPERTS_PER_GROUP = 8
N_EXPERTS = N_GROUPS * EXPERTS_PER_GROUP
EXPERT_TOP_K = 2
EXPERT_FF = D_MODEL // 4
NORM_EPS = 1e-6
NEG_INF = -1e30
FORCE_BONUS = 1e4

NSA_Q_COLS = N_NSA_HEADS * HEAD_DIM
NSA_KV_COLS = N_NSA_KV * HEAD_DIM
NSA_GATE_COLS = N_NSA_HEADS * 3
FOX_COLS = N_FOX_HEADS * HEAD_DIM
IN_SPLIT_SIZES = (NSA_Q_COLS,) + (NSA_KV_COLS,) * 6 + (NSA_GATE_COLS, FOX_COLS, FOX_COLS, FOX_COLS, N_FOX_HEADS)
IN_COLS = sum(IN_SPLIT_SIZES)

kernel_name = 'hybrid_nsa_fox_hmoe'


def rms_norm(x, w):
    xf = x.astype(jnp.float32)
    y = xf * lax.rsqrt(jnp.mean(xf * xf, axis=-1, keepdims=True) + NORM_EPS)
    return (y * w.astype(jnp.float32)).astype(x.dtype)


def t5_bucket(dist):
    n = jnp.maximum(dist, 0)
    max_exact = REL_BUCKETS // 2
    rel = jnp.log(jnp.maximum(n, 1).astype(jnp.float32) / max_exact) / math.log(REL_MAX_DIST / max_exact)
    large = max_exact + (rel * (REL_BUCKETS - max_exact)).astype(jnp.int32)
    large = jnp.minimum(large, REL_BUCKETS - 1)
    return jnp.where(n < max_exact, n, large)


def masked_softmax(s, mask):
    s = jnp.where(mask, s, NEG_INF)
    m = jnp.max(s, axis=-1, keepdims=True)
    e = jnp.where(mask, jnp.exp(s - m), 0.0)
    return e / jnp.maximum(jnp.sum(e, axis=-1, keepdims=True), 1e-30)


def compress_blocks(kv, pe, w1, w2):
    b, t, g, d = kv.shape
    nc = (t - CMP_BLOCK) // CMP_STRIDE + 1
    idx = jnp.arange(nc)[:, None] * CMP_STRIDE + jnp.arange(CMP_BLOCK)[None, :]
    blocks = kv[:, idx] + pe[None, None, :, None, :]
    blocks = jnp.moveaxis(blocks, 3, 2).reshape(b, nc, g, CMP_BLOCK * d)
    return jax.nn.silu(blocks @ w1) @ w2


def nsa_mixer(q, k_cmp, v_cmp, k_slc, v_slc, k_win, v_win, gate_logits,
              pe_k, pe_v, ck_w1, ck_w2, cv_w1, cv_w2, rel_table):
    b, t, _, d = q.shape
    g, r = N_NSA_KV, NSA_GQA
    scale = d ** -0.5
    qg = q.reshape(b, t, g, r, d)
    t_pos = jnp.arange(t)

    kc = compress_blocks(k_cmp, pe_k, ck_w1, ck_w2)
    vc = compress_blocks(v_cmp, pe_v, cv_w1, cv_w2)
    nc = kc.shape[1]
    c_end = jnp.arange(nc) * CMP_STRIDE + CMP_BLOCK - 1
    dist_c = t_pos[:, None] - c_end[None, :]
    bias_c = rel_table[t5_bucket(dist_c)].reshape(t, nc, g, r).transpose(2, 3, 0, 1)
    s_c = jnp.einsum('btgrd,bcgd->bgrtc', qg, kc, preferred_element_type=jnp.float32) * scale + bias_c
    p_cmp = masked_softmax(s_c, dist_c >= 0)
    o_cmp = jnp.einsum('bgrtc,bcgd->btgrd', p_cmp.astype(vc.dtype), vc)

    ns = t // SLC_BLOCK
    ratio = SLC_BLOCK // CMP_STRIDE
    span = CMP_BLOCK // CMP_STRIDE
    offs = (jnp.arange(ratio)[:, None] - jnp.arange(span)[None, :]).reshape(-1)
    cidx = jnp.arange(ns)[:, None] * ratio + offs[None, :]
    cvalid = (cidx >= 0) & (cidx < nc)
    p_grp = jnp.sum(p_cmp, axis=2)
    imp = jnp.sum(jnp.where(cvalid, jnp.take(p_grp, jnp.clip(cidx, 0, nc - 1), axis=-1), 0.0), axis=-1)
    blk = jnp.arange(ns)
    cur = t_pos // SLC_BLOCK
    forced = (blk[None, :] == 0) | (blk[None, :] == cur[:, None]) | (blk[None, :] == cur[:, None] - 1)
    blk_valid = blk[None, :] * SLC_BLOCK <= t_pos[:, None]
    sel_score = jnp.where(blk_valid, imp + jnp.where(forced, FORCE_BONUS, 0.0), NEG_INF)
    n_sel = min(SLC_TOP_N, ns)
    _, sel = lax.top_k(sel_score, n_sel)
    nk = n_sel * SLC_BLOCK

    k_t = jnp.moveaxis(k_slc, 2, 1)
    v_t = jnp.moveaxis(v_slc, 2, 1)
    b_idx = jnp.arange(b)[:, None, None]
    g_idx = jnp.arange(g)[None, :, None]
    table_g = rel_table.reshape(REL_BUCKETS, g, r).transpose(1, 0, 2)

    def slc_chunk(ci):
        t0 = ci * SLC_Q_BLOCK
        qc = lax.dynamic_slice_in_dim(qg, t0, SLC_Q_BLOCK, axis=1)
        selc = lax.dynamic_slice_in_dim(sel, t0, SLC_Q_BLOCK, axis=2)
        pos = (selc[..., None] * SLC_BLOCK + jnp.arange(SLC_BLOCK)).reshape(b, g, SLC_Q_BLOCK * nk)
        kg = k_t[b_idx, g_idx, pos].reshape(b, g, SLC_Q_BLOCK, nk, d)
        vg = v_t[b_idx, g_idx, pos].reshape(b, g, SLC_Q_BLOCK, nk, d)
        dist = (t0 + jnp.arange(SLC_Q_BLOCK))[:, None] - pos.reshape(b, g, SLC_Q_BLOCK, nk)
        bias = table_g[jnp.arange(g)[None, :, None, None], t5_bucket(dist)]
        s = jnp.einsum('bqgrd,bgqkd->bgrqk', qc, kg, preferred_element_type=jnp.float32) * scale
        s = s + jnp.moveaxis(bias, 4, 2)
        p = masked_softmax(s, (dist >= 0)[:, :, None])
        return jnp.einsum('bgrqk,bgqkd->bqgrd', p.astype(vg.dtype), vg)

    o_slc = lax.map(slc_chunk, jnp.arange(t // SLC_Q_BLOCK))
    o_slc = jnp.moveaxis(o_slc, 0, 1).reshape(b, t, g, r, d)

    kp = jnp.pad(k_win, ((0, 0), (WINDOW, 0), (0, 0), (0, 0)))
    vp = jnp.pad(v_win, ((0, 0), (WINDOW, 0), (0, 0), (0, 0)))
    span_w = WINDOW + Q_BLOCK
    j_loc = jnp.arange(span_w)
    dist_w = jnp.arange(Q_BLOCK)[:, None] + WINDOW - j_loc[None, :]
    band = (dist_w >= 0) & (dist_w < WINDOW)
    bias_w = rel_table[t5_bucket(dist_w)].reshape(Q_BLOCK, span_w, g, r).transpose(2, 3, 0, 1)

    def win_block(bi):
        t0 = bi * Q_BLOCK
        qb = lax.dynamic_slice_in_dim(qg, t0, Q_BLOCK, axis=1)
        kb = lax.dynamic_slice_in_dim(kp, t0, span_w, axis=1)
        vb = lax.dynamic_slice_in_dim(vp, t0, span_w, axis=1)
        mask = band & (t0 - WINDOW + j_loc >= 0)[None, :]
        s = jnp.einsum('bqgrd,bkgd->bgrqk', qb, kb, preferred_element_type=jnp.float32) * scale + bias_w
        p = masked_softmax(s, mask)
        return jnp.einsum('bgrqk,bkgd->bqgrd', p.astype(vb.dtype), vb)

    o_win = lax.map(win_block, jnp.arange(t // Q_BLOCK))
    o_win = jnp.moveaxis(o_win, 0, 1).reshape(b, t, g, r, d)

    gates = jax.nn.sigmoid(gate_logits.astype(jnp.float32)).reshape(b, t, g, r, 3).astype(q.dtype)
    o = gates[..., 0:1] * o_cmp + gates[..., 1:2] * o_slc + gates[..., 2:3] * o_win
    return o.reshape(b, t, g * r * d)


def fox_mixer(q, k, v, f_logit, f_bias):
    b, t, h, d = q.shape
    scale = d ** -0.5
    log_f = jax.nn.log_sigmoid(f_logit.astype(jnp.float32) + f_bias.astype(jnp.float32))
    c = jnp.moveaxis(jnp.cumsum(log_f, axis=1), 1, 2)
    outs = []
    for bi in range(t // Q_BLOCK):
        t0, t1 = bi * Q_BLOCK, (bi + 1) * Q_BLOCK
        s = jnp.einsum('bqhd,bkhd->bhqk', q[:, t0:t1], k[:, :t1], preferred_element_type=jnp.float32) * scale
        s = s + c[:, :, t0:t1, None] - c[:, :, None, :t1]
        mask = jnp.arange(t0, t1)[:, None] >= jnp.arange(t1)[None, :]
        p = masked_softmax(s, mask)
        outs.append(jnp.einsum('bhqk,bkhd->bqhd', p.astype(v.dtype), v[:, :t1]))
    return jnp.concatenate(outs, axis=1).reshape(b, t, h * d)


def hier_moe(xn, wg, bg, we, be, w_gate, w_up, w_down):
    b, t, dm = xn.shape
    xf = xn.reshape(b * t, dm)
    glog = (xf @ wg + bg).astype(jnp.float32)
    pg = jax.nn.softmax(glog, axis=-1)
    gsel = jnp.argmax(glog, axis=-1)
    p_gsel = jnp.take_along_axis(pg, gsel[:, None], axis=-1)
    elog = (xf @ we + be).astype(jnp.float32).reshape(b * t, N_GROUPS, EXPERTS_PER_GROUP)
    elog_g = jnp.take_along_axis(elog, gsel[:, None, None], axis=1)[:, 0]
    top_v, top_i = lax.top_k(elog_g, EXPERT_TOP_K)
    w_top = jax.nn.softmax(top_v, axis=-1) * p_gsel
    eid = gsel[:, None] * EXPERTS_PER_GROUP + top_i
    combine = jnp.sum(jax.nn.one_hot(eid, N_EXPERTS, dtype=jnp.float32) * w_top[..., None], axis=1)
    combine = combine.astype(xf.dtype)
    y = jnp.zeros_like(xf)
    for e in range(N_EXPERTS):
        he = jax.nn.silu(xf @ w_gate[e]) * (xf @ w_up[e])
        y = y + combine[:, e:e + 1] * (he @ w_down[e])
    return y.reshape(b, t, dm)


def setup_inputs(seed: int = 0) -> dict:
    key = jax.random.key(seed)
    ks = jax.random.split(key, 24)

    def nrm(k, shape, scale):
        return jax.random.normal(k, shape, jnp.float32) * scale

    L = DEPTH
    return {
        'x': nrm(ks[0], (BATCH, SEQ, D_MODEL), 1.0),
        'attn_norm_w': 1.0 + nrm(ks[1], (L, D_MODEL), 0.01),
        'w_in': nrm(ks[2], (L, D_MODEL, IN_COLS), D_MODEL ** -0.5),
        'cmp_pe_k': nrm(ks[3], (L, CMP_BLOCK, HEAD_DIM), 0.1),
        'cmp_pe_v': nrm(ks[4], (L, CMP_BLOCK, HEAD_DIM), 0.1),
        'cmp_k_w1': nrm(ks[5], (L, CMP_BLOCK * HEAD_DIM, CMP_HIDDEN), (CMP_BLOCK * HEAD_DIM) ** -0.5),
        'cmp_k_w2': nrm(ks[6], (L, CMP_HIDDEN, HEAD_DIM), CMP_HIDDEN ** -0.5),
        'cmp_v_w1': nrm(ks[7], (L, CMP_BLOCK * HEAD_DIM, CMP_HIDDEN), (CMP_BLOCK * HEAD_DIM) ** -0.5),
        'cmp_v_w2': nrm(ks[8], (L, CMP_HIDDEN, HEAD_DIM), CMP_HIDDEN ** -0.5),
        'rel_bias_table': nrm(ks[9], (REL_BUCKETS, N_NSA_HEADS), 0.5),
        'fox_forget_b': 2.0 + nrm(ks[10], (L, N_FOX_HEADS), 0.5),
        'nsa_out_norm_w': 1.0 + nrm(ks[11], (L, N_NSA_HEADS * HEAD_DIM), 0.01),
        'fox_out_norm_w': 1.0 + nrm(ks[12], (L, N_FOX_HEADS * HEAD_DIM), 0.01),
        'w_out': nrm(ks[13], (L, MIX_WIDTH, D_MODEL), MIX_WIDTH ** -0.5),
        'ffn_norm_w': 1.0 + nrm(ks[14], (L, D_MODEL), 0.01),
        'router_group_w': nrm(ks[15], (L, D_MODEL, N_GROUPS), D_MODEL ** -0.5),
        'router_group_b': nrm(ks[16], (L, N_GROUPS), 0.01),
        'router_expert_w': nrm(ks[17], (L, D_MODEL, N_EXPERTS), D_MODEL ** -0.5),
        'router_expert_b': nrm(ks[18], (L, N_EXPERTS), 0.01),
        'expert_w_gate': nrm(ks[19], (L, N_EXPERTS, D_MODEL, EXPERT_FF), D_MODEL ** -0.5),
        'expert_w_up': nrm(ks[20], (L, N_EXPERTS, D_MODEL, EXPERT_FF), D_MODEL ** -0.5),
        'expert_w_down': nrm(ks[21], (L, N_EXPERTS, EXPERT_FF, D_MODEL), EXPERT_FF ** -0.5),
        'final_norm_w': 1.0 + nrm(ks[22], (D_MODEL,), 0.01),
    }


def reference(x, attn_norm_w, w_in, cmp_pe_k, cmp_pe_v, cmp_k_w1, cmp_k_w2, cmp_v_w1, cmp_v_w2,
              rel_bias_table, fox_forget_b, nsa_out_norm_w, fox_out_norm_w, w_out, ffn_norm_w,
              router_group_w, router_group_b, router_expert_w, router_expert_b,
              expert_w_gate, expert_w_up, expert_w_down, final_norm_w):
    b, t, _ = x.shape
    split_at = [int(v) for v in np.cumsum(IN_SPLIT_SIZES)[:-1]]
    h = x
    for layer in range(DEPTH):
        xn = rms_norm(h, attn_norm_w[layer])
        proj = xn @ w_in[layer]
        (nq, kcmp, vcmp, kslc, vslc, kwin, vwin, ngate, fq, fk, fv, ff) = jnp.split(proj, split_at, axis=-1)
        o_nsa = nsa_mixer(
            nq.reshape(b, t, N_NSA_HEADS, HEAD_DIM),
            kcmp.reshape(b, t, N_NSA_KV, HEAD_DIM), vcmp.reshape(b, t, N_NSA_KV, HEAD_DIM),
            kslc.reshape(b, t, N_NSA_KV, HEAD_DIM), vslc.reshape(b, t, N_NSA_KV, HEAD_DIM),
            kwin.reshape(b, t, N_NSA_KV, HEAD_DIM), vwin.reshape(b, t, N_NSA_KV, HEAD_DIM),
            ngate, cmp_pe_k[layer], cmp_pe_v[layer], cmp_k_w1[layer], cmp_k_w2[layer],
            cmp_v_w1[layer], cmp_v_w2[layer], rel_bias_table)
        o_fox = fox_mixer(
            fq.reshape(b, t, N_FOX_HEADS, HEAD_DIM), fk.reshape(b, t, N_FOX_HEADS, HEAD_DIM),
            fv.reshape(b, t, N_FOX_HEADS, HEAD_DIM), ff, fox_forget_b[layer])
        mixed = jnp.concatenate([rms_norm(o_nsa, nsa_out_norm_w[layer]),
                                 rms_norm(o_fox, fox_out_norm_w[layer])], axis=-1)
        h = h + mixed @ w_out[layer]
        hn = rms_norm(h, ffn_norm_w[layer])
        h = h + hier_moe(hn, router_group_w[layer], router_group_b[layer], router_expert_w[layer],
                         router_expert_b[layer], expert_w_gate[layer], expert_w_up[layer], expert_w_down[layer])
    return rms_norm(h, final_norm_w)
```

```cpp
#include <hip/hip_runtime.h>
#include <cstdio>
#include <cstdint>

constexpr int BATCH = 8, SEQ = 2048, DM = 2048, NTOK = BATCH * SEQ;
constexpr int NPROJ = 5632, NPROJ_PAD = 5888;
constexpr int C_NQ = 0, C_KCMP = 1024, C_VCMP = 1280, C_KSLC = 1536, C_VSLC = 1792, C_KWIN = 2048, C_VWIN = 2304, C_FQ = 2560, C_FK = 3584, C_FV = 4608;
constexpr int NEXP = 32, EFF = 512;
constexpr int MAXROWS = 40960;
constexpr float NORM_EPS = 1e-6f;
constexpr float LOG2E = 1.4426950408889634f;
constexpr float C2 = 0.125f * LOG2E;

constexpr size_t MiB = 1u << 20;
constexpr size_t WS_CTL = 0, CTL_ZERO_BYTES = 1 * MiB;
constexpr size_t WS_WIN_T = 1 * MiB;
constexpr size_t WS_WOUT_T = 24 * MiB;
constexpr size_t WS_WGU_T = 32 * MiB;
constexpr size_t WS_WD_T = 160 * MiB;
constexpr size_t WS_W1T = 224 * MiB;
constexpr size_t WS_KC = 225 * MiB;
constexpr size_t WS_VC = WS_KC + 512 * 1024;
constexpr size_t WS_CUM = 226 * MiB;
constexpr size_t WS_GF = 227 * MiB;
constexpr size_t WS_SSQ = 231 * MiB;
constexpr size_t WS_HSSQ = 233 * MiB;
constexpr size_t WS_SEL = 235 * MiB;
constexpr size_t WS_ROUTE = 236 * MiB;
constexpr size_t WS_SORT = 237 * MiB;
constexpr size_t WS_XN = 244 * MiB;
constexpr size_t WS_PROJ = 308 * MiB;
constexpr size_t WS_HB = 484 * MiB;
constexpr size_t WS_END = 548 * MiB;
namespace pg8 {
#define PG8_LAS __attribute__((address_space(3)))
typedef unsigned short bf16_t;
typedef short bf16x8 __attribute__((ext_vector_type(8)));
typedef float f32x4 __attribute__((ext_vector_type(4)));
typedef unsigned u32x4 __attribute__((ext_vector_type(4)));
constexpr int BM = 256, BK = 64, HALF = 128, HTB = HALF * BK * 2  , STAGE_BYTES = 8 * HTB, NXCD = 8, WGM = 8;

__host__ __device__ __forceinline__ int lds_byte(int r, int c) { const int st = (r >> 4) * 2 + (c >> 5), rr = r & 15, cc = c & 31, ob = rr * 64 + cc * 2; return st * 1024 + (ob ^ (((ob >> 9) & 1) << 5)); }
__host__ __device__ __forceinline__ void stage_rc(int b, int& R, int& C) { const int st = b / 1024, sb = b % 1024, swz = sb ^ (((sb >> 9) & 1) << 5); R = (st >> 1) * 16 + swz / 64; C = (st & 1) * 32 + (swz % 64) / 2; }
__host__ __device__ __forceinline__ int perm32(int rho) { const int n = rho >> 4, i = rho & 15; return 8 * (i >> 2) + 4 * n + (i & 3); }

struct Unit { int pm, pn, bn; };
struct Gemm { const bf16_t* A; const bf16_t* Bt; int M, N, K; };

struct StaticOrder {
    int nM, nN, nwg, G, c;
    __host__ __device__ void init(int M, int N, int G_, int c_) { nM = M / BM; nN = N / BM; nwg = nM * nN; G = G_; c = c_; }
    __host__ __device__ bool next(int i, Unit& u) const {
        const long L = (long)i * G + c; if (L >= nwg) return false;
        int wgid = (int)L; { const int q = nwg / NXCD, r = nwg % NXCD, xcd = wgid % NXCD, off = wgid / NXCD; wgid = (xcd < r ? xcd * (q + 1) : r * (q + 1) + (xcd - r) * q) + off; }
        const int nig = WGM * nN, gid = wgid / nig, fm = gid * WGM, gsz = (nM - fm) < WGM ? (nM - fm) : WGM;
        u.pm = fm + ((wgid % nig) % gsz); u.pn = (wgid % nig) / gsz; u.bn = u.pn; return true;
    }
    __device__ __forceinline__ void a_ready(const Unit&) const {}
    __device__ __forceinline__ void done(const Unit&) const {}
};

__device__ __forceinline__ unsigned cvt_pk_bf16(float lo, float hi) { unsigned r; asm volatile("v_cvt_pk_bf16_f32 %0, %1, %2" : "=v"(r) : "v"(lo), "v"(hi)); return r; }
typedef float f32x2 __attribute__((ext_vector_type(2)));

struct EpiProj {
    static constexpr bool PERM = true, AFTER_DRAIN = false;
    bf16_t* P; float* GF;
    __device__ __forceinline__ void operator()(const f32x4 (&acc)[2][2][4][2], const Unit& u, int wr, int wc, int fr, int fq) const {
        const int row0 = u.pm * BM + wr * 64 + fr;
        if (u.pn < 22) {
            const int col0 = u.pn * BM + wc * 32 + 8 * fq;
#pragma unroll
            for (int ai = 0; ai < 2; ++ai)
#pragma unroll
                for (int m = 0; m < 4; ++m) { bf16_t* rowp = P + (size_t)(row0 + ai * HALF + m * 16) * 5632 + col0;
#pragma unroll
                    for (int bj = 0; bj < 2; ++bj) { const f32x4 v0 = acc[ai][bj][m][0], v1 = acc[ai][bj][m][1];
                        u32x4 w; w.x = cvt_pk_bf16(v0[0], v0[1]); w.y = cvt_pk_bf16(v0[2], v0[3]); w.z = cvt_pk_bf16(v1[0], v1[1]); w.w = cvt_pk_bf16(v1[2], v1[3]);
                        *(u32x4*)(rowp + bj * HALF) = w; } }
        } else {
            const int col0 = wc * 32 + 8 * fq;
            if (col0 < 64) {
#pragma unroll
                for (int ai = 0; ai < 2; ++ai)
#pragma unroll
                    for (int m = 0; m < 4; ++m) { float* rowp = GF + (size_t)(row0 + ai * HALF + m * 16) * 64 + col0;
                        *(f32x4*)(rowp) = acc[ai][0][m][0]; *(f32x4*)(rowp + 4) = acc[ai][0][m][1]; }
            }
        }
    }
};
struct EpiOut {
    static constexpr bool PERM = true, AFTER_DRAIN = false;
    const float* X; bf16_t* HB; float* HSSQ; const float* rowscale;
    __device__ __forceinline__ void operator()(const f32x4 (&acc)[2][2][4][2], const Unit& u, int wr, int wc, int fr, int fq) const {
        const int row0 = u.pm * BM + wr * 64 + fr, col0 = u.pn * BM + wc * 32 + 8 * fq;
#pragma unroll
        for (int ai = 0; ai < 2; ++ai)
#pragma unroll
            for (int m = 0; m < 4; ++m) { const int row = row0 + ai * HALF + m * 16; const float rs = rowscale ? rowscale[row] : 1.f;
                const float* xr = X + (size_t)row * 2048 + col0; bf16_t* hr = HB + (size_t)row * 2048 + col0; float ss = 0.f;
#pragma unroll
                for (int bj = 0; bj < 2; ++bj) { const f32x4 x0 = *(const f32x4*)(xr + bj * HALF), x1 = *(const f32x4*)(xr + bj * HALF + 4);
                    const f32x4 v0 = acc[ai][bj][m][0] * rs + x0, v1 = acc[ai][bj][m][1] * rs + x1;
                    ss += (v0[0] * v0[0] + v0[1] * v0[1]) + (v0[2] * v0[2] + v0[3] * v0[3]) + (v1[0] * v1[0] + v1[1] * v1[1]) + (v1[2] * v1[2] + v1[3] * v1[3]);
                    u32x4 w; w.x = cvt_pk_bf16(v0[0], v0[1]); w.y = cvt_pk_bf16(v0[2], v0[3]); w.z = cvt_pk_bf16(v1[0], v1[1]); w.w = cvt_pk_bf16(v1[2], v1[3]);
                    *(u32x4*)(hr + bj * HALF) = w; }
                ss += __shfl_xor(ss, 16); ss += __shfl_xor(ss, 32);
                if (fq == 0) HSSQ[(size_t)row * 32 + u.pn * 4 + wc] = ss; }
    }
};
struct EpiGateUp {
    static constexpr bool PERM = true, AFTER_DRAIN = false;
    bf16_t* HID; const float* rstd_s;
    __device__ __forceinline__ void operator()(const f32x4 (&acc)[2][2][4][2], const Unit& u, int wr, int wc, int fr, int fq) const {
        const int row0 = u.pm * BM + wr * 64 + fr, col0 = u.pn * 128 + wc * 32 + 8 * fq;
#pragma unroll
        for (int ai = 0; ai < 2; ++ai)
#pragma unroll
            for (int m = 0; m < 4; ++m) { const int row = row0 + ai * HALF + m * 16; const float rs = rstd_s[row];
                float o[8];
#pragma unroll
                for (int n = 0; n < 2; ++n)
#pragma unroll
                    for (int j = 0; j < 4; ++j) { const float g = acc[ai][0][m][n][j] * rs, up = acc[ai][1][m][n][j] * rs;
                        const float sg = __builtin_amdgcn_rcpf(1.f + __builtin_amdgcn_exp2f(-g * 1.4426950408889634f)); o[n * 4 + j] = g * sg * up; }
                u32x4 w; w.x = cvt_pk_bf16(o[0], o[1]); w.y = cvt_pk_bf16(o[2], o[3]); w.z = cvt_pk_bf16(o[4], o[5]); w.w = cvt_pk_bf16(o[6], o[7]);
                *(u32x4*)(HID + (size_t)row * 512 + col0) = w; }
    }
};
struct EpiDown {
    static constexpr bool PERM = true, AFTER_DRAIN = false;
    bf16_t* YS; const int* rdst; const float* rwt;
    __device__ __forceinline__ void operator()(const f32x4 (&acc)[2][2][4][2], const Unit& u, int wr, int wc, int fr, int fq) const {
        const int row0 = u.pm * BM + wr * 64 + fr, col0 = u.pn * BM + wc * 32 + 8 * fq;
#pragma unroll
        for (int ai = 0; ai < 2; ++ai)
#pragma unroll
            for (int m = 0; m < 4; ++m) { const int row = row0 + ai * HALF + m * 16; const int d = rdst[row]; const float wt = rwt[row];
                if (d >= 0) { bf16_t* yr = YS + ((size_t)(d & 1) * 16384 + (size_t)(d >> 1)) * 2048 + col0;
#pragma unroll
                    for (int bj = 0; bj < 2; ++bj) { const f32x4 v0 = acc[ai][bj][m][0] * wt, v1 = acc[ai][bj][m][1] * wt;
                        u32x4 w; w.x = cvt_pk_bf16(v0[0], v0[1]); w.y = cvt_pk_bf16(v0[2], v0[3]); w.z = cvt_pk_bf16(v1[0], v1[1]); w.w = cvt_pk_bf16(v1[2], v1[3]);
                        *(u32x4*)(yr + bj * HALF) = w; } } }
    }
};
struct GroupedOrder {
    int ntiles, nN, G, c; const int* tile_expert;
    __device__ __forceinline__ bool next(int i, Unit& u) const {
        const int L = i * G + c; if (L >= ntiles * nN) return false;
        u.pm = L / nN; u.pn = L % nN; u.bn = tile_expert[u.pm] * nN + u.pn; return true;
    }
    __device__ __forceinline__ void a_ready(const Unit&) const {}
    __device__ __forceinline__ void done(const Unit&) const {}
};
template <class Epi, class Sched, bool ALIGN_EPI = false, bool SP2 = false>
__device__ __forceinline__ void gemm_phase(PG8_LAS unsigned char* lds, const Gemm g, const Sched& S, const Epi& E) {
    const int tid = threadIdx.x, wid = __builtin_amdgcn_readfirstlane(tid >> 6), lane = tid & 63, wr = wid >> 2, wc = wid & 3, fr = lane & 15, fq = lane >> 4;
    const int K = g.K, nt = K / BK;
    unsigned voffA[2], voffB[2];
#pragma unroll
    for (int i = 0; i < 2; ++i) { int R, C; stage_rc(tid * 16 + i * 8192, R, C); const int Rb = Epi::PERM ? ((R & ~31) + perm32(R & 31)) : R;
        voffA[i] = (unsigned)(R * K + C) * 2u; voffB[i] = (unsigned)(Rb * K + C) * 2u; }
    const size_t kstep = (size_t)(BK * 2);
    const size_t hstep = (size_t)HALF * K * 2;
    const size_t tstep = 2 * hstep;
    const unsigned ldsw = (unsigned)wid * 1024u;
    const int aoff = lds_byte(wr * 64 + fr, fq * 8), boff = lds_byte(wc * 32 + fr, fq * 8);
#define PG8_SA(b, h) (((b) * 2 + (h)) * HTB)
#define PG8_SB(b, h) ((4 + (b) * 2 + (h)) * HTB)
#define PG8_STAGE(bufoff, gbase, voff) do { _Pragma("unroll") for (int _i = 0; _i < 2; ++_i) \
        __builtin_amdgcn_global_load_lds((const unsigned*)((const char*)(gbase) + (voff)[_i]), (PG8_LAS unsigned*)(lds + (bufoff) + ldsw + _i * 8192), 16, 0, 0); } while (0)
#define PG8_LDA(dst, b, h) do { _Pragma("unroll") for (int m = 0; m < 4; ++m) _Pragma("unroll") for (int k = 0; k < 2; ++k) dst[m][k] = *(const PG8_LAS bf16x8*)(lds + PG8_SA(b, h) + aoff + m * 2048 + k * 1024); } while (0)
#define PG8_LDB(dst, b, h) do { _Pragma("unroll") for (int n = 0; n < 2; ++n) _Pragma("unroll") for (int k = 0; k < 2; ++k) dst[n][k] = *(const PG8_LAS bf16x8*)(lds + PG8_SB(b, h) + boff + n * 2048 + k * 1024); } while (0)
#define PG8_MMA(ai, bj, At, Bt) do { __builtin_amdgcn_s_setprio(1); _Pragma("unroll") for (int m = 0; m < 4; ++m) _Pragma("unroll") for (int n = 0; n < 2; ++n) _Pragma("unroll") for (int k = 0; k < 2; ++k) \
        acc[ai][bj][m][n] = __builtin_amdgcn_mfma_f32_16x16x32_bf16(Bt[n][k], At[m][k], acc[ai][bj][m][n], 0, 0, 0); __builtin_amdgcn_s_setprio(0); } while (0)
#define PG8_WAIT_V(n) asm volatile("s_waitcnt vmcnt(" #n ")" ::: "memory")
#define PG8_WAIT_L(n) asm volatile("s_waitcnt lgkmcnt(" #n ")" ::: "memory")
#define PG8_BAR __builtin_amdgcn_s_barrier()
#define PG8_SCHED __builtin_amdgcn_sched_barrier(0)
    Unit cur, nxt; int ui = 0;
    if (!S.next(0, cur)) return;
    f32x4 acc[2][2][4][2];
#pragma unroll
    for (int a = 0; a < 2; ++a)
#pragma unroll
        for (int b = 0; b < 2; ++b)
#pragma unroll
            for (int m = 0; m < 4; ++m)
#pragma unroll
                for (int n = 0; n < 2; ++n) acc[a][b][m][n] = (f32x4){0.f, 0.f, 0.f, 0.f};
    bf16x8 At[4][2], B0[2][2], B1[2][2];
    const char* cA = (const char*)g.A + (size_t)cur.pm * tstep; const char* cB = (const char*)g.Bt + (size_t)cur.bn * tstep;
    S.a_ready(cur);
    if constexpr (SP2) {
        PG8_STAGE(PG8_SB(0, 0), cB, voffB); PG8_STAGE(PG8_SB(0, 1), cB + hstep, voffB); PG8_STAGE(PG8_SA(0, 0), cA, voffA); PG8_STAGE(PG8_SA(0, 1), cA + hstep, voffA);
        if (wr == 1) PG8_BAR;
        PG8_WAIT_V(2); PG8_BAR;
        PG8_STAGE(PG8_SB(1, 0), cB + kstep, voffB); PG8_STAGE(PG8_SA(1, 0), cA + kstep, voffA); PG8_STAGE(PG8_SB(1, 1), cB + hstep + kstep, voffB);
        PG8_WAIT_V(6); PG8_BAR;
    } else {
        PG8_STAGE(PG8_SB(0, 0), cB, voffB); PG8_STAGE(PG8_SA(0, 0), cA, voffA); PG8_STAGE(PG8_SB(0, 1), cB + hstep, voffB); PG8_STAGE(PG8_SA(0, 1), cA + hstep, voffA);
        if (wr == 1) PG8_BAR;
        PG8_WAIT_V(4); PG8_BAR;
        PG8_STAGE(PG8_SB(1, 0), cB + kstep, voffB); PG8_STAGE(PG8_SA(1, 0), cA + kstep, voffA); PG8_STAGE(PG8_SB(1, 1), cB + hstep + kstep, voffB);
        PG8_WAIT_V(6); PG8_BAR;
    }
    for (;;) {
        const bool has_next = S.next(ui + 1, nxt);
        const char* nA = has_next ? (const char*)g.A + (size_t)nxt.pm * tstep : cA; const char* nB = has_next ? (const char*)g.Bt + (size_t)nxt.bn * tstep : cB;
        for (int t = 0; t < nt; t += 2) {
            const bool last = (t == nt - 2);
            const char* a1 = cA + (size_t)(t + 1) * kstep;
            const char* a2 = last ? nA : cA + (size_t)(t + 2) * kstep; const char* b2 = last ? nB : cB + (size_t)(t + 2) * kstep;
            const char* a3 = a2 + kstep; const char* b3 = b2 + kstep;
            if (last && has_next) S.a_ready(nxt);
            if constexpr (SP2) {
            PG8_LDB(B0, 0, 0); PG8_LDB(B1, 0, 1); PG8_SCHED; PG8_LDA(At, 0, 0); PG8_STAGE(PG8_SA(1, 1), a1 + hstep, voffA);
            PG8_WAIT_V(8); PG8_WAIT_L(0); PG8_BAR; PG8_MMA(0, 0, At, B0); PG8_MMA(0, 1, At, B1); PG8_BAR; PG8_SCHED;
            PG8_LDA(At, 0, 1); PG8_STAGE(PG8_SB(0, 0), b2, voffB); PG8_STAGE(PG8_SB(0, 1), b2 + hstep, voffB); PG8_STAGE(PG8_SA(0, 0), a2, voffA);
            PG8_WAIT_V(8); PG8_WAIT_L(0); PG8_BAR; PG8_MMA(1, 0, At, B0); PG8_MMA(1, 1, At, B1); PG8_BAR; PG8_SCHED;
            PG8_LDB(B0, 1, 0); PG8_LDB(B1, 1, 1); PG8_SCHED; PG8_LDA(At, 1, 0); PG8_STAGE(PG8_SA(0, 1), a2 + hstep, voffA);
            PG8_WAIT_V(8); PG8_WAIT_L(0); PG8_BAR; PG8_MMA(0, 0, At, B0); PG8_MMA(0, 1, At, B1); PG8_BAR; PG8_SCHED;
            PG8_LDA(At, 1, 1); PG8_STAGE(PG8_SB(1, 0), b3, voffB); PG8_STAGE(PG8_SB(1, 1), b3 + hstep, voffB); PG8_STAGE(PG8_SA(1, 0), a3, voffA);
            PG8_WAIT_V(8); PG8_WAIT_L(0); PG8_BAR; PG8_MMA(1, 0, At, B0); PG8_MMA(1, 1, At, B1); PG8_BAR; PG8_SCHED;
            } else {
            PG8_LDB(B0, 0, 0); PG8_SCHED; PG8_LDA(At, 0, 0); PG8_STAGE(PG8_SA(1, 1), a1 + hstep, voffA);
            PG8_WAIT_L(8); PG8_BAR; PG8_WAIT_L(0); PG8_MMA(0, 0, At, B0); PG8_BAR; PG8_SCHED;
            PG8_LDB(B1, 0, 1); PG8_STAGE(PG8_SB(0, 0), b2, voffB);
            PG8_BAR; PG8_WAIT_L(0); PG8_MMA(0, 1, At, B1); PG8_BAR;
            PG8_LDA(At, 0, 1); PG8_STAGE(PG8_SA(0, 0), a2, voffA);
            PG8_BAR; PG8_WAIT_L(0); PG8_MMA(1, 0, At, B0); PG8_BAR; PG8_SCHED;
            PG8_STAGE(PG8_SB(0, 1), b2 + hstep, voffB);
            PG8_WAIT_V(6); PG8_BAR; PG8_MMA(1, 1, At, B1); PG8_BAR;
            PG8_LDB(B0, 1, 0); PG8_SCHED; PG8_LDA(At, 1, 0); PG8_STAGE(PG8_SA(0, 1), a2 + hstep, voffA);
            PG8_WAIT_L(8); PG8_BAR; PG8_WAIT_L(0); PG8_MMA(0, 0, At, B0); PG8_BAR; PG8_SCHED;
            PG8_LDB(B1, 1, 1); PG8_STAGE(PG8_SB(1, 0), b3, voffB);
            PG8_BAR; PG8_WAIT_L(0); PG8_MMA(0, 1, At, B1); PG8_BAR;
            PG8_LDA(At, 1, 1); PG8_STAGE(PG8_SA(1, 0), a3, voffA);
            PG8_BAR; PG8_WAIT_L(0); PG8_MMA(1, 0, At, B0); PG8_BAR; PG8_SCHED;
            PG8_STAGE(PG8_SB(1, 1), b3 + hstep, voffB);
            PG8_WAIT_V(6); PG8_BAR; PG8_MMA(1, 1, At, B1); PG8_BAR;
            }
        }
        if constexpr (ALIGN_EPI) { if (wr == 0) PG8_BAR; }
        if constexpr (!Epi::AFTER_DRAIN) { E(acc, cur, wr, wc, fr, fq); S.done(cur); }
        if (!has_next) break;
#pragma unroll
        for (int a = 0; a < 2; ++a)
#pragma unroll
            for (int b = 0; b < 2; ++b)
#pragma unroll
                for (int m = 0; m < 4; ++m)
#pragma unroll
                    for (int n = 0; n < 2; ++n) acc[a][b][m][n] = (f32x4){0.f, 0.f, 0.f, 0.f};
        cur = nxt; cA = nA; cB = nB; ++ui;
        if constexpr (ALIGN_EPI) { if (wr == 1) PG8_BAR; }
    }
    PG8_WAIT_V(0);
    if constexpr (!ALIGN_EPI) { if (wr == 0) PG8_BAR; }
    PG8_BAR;
    if constexpr (Epi::AFTER_DRAIN) { E.fused(acc, cur, wr, wc, fr, fq, lds, wid, lane); S.done(cur); }
#undef PG8_SA
#undef PG8_SB
#undef PG8_STAGE
#undef PG8_LDA
#undef PG8_LDB
#undef PG8_MMA
#undef PG8_WAIT_V
#undef PG8_WAIT_L
#undef PG8_BAR
#undef PG8_SCHED
}
}

#define GAS __attribute__((address_space(1)))
#define LAS __attribute__((address_space(3)))
typedef unsigned short bf16;
typedef unsigned v4u __attribute__((ext_vector_type(4)));
typedef float f32x4 __attribute__((ext_vector_type(4)));
typedef short bf16x8 __attribute__((ext_vector_type(8)));
typedef GAS unsigned gu32;
#define RLX_AGENT __ATOMIC_RELAXED, __HIP_MEMORY_SCOPE_AGENT
#define LDS_WAIT() asm volatile("s_waitcnt lgkmcnt(0)" ::: "memory")
#define VM_WAIT() asm volatile("s_waitcnt vmcnt(0)" ::: "memory")
__device__ __forceinline__ unsigned f2bf(float f) { unsigned u = __builtin_bit_cast(unsigned, f); return (u + 0x7fffu + ((u >> 16) & 1u)) >> 16; }
__device__ __forceinline__ unsigned pk2(float lo, float hi) { return f2bf(lo) | (f2bf(hi) << 16); }
__device__ __forceinline__ float bf2f(unsigned short b) { return __builtin_bit_cast(float, (unsigned)b << 16); }
__device__ __forceinline__ float bflo(unsigned w) { return __builtin_bit_cast(float, w << 16); }
__device__ __forceinline__ float bfhi(unsigned w) { return __builtin_bit_cast(float, w & 0xffff0000u); }
__device__ __forceinline__ int ld_i32(const int* p) { return __hip_atomic_load(p, __ATOMIC_RELAXED, __HIP_MEMORY_SCOPE_AGENT); }
__device__ __forceinline__ float wave_sum(float v) {
#pragma unroll
    for (int o = 1; o < 64; o <<= 1) v += __shfl_xor(v, o);
    return v;
}
__device__ __forceinline__ float wave_max(float v) {
#pragma unroll
    for (int o = 1; o < 64; o <<= 1) v = fmaxf(v, __shfl_xor(v, o));
    return v;
}
__device__ const unsigned char T5B[128] = {0,1,2,3,4,5,6,7,8,9,10,11,12,13,14,15,16,16,16,17,17,18,18,18,19,19,19,20,20,20,20,21,21,21,21,22,22,22,22,22,23,23,23,23,23,23,24,24,24,24,24,24,25,25,25,25,25,25,25,26,26,26,26,26,26,26,26,27,27,27,27,27,27,27,27,27,27,28,28,28,28,28,28,28,28,28,28,29,29,29,29,29,29,29,29,29,29,29,29,30,30,30,30,30,30,30,30,30,30,30,30,30,30,31,31,31,31,31,31,31,31,31,31,31,31,31,31,31};
__device__ __forceinline__ int t5_bucket(int dist) { return dist >= 128 ? 31 : (int)T5B[dist < 0 ? 0 : dist]; }
#define XB_TMO      128
#define XB_XCNT(j)  (256  + 64 * (j))
#define XB_XSUB(j)  (1280 + 64 * (j))
#define XB_XGEN(j)  (2304 + 64 * (j))
#define XB_TOP      3328
#define XB_TOPGEN   3392
#define XCD_BAR_WORDS 3456
#define XB_SPIN_CAP (1u << 18)

__device__ __forceinline__ unsigned xb_ld(unsigned* p)              { return __hip_atomic_load(p, __ATOMIC_RELAXED, __HIP_MEMORY_SCOPE_AGENT); }
__device__ __forceinline__ unsigned xb_add(unsigned* p, unsigned v) { return __hip_atomic_fetch_add(p, v, __ATOMIC_RELAXED, __HIP_MEMORY_SCOPE_AGENT); }
__device__ __forceinline__ unsigned xb_xcc_id() { return (unsigned)__builtin_amdgcn_s_getreg((3 << 11) | 20) & 0xFu; }
#define XB_SPIN(cond, bar) do { unsigned _sp = 0; while (cond) { __builtin_amdgcn_s_sleep(1); \
    if ((++_sp & 255u) == 0u) { if (xb_ld(&(bar)[XB_TMO])) break; if (_sp > XB_SPIN_CAP) { atomicAdd(&(bar)[XB_TMO], 1u); break; } } } } while (0)

struct XcdBarrier {
    unsigned* bar; unsigned x;
    volatile LAS unsigned* st;
};

__device__ __forceinline__ XcdBarrier xcd_barrier_post(unsigned* bar, volatile LAS unsigned* st) {
    XcdBarrier b; b.bar = bar; b.x = xb_xcc_id(); b.st = st;
    if (threadIdx.x == 0) (void)xb_add(&bar[XB_XCNT(b.x)], 1u);
    return b;
}
__device__ __forceinline__ void xcd_barrier_complete(unsigned* bar, unsigned x, unsigned& nloc, unsigned& nx) {
    const unsigned G = gridDim.x * gridDim.y * gridDim.z;
    unsigned sum, cnt, mine, sp = 0u;
    for (;;) {
        sum = 0u; cnt = 0u; mine = 0u;
#pragma unroll
        for (unsigned j = 0; j < 16; ++j) { const unsigned c = xb_ld(&bar[XB_XCNT(j)]); sum += c; cnt += (c > 0u) ? 1u : 0u; mine = (j == x) ? c : mine; }
        if (sum == G) break;
        __builtin_amdgcn_s_sleep(1);
        if ((++sp & 255u) == 0u) { if (xb_ld(&bar[XB_TMO])) break; if (sp > XB_SPIN_CAP) { atomicAdd(&bar[XB_TMO], 1u); break; } }
    }
    nloc = mine > 0u ? mine : 1u; nx = cnt > 0u ? cnt : 1u;
}

__device__ __forceinline__ void xcd_barrier(const XcdBarrier& b) {
    asm volatile("s_waitcnt vmcnt(0)" ::: "memory");
    __syncthreads();
    if (threadIdx.x == 0) {
        unsigned* bar = b.bar;
        __builtin_amdgcn_s_waitcnt(0);
        unsigned nloc = b.st[0], nx = b.st[1];
        if (nloc == 0u) { xcd_barrier_complete(bar, b.x, nloc, nx); b.st[0] = nloc; b.st[1] = nx; }
        const unsigned old = xb_add(&bar[XB_XSUB(b.x)], 1u);
        const unsigned gen = old / nloc;
        if (old + 1u == (gen + 1u) * nloc) {
            __builtin_amdgcn_fence(__ATOMIC_RELEASE, "agent");
            asm volatile("s_waitcnt vmcnt(0)" ::: "memory");
            const unsigned og = xb_add(&bar[XB_TOP], 1u);
            const unsigned tg = og / nx;
            if (og + 1u == (tg + 1u) * nx) xb_add(&bar[XB_TOPGEN], 1u);
            else XB_SPIN(xb_ld(&bar[XB_TOPGEN]) == tg, bar);
            __builtin_amdgcn_fence(__ATOMIC_ACQUIRE, "agent");
            xb_add(&bar[XB_XGEN(b.x)], 1u);
            asm volatile("s_waitcnt vmcnt(0)" ::: "memory");
        } else {
            XB_SPIN(xb_ld(&bar[XB_XGEN(b.x)]) == gen, bar);
            __builtin_amdgcn_fence(__ATOMIC_ACQUIRE, "agent");
            asm volatile("s_waitcnt vmcnt(0)" ::: "memory");
        }
    }
    __syncthreads();
}

__global__ void __launch_bounds__(128) k_compress(const bf16* PROJ, const float* pe_k, const float* pe_v, const float* w1k, const float* w2k, const float* w1v, const float* w2v, bf16* KC, bf16* VC) {
    __shared__ float xin[2048]; __shared__ float hid[128];
    const int blk = blockIdx.x, kv = blk & 1, g = (blk >> 1) & 3, bc = blk >> 3, c = bc & 127, b = bc >> 7, tid = threadIdx.x;
    bf16* dst = (kv ? VC : KC) + ((size_t)(b * 128 + c) * 4 + g) * 64;
    if (c == 127) { if (tid < 64) dst[tid] = 0; return; }
    const float* pe = kv ? pe_v : pe_k; const float* w1 = kv ? w1v : w1k; const float* w2 = kv ? w2v : w2k;
    const int colbase = (kv ? C_VCMP : C_KCMP) + g * 64;
    for (int i = tid; i < 2048; i += 128) { const int l = i >> 6, d = i & 63; xin[i] = bf2f(PROJ[(size_t)(b * 2048 + 16 * c + l) * NPROJ + colbase + d]) + pe[i]; }
    __syncthreads();
    float s = 0.f;
    for (int i = 0; i < 2048; ++i) s += xin[i] * w1[(size_t)i * 128 + tid];
    hid[tid] = s / (1.f + expf(-s));
    __syncthreads();
    if (tid < 64) { float o = 0.f; for (int j = 0; j < 128; ++j) o += hid[j] * w2[j * 64 + tid]; dst[tid] = (bf16)f2bf(o); }
}
__device__ __forceinline__ float log_sigmoid(float x) { return fminf(x, 0.f) - log1pf(expf(-fabsf(x))); }
__global__ void __launch_bounds__(64) k_cumsum(const float* GF, const float* fb, float* CUM) {
    const int bh = blockIdx.x, b = bh >> 4, h = bh & 15, lane = threadIdx.x; const float bias = fb[h];
    float s = 0.f;
    for (int i = 0; i < 32; ++i) { const int t = lane * 32 + i; s += log_sigmoid(GF[(size_t)(b * 2048 + t) * 64 + 48 + h] + bias); }
    float incl = s;
    for (int o = 1; o < 64; o <<= 1) { const float v = __shfl_up(incl, o); if (lane >= o) incl += v; }
    float run = incl - s;
    for (int i = 0; i < 32; ++i) { const int t = lane * 32 + i; run += log_sigmoid(GF[(size_t)(b * 2048 + t) * 64 + 48 + h] + bias); CUM[(size_t)bh * 2048 + t] = run * LOG2E; }
}
__global__ void __launch_bounds__(64) k_cmp_sel(const bf16* PROJ, const bf16* KC, const bf16* VC, const float* rel, float* OC, unsigned* SEL) {
    __shared__ float qs[4][64]; __shared__ float ps[4][128]; __shared__ float pg[132]; __shared__ float sc[32];
    const int id = blockIdx.x, g = id & 3, bt = id >> 2, t = bt & 2047, b = bt >> 11, lane = threadIdx.x; const size_t tok = (size_t)b * 2048 + t;
#pragma unroll
    for (int r = 0; r < 4; ++r) qs[r][lane] = bf2f(PROJ[tok * NPROJ + C_NQ + (g * 4 + r) * 64 + lane]);
    __syncthreads();
    const int nvalid = t >= 31 ? min(127, (t - 31) / 16 + 1) : 0;
    float s0[4], s1[4];
#pragma unroll
    for (int half = 0; half < 2; ++half) { const int c = lane + 64 * half; const bf16* kr = KC + ((size_t)(b * 128 + c) * 4 + g) * 64;
        float d0 = 0.f, d1 = 0.f, d2 = 0.f, d3 = 0.f;
        for (int d = 0; d < 64; ++d) { const float kk = bf2f(kr[d]); d0 += qs[0][d] * kk; d1 += qs[1][d] * kk; d2 += qs[2][d] * kk; d3 += qs[3][d] * kk; }
        const bool ok = c < nvalid; const int bk = t5_bucket(t - (16 * c + 31)); const float* rb = rel + bk * 16 + g * 4;
        const float v0 = ok ? d0 + rb[0] * LOG2E : -INFINITY, v1 = ok ? d1 + rb[1] * LOG2E : -INFINITY, v2 = ok ? d2 + rb[2] * LOG2E : -INFINITY, v3 = ok ? d3 + rb[3] * LOG2E : -INFINITY;
        if (half == 0) { s0[0] = v0; s0[1] = v1; s0[2] = v2; s0[3] = v3; } else { s1[0] = v0; s1[1] = v1; s1[2] = v2; s1[3] = v3; } }
    float pgl0 = 0.f, pgl1 = 0.f;
#pragma unroll
    for (int r = 0; r < 4; ++r) { const float m = wave_max(fmaxf(s0[r], s1[r]));
        const float e0 = (lane < nvalid) ? exp2f(s0[r] - m) : 0.f, e1 = (lane + 64 < nvalid) ? exp2f(s1[r] - m) : 0.f;
        const float sum = wave_sum(e0 + e1), inv = 1.f / fmaxf(sum, 1e-30f); const float p0 = e0 * inv, p1 = e1 * inv;
        ps[r][lane] = p0; ps[r][lane + 64] = p1; pgl0 += p0; pgl1 += p1; }
    pg[1 + lane] = pgl0; pg[65 + lane] = pgl1; if (lane == 0) { pg[0] = 0.f; pg[129] = 0.f; }
    __syncthreads();
    {   float o0 = 0.f, o1 = 0.f, o2 = 0.f, o3 = 0.f;
        for (int c = 0; c < nvalid; ++c) { const float v = bf2f(VC[((size_t)(b * 128 + c) * 4 + g) * 64 + lane]); o0 += ps[0][c] * v; o1 += ps[1][c] * v; o2 += ps[2][c] * v; o3 += ps[3][c] * v; }
        float* op = OC + tok * 1024 + (g * 4) * 64 + lane; op[0] = o0; op[64] = o1; op[128] = o2; op[192] = o3; }
    const int cur = t >> 6; float score = -1e30f; bool valid = false; const int blk = lane & 31;
    {   const int c0 = 4 * blk;
        const float imp = pg[c0] + 2.f * (pg[c0 + 1] + pg[c0 + 2] + pg[c0 + 3]) + pg[c0 + 4];
        valid = blk <= cur; const bool forced = (blk == 0) || (blk == cur) || (blk == cur - 1);
        score = valid ? imp + (forced ? 1e4f : 0.f) : -1e30f; if (lane < 32) sc[lane] = score; }
    __syncthreads();
    int rank = 0;
    for (int j = 0; j < 32; ++j) { const float o = sc[j]; rank += (o > score || (o == score && j < blk)) ? 1 : 0; }
    const bool sel = (lane < 32) && valid && rank < 16;
    const unsigned long long bal = __ballot(sel);
    if (lane == 0) SEL[(size_t)(b * 4 + g) * 2048 + t] = (unsigned)bal;
}
template <int MODE> __global__ void __launch_bounds__(64) k_attn_naive(const bf16* PROJ, const float* rel, const unsigned* SEL, const float* CUM, float* OUTF, bf16* O, float* SSQ) {
    constexpr int NH = MODE == 2 ? 1 : 4, MAXK = MODE == 0 ? 1024 : (MODE == 1 ? 512 : 2048);
    __shared__ float qs[NH][64]; __shared__ float sb[NH][MAXK]; __shared__ int posb[MAXK];
    const int id = blockIdx.x, lane = threadIdx.x;
    const int hg = MODE == 2 ? (id & 15) : (id & 3), bt = MODE == 2 ? (id >> 4) : (id >> 2), t = bt & 2047, b = bt >> 11; const size_t tok = (size_t)b * 2048 + t;
    const int qcol = MODE == 2 ? C_FQ + hg * 64 : C_NQ + hg * 256, kcol = (MODE == 0 ? C_KSLC : MODE == 1 ? C_KWIN : C_FK) + hg * 64, vcol = (MODE == 0 ? C_VSLC : MODE == 1 ? C_VWIN : C_FV) + hg * 64;
#pragma unroll
    for (int r = 0; r < NH; ++r) qs[r][lane] = bf2f(PROJ[tok * NPROJ + qcol + r * 64 + lane]);
    __syncthreads();
    const unsigned mask = MODE == 0 ? SEL[(size_t)(b * 4 + hg) * 2048 + t] : 0u;
    const float ct = MODE == 2 ? CUM[(size_t)(b * 16 + hg) * 2048 + t] : 0.f;
    const int nchunk = MODE == 0 ? 32 : (MODE == 1 ? 8 : (t >> 6) + 1);
    int nk = 0; float mx[NH];
#pragma unroll
    for (int r = 0; r < NH; ++r) mx[r] = -INFINITY;
    for (int ch = 0; ch < nchunk; ++ch) {
        if (MODE == 0 && !((mask >> ch) & 1u)) continue;
        const int pos = MODE == 1 ? t - 511 + ch * 64 + lane : ch * 64 + lane; const bool ok = pos >= 0 && pos <= t;
        float d[NH];
#pragma unroll
        for (int r = 0; r < NH; ++r) d[r] = 0.f;
        if (ok) { const v4u* kr = (const v4u*)(PROJ + (size_t)(b * 2048 + pos) * NPROJ + kcol);
            for (int i = 0; i < 8; ++i) { const v4u w = kr[i];
                const float k0 = bflo(w.x), k1 = bfhi(w.x), k2 = bflo(w.y), k3 = bfhi(w.y), k4 = bflo(w.z), k5 = bfhi(w.z), k6 = bflo(w.w), k7 = bfhi(w.w);
#pragma unroll
                for (int r = 0; r < NH; ++r) { const float* q = &qs[r][i * 8]; d[r] += q[0] * k0 + q[1] * k1 + q[2] * k2 + q[3] * k3 + q[4] * k4 + q[5] * k5 + q[6] * k6 + q[7] * k7; } } }
#pragma unroll
        for (int r = 0; r < NH; ++r) { float bias;
            if (MODE == 2) bias = ok ? ct - CUM[(size_t)(b * 16 + hg) * 2048 + pos] : 0.f; else bias = rel[t5_bucket(t - pos) * 16 + hg * 4 + r] * LOG2E;
            const float s = ok ? d[r] + bias : -INFINITY; sb[r][nk + lane] = s; mx[r] = fmaxf(mx[r], s); }
        posb[nk + lane] = ok ? pos : -1; nk += 64;
    }
    __syncthreads();
    float inv[NH];
#pragma unroll
    for (int r = 0; r < NH; ++r) { const float m = wave_max(mx[r]); float sum = 0.f;
        for (int i = lane; i < nk; i += 64) { const float s = sb[r][i]; const float e = (s == -INFINITY) ? 0.f : exp2f(s - m); sb[r][i] = e; sum += e; }
        inv[r] = 1.f / fmaxf(wave_sum(sum), 1e-30f); }
    __syncthreads();
    float o[NH];
#pragma unroll
    for (int r = 0; r < NH; ++r) o[r] = 0.f;
    for (int i = 0; i < nk; ++i) { const int pos = posb[i]; if (pos < 0) continue; const float v = bf2f(PROJ[(size_t)(b * 2048 + pos) * NPROJ + vcol + lane]);
#pragma unroll
        for (int r = 0; r < NH; ++r) o[r] += sb[r][i] * v; }
    if (MODE == 2) { const float v = o[0] * inv[0]; O[tok * 2048 + 1024 + hg * 64 + lane] = (bf16)f2bf(v); const float ss = wave_sum(v * v); if (lane == 0) SSQ[tok * 32 + 16 + hg] = ss; }
    else {
#pragma unroll
        for (int r = 0; r < NH; ++r) OUTF[tok * 1024 + (hg * 4 + r) * 64 + lane] = o[r] * inv[r]; }
}
__global__ void __launch_bounds__(64) k_combine(const float* OC, const float* OS, const float* OW, const float* GF, bf16* O, float* SSQ) {
    const size_t tok = blockIdx.x; const int lane = threadIdx.x;
    for (int g = 0; g < 4; ++g) { float ss = 0.f;
        for (int r = 0; r < 4; ++r) { const float* gl = GF + tok * 64 + g * 12 + r * 3;
            const float g0 = 1.f / (1.f + expf(-gl[0])), g1 = 1.f / (1.f + expf(-gl[1])), g2 = 1.f / (1.f + expf(-gl[2]));
            const size_t idx = tok * 1024 + (g * 4 + r) * 64 + lane; const float v = g0 * OC[idx] + g1 * OS[idx] + g2 * OW[idx];
            O[tok * 2048 + (g * 4 + r) * 64 + lane] = (bf16)f2bf(v); ss += v * v; }
        ss = wave_sum(ss); if (lane == 0) SSQ[tok * 32 + g] = ss; }
}
__global__ void __launch_bounds__(64) k_normalize(const bf16* O, const float* SSQ, bf16* MIXED) {
    const size_t tok = blockIdx.x; const int lane = threadIdx.x;
    float a = 0.f, f = 0.f;
    for (int i = 0; i < 4; ++i) a += SSQ[tok * 32 + i];
    for (int i = 0; i < 16; ++i) f += SSQ[tok * 32 + 16 + i];
    const float ra = 1.f / sqrtf(a * (1.f / 1024.f) + NORM_EPS), rf = 1.f / sqrtf(f * (1.f / 1024.f) + NORM_EPS);
    for (int i = lane; i < 2048; i += 64) MIXED[tok * 2048 + i] = (bf16)f2bf(bf2f(O[tok * 2048 + i]) * (i < 1024 ? ra : rf));
}
__global__ void __launch_bounds__(64) k_router(const bf16* HB, const float* HSSQ, const float* ffn_w, const float* wg, const float* bg, const float* we, const float* be, int* EID, float* WT, float* RSTD) {
    __shared__ float lg[40];
    const size_t tok = blockIdx.x; const int lane = threadIdx.x;
    float ss = (lane < 32) ? HSSQ[tok * 32 + lane] : 0.f; ss = wave_sum(ss);
    const float rstd = 1.f / sqrtf(ss * (1.f / 2048.f) + NORM_EPS);
    float acc[36];
#pragma unroll
    for (int o = 0; o < 36; ++o) acc[o] = 0.f;
    for (int i = 0; i < 32; ++i) { const int k = i * 64 + lane; const float hn = bf2f(HB[tok * 2048 + k]) * rstd * ffn_w[k];
        const f32x4 g4 = *(const f32x4*)(wg + (size_t)k * 4);
        acc[0] += hn * g4[0]; acc[1] += hn * g4[1]; acc[2] += hn * g4[2]; acc[3] += hn * g4[3];
#pragma unroll
        for (int j = 0; j < 8; ++j) { const f32x4 e4 = *(const f32x4*)(we + (size_t)k * 32 + j * 4);
            acc[4 + j * 4 + 0] += hn * e4[0]; acc[4 + j * 4 + 1] += hn * e4[1]; acc[4 + j * 4 + 2] += hn * e4[2]; acc[4 + j * 4 + 3] += hn * e4[3]; } }
#pragma unroll
    for (int o = 0; o < 36; ++o) { const float v = wave_sum(acc[o]); if (lane == 0) lg[o] = v + (o < 4 ? bg[o] : be[o - 4]); }
    __syncthreads();
    if (lane == 0) {
        int gsel = 0; float gm = lg[0];
        for (int i = 1; i < 4; ++i) if (lg[i] > gm) { gm = lg[i]; gsel = i; }
        float den = 0.f; for (int i = 0; i < 4; ++i) den += expf(lg[i] - gm);
        const float pgs = 1.f / den;
        const float* el = lg + 4 + gsel * 8;
        int i1 = 0; float v1 = el[0];
        for (int j = 1; j < 8; ++j) if (el[j] > v1) { v1 = el[j]; i1 = j; }
        int i2 = -1; float v2 = -INFINITY;
        for (int j = 0; j < 8; ++j) if (j != i1 && el[j] > v2) { v2 = el[j]; i2 = j; }
        const float e2 = expf(v2 - v1), d2 = 1.f / (1.f + e2);
        EID[tok * 2] = gsel * 8 + i1; EID[tok * 2 + 1] = gsel * 8 + i2; WT[tok * 2] = d2 * pgs; WT[tok * 2 + 1] = e2 * d2 * pgs; RSTD[tok] = rstd;
    }
}
__global__ void __launch_bounds__(1024) k_sort1(const int* EID, int* LIST, int* CNT) {
    __shared__ int wtot[16];
    const int e = blockIdx.x, tid = threadIdx.x, lane = tid & 63, w = tid >> 6; int base = 0;
    for (int chunk = 0; chunk < 32768; chunk += 1024) { const int idx = chunk + tid; const bool f = EID[idx] == e;
        const unsigned long long bal = __ballot(f); const int pre = __popcll(bal & ((1ull << lane) - 1ull));
        if (lane == 0) wtot[w] = __popcll(bal);
        __syncthreads();
        int woff = 0, tot = 0;
        for (int i = 0; i < 16; ++i) { const int c = wtot[i]; if (i < w) woff += c; tot += c; }
        if (f) LIST[(size_t)e * 32768 + base + woff + pre] = idx;
        base += tot; __syncthreads(); }
    if (tid == 0) CNT[e] = base;
}
__global__ void __launch_bounds__(64) k_sort2(const int* CNT, int* BASE, int* NT, int* TEXP) {
    const int lane = threadIdx.x; const int cnt = lane < 32 ? CNT[lane] : 0; const int padded = (cnt + 255) & ~255;
    int incl = padded;
    for (int o = 1; o < 64; o <<= 1) { const int v = __shfl_up(incl, o); if (lane >= o) incl += v; }
    const int excl = incl - padded;
    if (lane < 32) { BASE[lane] = excl; for (int tl = excl >> 8; tl < (incl >> 8); ++tl) TEXP[tl] = lane; }
    if (lane == 31) { BASE[32] = incl; NT[0] = incl >> 8; }
}
__global__ void __launch_bounds__(256) k_sort3(const int* CNT, const int* BASE, const int* NT, const int* TEXP, const int* LIST, const float* WT, const float* RSTD, int* RDST, float* RWT, float* RSTDS) {
    const int row = blockIdx.x * 256 + threadIdx.x, tl = row >> 8; int d = -1; float w = 0.f, r = 0.f;
    if (tl < NT[0]) { const int e = TEXP[tl], j = row - BASE[e]; if (j < CNT[e]) { d = LIST[(size_t)e * 32768 + j]; w = WT[d]; r = RSTD[d >> 1]; } }
    RDST[row] = d; RWT[row] = w; RSTDS[row] = r;
}
__global__ void __launch_bounds__(256) k_gather(const bf16* HB, const int* RDST, bf16* XS) {
    const int row = blockIdx.x * 4 + (threadIdx.x >> 6), lane = threadIdx.x & 63; const int d = RDST[row];
    v4u* dst = (v4u*)(XS + (size_t)row * 2048);
    if (d >= 0) { const v4u* src = (const v4u*)(HB + (size_t)(d >> 1) * 2048);
#pragma unroll
        for (int i = 0; i < 4; ++i) dst[i * 64 + lane] = src[i * 64 + lane]; }
    else {
#pragma unroll
        for (int i = 0; i < 4; ++i) dst[i * 64 + lane] = (v4u){0u, 0u, 0u, 0u}; }
}
__global__ void __launch_bounds__(64) k_final(const bf16* HB, const bf16* YS, const float* fw, float* OUT) {
    const size_t tok = blockIdx.x; const int lane = threadIdx.x;
    float v[32]; float ss = 0.f;
#pragma unroll
    for (int i = 0; i < 32; ++i) { const int k = i * 64 + lane; const float x = bf2f(HB[tok * 2048 + k]) + bf2f(YS[tok * 2048 + k]) + bf2f(YS[(size_t)16384 * 2048 + tok * 2048 + k]); v[i] = x; ss += x * x; }
    ss = wave_sum(ss); const float r = 1.f / sqrtf(ss * (1.f / 2048.f) + NORM_EPS);
#pragma unroll
    for (int i = 0; i < 32; ++i) { const int k = i * 64 + lane; OUT[tok * 2048 + k] = v[i] * r * fw[k]; }
}

constexpr int NWAVES = 8;
constexpr int RING_BYTES = 131072;
constexpr int LDSCTL_OFF = RING_BYTES, MISC_OFF = LDSCTL_OFF + 320;
constexpr int LDS_BYTES = 147456;
constexpr int CW_BAR = 4096;
constexpr int N_BAR_REGIONS = 8;
static_assert((CW_BAR + N_BAR_REGIONS * XCD_BAR_WORDS) * 4 <= (int)CTL_ZERO_BYTES, "barrier words inside the memset region");

struct Args { const float* in[23]; float* out; unsigned char* ws; int ph_lo, ph_hi, li, pad; };

template <class ColOf, class RowOf, class ScaleOf>
__device__ __forceinline__ void tr_item(const float* W, size_t pitch, int k0, int n0, LAS float* scr, int lane, bf16* WT, int Kdst, const float* ks, ColOf colof, RowOf rowof, ScaleOf scaleof) {
    const int nl = lane & 31; const int sc = colof(n0 + nl);
#pragma unroll 8
    for (int i = 0; i < 32; ++i) { const int kk = 2 * i + (lane >> 5); scr[kk * 33 + nl] = W[(size_t)(k0 + kk) * pitch + sc]; }
    LDS_WAIT(); asm volatile("" ::: "memory");
    const int c = lane & 7; float kf[8];
#pragma unroll
    for (int j = 0; j < 8; ++j) kf[j] = ks ? ks[k0 + 8 * c + j] : 1.f;
#pragma unroll
    for (int j = 0; j < 4; ++j) { const int n = (lane >> 3) + 8 * j; const LAS float* s = scr + (8 * c) * 33 + n; const float cs = scaleof(n0 + n);
        v4u o; o.x = pk2(s[0 * 33] * kf[0] * cs, s[1 * 33] * kf[1] * cs); o.y = pk2(s[2 * 33] * kf[2] * cs, s[3 * 33] * kf[3] * cs);
        o.z = pk2(s[4 * 33] * kf[4] * cs, s[5 * 33] * kf[5] * cs); o.w = pk2(s[6 * 33] * kf[6] * cs, s[7 * 33] * kf[7] * cs);
        *(GAS v4u*)(WT + (size_t)rowof(n0 + n) * Kdst + k0 + 8 * c) = o; }
    LDS_WAIT(); asm volatile("" ::: "memory");
}
__device__ __forceinline__ void rms_row_to_bf16(const float* xrow, const float* w, bf16* orow, int lane) {
    const GAS f32x4* xr = (const GAS f32x4*)xrow + lane; const GAS f32x4* wr = (const GAS f32x4*)w + lane;
    f32x4 v[8]; float s = 0.f;
#pragma unroll
    for (int j = 0; j < 8; ++j) { v[j] = xr[64 * j]; s += (v[j].x * v[j].x + v[j].y * v[j].y) + (v[j].z * v[j].z + v[j].w * v[j].w); }
    const float r = 1.f / sqrtf(wave_sum(s) * (1.f / 2048.f) + NORM_EPS);
    GAS unsigned long long* o8 = (GAS unsigned long long*)orow + lane;
#pragma unroll
    for (int j = 0; j < 8; ++j) { const f32x4 ww = wr[64 * j]; o8[64 * j] = (unsigned long long)pk2(v[j].x * r * ww.x, v[j].y * r * ww.y) | ((unsigned long long)pk2(v[j].z * r * ww.z, v[j].w * r * ww.w) << 32); }
}

__global__ void __launch_bounds__(NWAVES * 64, 2) mk(Args args) {
    extern __shared__ __attribute__((aligned(16))) unsigned char lds[];
    LAS unsigned char* L = (LAS unsigned char*)lds;
    volatile LAS unsigned* MISC = (volatile LAS unsigned*)(L + MISC_OFF);
    const int tid = threadIdx.x, lane = tid & 63, wave = __builtin_amdgcn_readfirstlane(tid >> 6);
    const int G = gridDim.x; const int bx = blockIdx.x; const int vcu = (G % 8 == 0) ? (bx % 8) * (G / 8) + bx / 8 : bx;
    unsigned char* ws = args.ws;
    gu32* ctl = (gu32*)(ws + WS_CTL);
    for (int u = tid; u < (LDS_BYTES - LDSCTL_OFF) / 4; u += NWAVES * 64) ((LAS unsigned*)(L + LDSCTL_OFF))[u] = 0u;
    __syncthreads();
    XcdBarrier bar = xcd_barrier_post((unsigned*)(ctl + CW_BAR) + args.li * XCD_BAR_WORDS, MISC + 8);
    const int lo = args.ph_lo, hi = args.ph_hi;
#define IN(k) (lo <= (k) && (k) < hi)
#define BOTH(k, k2) (IN(k) && IN(k2))
    bf16* WinT = (bf16*)(ws + WS_WIN_T); bf16* WoutT = (bf16*)(ws + WS_WOUT_T); bf16* WguT = (bf16*)(ws + WS_WGU_T); bf16* WdT = (bf16*)(ws + WS_WD_T);
    bf16* XN = (bf16*)(ws + WS_XN); bf16* PROJ = (bf16*)(ws + WS_PROJ); float* GF = (float*)(ws + WS_GF); bf16* HB = (bf16*)(ws + WS_HB);
    bf16* MIXED = (bf16*)(ws + WS_PROJ); bf16* XS = (bf16*)(ws + WS_PROJ); bf16* YS = (bf16*)(ws + WS_PROJ); bf16* HID = (bf16*)(ws + WS_XN);
    float* HSSQ = (float*)(ws + WS_HSSQ);
    const int* NTp = (const int*)(ws + WS_SORT + 512); const int* TEXP = (const int*)(ws + WS_SORT + 1024);
    const int* RDST = (const int*)(ws + WS_SORT + 65536); const float* RWT = (const float*)(ws + WS_SORT + 262144); const float* RSTDS = (const float*)(ws + WS_SORT + 458752);

    if (IN(0)) {
        LAS float* scr = (LAS float*)(L + wave * 16384);
        const int gw = vcu * NWAVES + wave, NGW = G * NWAVES;
        const float* w_in = args.in[2]; const float* w_out = args.in[13]; const float* wgate = args.in[19]; const float* wup = args.in[20]; const float* wdown = args.in[21];
        const float* nsa_w = args.in[11]; const float* fox_w = args.in[12]; const float* ffn_w = args.in[14];
        constexpr int I_IN = 32 * 178, I_OUT = 32 * 64, I_GU = 32 * 32 * 16, I_D = 32 * 8 * 64;
        constexpr int NITEMS = I_IN + I_OUT + 2 * I_GU + I_D;
        for (int it = gw; it < NITEMS; it += NGW) {
            int r = it;
            if (r < I_IN) { const int kb = r / 178, nb = r % 178;
                tr_item(w_in, 5696, 64 * kb, 32 * nb, scr, lane, WinT, 2048, nullptr,
                        [](int j) { return j < 2560 ? j : (j < 5632 ? j + 48 : (j < 5680 ? j - 5632 + 2560 : j)); }, [](int j) { return j; },
                        [](int j) { return (j < 1024 || (j >= 2560 && j < 3584)) ? C2 : 1.f; });
                continue; } r -= I_IN;
            if (r < I_OUT) { const int kb = r / 64, nb = r % 64; const float* ks = (kb < 16) ? nsa_w : fox_w - 1024;
                tr_item(w_out, 2048, 64 * kb, 32 * nb, scr, lane, WoutT, 2048, ks, [](int j) { return j; }, [](int j) { return j; }, [](int) { return 1.f; });
                continue; } r -= I_OUT;
            if (r < 2 * I_GU) { const int up = r >= I_GU; if (up) r -= I_GU; const int e = r / 512, q = r % 512, kb = q / 16, nb = q % 16;
                const float* src = (up ? wup : wgate) + (size_t)e * 2048 * 512; const int rb = e * 1024 + (up ? 128 : 0);
                tr_item(src, 512, 64 * kb, 32 * nb, scr, lane, WguT, 2048, ffn_w, [](int j) { return j; }, [rb](int j) { return rb + (j >> 7) * 256 + (j & 127); }, [](int) { return 1.f; });
                continue; } r -= 2 * I_GU;
            { const int e = r / 512, q = r % 512, kb = q / 64, nb = q % 64; const float* src = wdown + (size_t)e * 512 * 2048; const int rb = e * 2048;
                tr_item(src, 2048, 64 * kb, 32 * nb, scr, lane, WdT, 512, nullptr, [](int j) { return j; }, [rb](int j) { return rb + j; }, [](int) { return 1.f; }); }
        }
        for (int i = gw * 64 + lane; i < 192 * 256; i += NGW * 64) ((GAS v4u*)(WinT + (size_t)5696 * 2048))[i] = (v4u){0u, 0u, 0u, 0u};
        for (int m = gw; m < NTOK; m += NGW) rms_row_to_bf16(args.in[0] + (size_t)m * DM, args.in[1], XN + (size_t)m * DM, lane);
        if (BOTH(0, 1)) xcd_barrier(bar);
    }
    if (IN(1)) {
        pg8::Gemm g{XN, WinT, NTOK, NPROJ_PAD, DM}; pg8::StaticOrder S; S.init(NTOK, NPROJ_PAD, G, bx);
        pg8::EpiProj E{PROJ, GF};
        pg8::gemm_phase<pg8::EpiProj, pg8::StaticOrder, true, true>(L, g, S, E);
    }
    if (IN(4)) {
        pg8::Gemm g{MIXED, WoutT, NTOK, DM, DM}; pg8::StaticOrder S; S.init(NTOK, DM, G, bx);
        pg8::EpiOut E{args.in[0], HB, HSSQ, nullptr};
        pg8::gemm_phase<pg8::EpiOut, pg8::StaticOrder, true, true>(L, g, S, E);
    }
    if (IN(6)) {
        const int nt = ld_i32(NTp);
        pg8::Gemm g{XS, WguT, MAXROWS, 1024, DM}; pg8::GroupedOrder S{nt, 4, G, bx, TEXP};
        pg8::EpiGateUp E{HID, RSTDS};
        pg8::gemm_phase<pg8::EpiGateUp, pg8::GroupedOrder, true, true>(L, g, S, E);
        if (BOTH(6, 7)) xcd_barrier(bar);
    }
    if (IN(7)) {
        const int nt = ld_i32(NTp);
        pg8::Gemm g{HID, WdT, MAXROWS, 2048, EFF}; pg8::GroupedOrder S{nt, 8, G, bx, TEXP};
        pg8::EpiDown E{YS, RDST, RWT};
        pg8::gemm_phase<pg8::EpiDown, pg8::GroupedOrder, true, true>(L, g, S, E);
    }
#undef IN
#undef BOTH
}

extern "C" void kernel_launch(void* const* d_in, const int* in_sizes, int n_in, void* d_out, int out_size, void* d_ws, size_t ws_size, hipStream_t stream) {
    static int grid = 0;
    if (grid == 0) {
        if (n_in != 23 || in_sizes[0] != NTOK * DM || out_size != NTOK * DM || ws_size < WS_END) { fprintf(stderr, "kernel_launch: unexpected shapes (n_in %d, in0 %d, out %d, ws %zu < %zu)\n", n_in, n_in > 0 ? in_sizes[0] : -1, out_size, ws_size, (size_t)WS_END); grid = -1; return; }
        int dev = 0, cus = 0;
        if (hipGetDevice(&dev) != hipSuccess || hipDeviceGetAttribute(&cus, hipDeviceAttributeMultiprocessorCount, dev) != hipSuccess) { grid = -1; return; }
        if (hipFuncSetAttribute((const void*)mk, hipFuncAttributeMaxDynamicSharedMemorySize, LDS_BYTES) != hipSuccess) { fprintf(stderr, "kernel_launch: hipFuncSetAttribute failed\n"); grid = -1; return; }
        int per_cu = 0;
        if (hipOccupancyMaxActiveBlocksPerMultiprocessor(&per_cu, (const void*)mk, NWAVES * 64, LDS_BYTES) != hipSuccess || per_cu < 1) fprintf(stderr, "kernel_launch: occupancy query says %d\n", per_cu);
        (void)hipGetLastError();
        grid = cus;
    }
    if (grid < 0) return;
    unsigned char* ws = (unsigned char*)d_ws;
    (void)hipMemsetAsync(ws + WS_CTL, 0, CTL_ZERO_BYTES, stream);
    Args a{};
    for (int i = 0; i < 23; ++i) a.in[i] = (const float*)d_in[i];
    a.out = (float*)d_out; a.ws = ws;
    const float* const* in = (const float* const*)d_in;
    bf16* PROJ = (bf16*)(ws + WS_PROJ); float* GF = (float*)(ws + WS_GF); bf16* KC = (bf16*)(ws + WS_KC); bf16* VC = (bf16*)(ws + WS_VC); float* CUM = (float*)(ws + WS_CUM);
    float* SSQ = (float*)(ws + WS_SSQ); float* HSSQ = (float*)(ws + WS_HSSQ); unsigned* SEL = (unsigned*)(ws + WS_SEL);
    int* EID = (int*)(ws + WS_ROUTE); float* WT = (float*)(ws + WS_ROUTE + 131072); float* RSTD = (float*)(ws + WS_ROUTE + 262144);
    int* CNT = (int*)(ws + WS_SORT); int* BASE = (int*)(ws + WS_SORT + 256); int* NT = (int*)(ws + WS_SORT + 512); int* TEXP = (int*)(ws + WS_SORT + 1024);
    int* RDST = (int*)(ws + WS_SORT + 65536); float* RWT = (float*)(ws + WS_SORT + 262144); float* RSTDS = (float*)(ws + WS_SORT + 458752); int* LIST = (int*)(ws + WS_SORT + MiB);
    bf16* O = (bf16*)(ws + WS_XN); bf16* MIXED = (bf16*)(ws + WS_PROJ); bf16* XS = (bf16*)(ws + WS_PROJ); bf16* YS = (bf16*)(ws + WS_PROJ); bf16* HB = (bf16*)(ws + WS_HB);
    float* OC = (float*)d_out; float* OS = (float*)d_out + (size_t)NTOK * 1024; float* OW = (float*)(ws + WS_HB);
    auto launch_mk = [&](int lo, int hi, int li) { a.ph_lo = lo; a.ph_hi = hi; a.li = li; hipLaunchKernelGGL(mk, dim3(grid), dim3(NWAVES * 64), LDS_BYTES, stream, a); };
    launch_mk(0, 2, 0);
    hipLaunchKernelGGL(k_compress, dim3(8 * 128 * 4 * 2), dim3(128), 0, stream, PROJ, in[3], in[4], in[5], in[6], in[7], in[8], KC, VC);
    hipLaunchKernelGGL(k_cumsum, dim3(128), dim3(64), 0, stream, GF, in[10], CUM);
    hipLaunchKernelGGL(k_cmp_sel, dim3(NTOK * 4), dim3(64), 0, stream, PROJ, KC, VC, in[9], OC, SEL);
    hipLaunchKernelGGL(k_attn_naive<0>, dim3(NTOK * 4), dim3(64), 0, stream, PROJ, in[9], SEL, CUM, OS, O, SSQ);
    hipLaunchKernelGGL(k_attn_naive<1>, dim3(NTOK * 4), dim3(64), 0, stream, PROJ, in[9], SEL, CUM, OW, O, SSQ);
    hipLaunchKernelGGL(k_attn_naive<2>, dim3(NTOK * 16), dim3(64), 0, stream, PROJ, in[9], SEL, CUM, (float*)nullptr, O, SSQ);
    hipLaunchKernelGGL(k_combine, dim3(NTOK), dim3(64), 0, stream, OC, OS, OW, GF, O, SSQ);
    hipLaunchKernelGGL(k_normalize, dim3(NTOK), dim3(64), 0, stream, O, SSQ, MIXED);
    launch_mk(4, 5, 1);
    hipLaunchKernelGGL(k_router, dim3(NTOK), dim3(64), 0, stream, HB, HSSQ, in[14], in[15], in[16], in[17], in[18], EID, WT, RSTD);
    hipLaunchKernelGGL(k_sort1, dim3(32), dim3(1024), 0, stream, EID, LIST, CNT);
    hipLaunchKernelGGL(k_sort2, dim3(1), dim3(64), 0, stream, CNT, BASE, NT, TEXP);
    hipLaunchKernelGGL(k_sort3, dim3(MAXROWS / 256), dim3(256), 0, stream, CNT, BASE, NT, TEXP, LIST, WT, RSTD, RDST, RWT, RSTDS);
    hipLaunchKernelGGL(k_gather, dim3(MAXROWS / 4), dim3(256), 0, stream, HB, RDST, XS);
    launch_mk(6, 8, 2);
    hipLaunchKernelGGL(k_final, dim3(NTOK), dim3(64), 0, stream, HB, YS, in[22], (float*)d_out);
}
```

```cpp
#include <hip/hip_runtime.h>
#include <cstdio>
#include <cstdint>

constexpr int BATCH = 8, SEQ = 2048, DM = 2048, NTOK = BATCH * SEQ;
constexpr int NPROJ = 5632, NPROJ_PAD = 5888;
constexpr int C_NQ = 0, C_KCMP = 1024, C_VCMP = 1280, C_KSLC = 1536, C_VSLC = 1792, C_KWIN = 2048, C_VWIN = 2304, C_FQ = 2560, C_FK = 3584, C_FV = 4608;
constexpr int NEXP = 32, EFF = 512;
constexpr int MAXROWS = 40960;
constexpr float NORM_EPS = 1e-6f;
constexpr float LOG2E = 1.4426950408889634f;
constexpr float C2 = 0.125f * LOG2E;

constexpr size_t MiB = 1u << 20;
constexpr size_t WS_CTL = 0, CTL_ZERO_BYTES = 1 * MiB;
constexpr size_t WS_WIN_T = 1 * MiB;
constexpr size_t WS_WOUT_T = 24 * MiB;
constexpr size_t WS_WGU_T = 32 * MiB;
constexpr size_t WS_WD_T = 160 * MiB;
constexpr size_t WS_W1T = 224 * MiB;
constexpr size_t WS_KC = 225 * MiB;
constexpr size_t WS_VC = WS_KC + 512 * 1024;
constexpr size_t WS_CUM = 226 * MiB;
constexpr size_t WS_GF = 227 * MiB;
constexpr size_t WS_SSQ = 231 * MiB;
constexpr size_t WS_HSSQ = 233 * MiB;
constexpr size_t WS_B1 = 235 * MiB;
constexpr size_t WS_WRT = 235 * MiB + 512 * 1024;
constexpr size_t WS_ROUTE = 236 * MiB;
constexpr size_t WS_SORT = 237 * MiB;
constexpr size_t WS_XN = 244 * MiB;
constexpr size_t WS_PROJ = 308 * MiB;
constexpr size_t WS_HB = 484 * MiB;
constexpr size_t WS_END = 548 * MiB;
namespace pg8 {
#define PG8_LAS __attribute__((address_space(3)))
typedef unsigned short bf16_t;
typedef short bf16x8 __attribute__((ext_vector_type(8)));
typedef float f32x4 __attribute__((ext_vector_type(4)));
typedef unsigned u32x4 __attribute__((ext_vector_type(4)));
constexpr int BM = 256, BK = 64, HALF = 128, HTB = HALF * BK * 2  , STAGE_BYTES = 8 * HTB, NXCD = 8, WGM = 8;

__host__ __device__ __forceinline__ int lds_byte(int r, int c) { const int st = (r >> 4) * 2 + (c >> 5), rr = r & 15, cc = c & 31, ob = rr * 64 + cc * 2; return st * 1024 + (ob ^ (((ob >> 9) & 1) << 5)); }
__host__ __device__ __forceinline__ void stage_rc(int b, int& R, int& C) { const int st = b / 1024, sb = b % 1024, swz = sb ^ (((sb >> 9) & 1) << 5); R = (st >> 1) * 16 + swz / 64; C = (st & 1) * 32 + (swz % 64) / 2; }
__host__ __device__ __forceinline__ int perm32(int rho) { const int n = rho >> 4, i = rho & 15; return 8 * (i >> 2) + 4 * n + (i & 3); }

typedef int v8i32 __attribute__((ext_vector_type(8)));
__device__ __forceinline__ v8i32 cat8(bf16x8 lo, bf16x8 hi) { typedef int v4i __attribute__((ext_vector_type(4))); const v4i a = __builtin_bit_cast(v4i, lo), b = __builtin_bit_cast(v4i, hi); return (v8i32){a[0], a[1], a[2], a[3], b[0], b[1], b[2], b[3]}; }
typedef int v4i32 __attribute__((ext_vector_type(4)));
template <bool FP8> struct FragT;
template <> struct FragT<false> {
    struct type { bf16x8 k0, k1; };
    static __device__ __forceinline__ void ld(type& f, const PG8_LAS unsigned char* p) { f.k0 = *(const PG8_LAS bf16x8*)p; f.k1 = *(const PG8_LAS bf16x8*)(p + 1024); }
    static __device__ __forceinline__ void mma(f32x4& acc, const type& b, const type& a) { acc = __builtin_amdgcn_mfma_f32_16x16x32_bf16(b.k0, a.k0, acc, 0, 0, 0); acc = __builtin_amdgcn_mfma_f32_16x16x32_bf16(b.k1, a.k1, acc, 0, 0, 0); }
};
template <> struct FragT<true> {
    typedef v8i32 type;
    static __device__ __forceinline__ void ld(type& f, const PG8_LAS unsigned char* p) { f.lo = *(const PG8_LAS v4i32*)p; f.hi = *(const PG8_LAS v4i32*)(p + 1024); }
    static __device__ __forceinline__ void mma(f32x4& acc, const type& b, const type& a) {
#if defined(__HIP_DEVICE_COMPILE__)
        int sc = 0x7F7F7F7F;
        asm volatile("v_mfma_scale_f32_16x16x128_f8f6f4 %0, %1, %2, %0, %3, %3 op_sel_hi:[0,0,0]" : "+v"(acc) : "v"(b), "v"(a), "v"(sc));
#endif
    }
};
struct Unit { int pm, pn, bn, koff, kh; };
struct Gemm { const bf16_t* A; const bf16_t* Bt; int M, N, K, ld; };

struct StaticOrder {
    int nM, nN, nwg, G, c;
    __host__ __device__ void init(int M, int N, int G_, int c_) { nM = M / BM; nN = N / BM; nwg = nM * nN; G = G_; c = c_; }
    __host__ __device__ bool next(int i, Unit& u) const {
        const long L = (long)i * G + c; if (L >= nwg) return false;
        int wgid = (int)L; { const int q = nwg / NXCD, r = nwg % NXCD, xcd = wgid % NXCD, off = wgid / NXCD; wgid = (xcd < r ? xcd * (q + 1) : r * (q + 1) + (xcd - r) * q) + off; }
        const int nig = WGM * nN, gid = wgid / nig, fm = gid * WGM, gsz = (nM - fm) < WGM ? (nM - fm) : WGM;
        u.pm = fm + ((wgid % nig) % gsz); u.pn = (wgid % nig) / gsz; u.bn = u.pn; u.koff = 0; u.kh = 1; return true;
    }
    __device__ __forceinline__ void a_ready(const Unit&) const {}
    __device__ __forceinline__ void done(const Unit&) const {}
};

struct StaticOrder2 {
    StaticOrder S; int khalf;
    __host__ __device__ bool next(int i, Unit& u) const { if (!S.next(i >> 1, u)) return false; u.kh = i & 1; u.koff = (i & 1) * khalf; return true; }
    __device__ __forceinline__ void a_ready(const Unit&) const {}
    __device__ __forceinline__ void done(const Unit&) const {}
};

__device__ __forceinline__ unsigned cvt_pk_bf16(float lo, float hi) { unsigned r; asm volatile("v_cvt_pk_bf16_f32 %0, %1, %2" : "=v"(r) : "v"(lo), "v"(hi)); return r; }
typedef float f32x2 __attribute__((ext_vector_type(2)));

__device__ __forceinline__ unsigned pk_fp8x4(float a, float b, float c, float d) { unsigned w = 0u; w = (unsigned)__builtin_amdgcn_cvt_pk_fp8_f32(a, b, (int)w, false); w = (unsigned)__builtin_amdgcn_cvt_pk_fp8_f32(c, d, (int)w, true); return w; }
struct EpiProj {
    static constexpr bool PERM = true, AFTER_DRAIN = false, MID = false;
    bf16_t* P; float* GF;
    __device__ __forceinline__ void operator()(const f32x4 (&acc)[2][2][4][2], const Unit& u, int wr, int wc, int fr, int fq) const {
        const int row0 = u.pm * BM + wr * 64 + fr;
        if (u.pn < 22) {
            const int col0 = u.pn * BM + wc * 32 + 8 * fq;
#pragma unroll
            for (int ai = 0; ai < 2; ++ai)
#pragma unroll
                for (int m = 0; m < 4; ++m) { bf16_t* rowp = P + (size_t)(row0 + ai * HALF + m * 16) * 5632 + col0;
#pragma unroll
                    for (int bj = 0; bj < 2; ++bj) { const f32x4 v0 = acc[ai][bj][m][0], v1 = acc[ai][bj][m][1];
                        u32x4 w; w.x = cvt_pk_bf16(v0[0], v0[1]); w.y = cvt_pk_bf16(v0[2], v0[3]); w.z = cvt_pk_bf16(v1[0], v1[1]); w.w = cvt_pk_bf16(v1[2], v1[3]);
                        *(u32x4*)(rowp + bj * HALF) = w; } }
        } else {
            const int col0 = wc * 32 + 8 * fq;
            if (col0 < 64) {
#pragma unroll
                for (int ai = 0; ai < 2; ++ai)
#pragma unroll
                    for (int m = 0; m < 4; ++m) { float* rowp = GF + (size_t)(row0 + ai * HALF + m * 16) * 64 + col0;
                        *(f32x4*)(rowp) = acc[ai][0][m][0]; *(f32x4*)(rowp + 4) = acc[ai][0][m][1]; }
            }
        }
    }
};
struct EpiOut {
    static constexpr bool PERM = true, AFTER_DRAIN = false, MID = true;
    const float* X; bf16_t* HB; float* HSSQ; const float* SSQ; unsigned char* HB8;
    const PG8_LAS float* RT; int pm0, pn0;
    __device__ __forceinline__ const PG8_LAS float* rt_of(const Unit& u, int wr, int fr) const { return RT + ((u.pm == pm0 && u.pn == pn0) ? 0 : 512) + (wr * 64 + fr) * 2; }
    __device__ __forceinline__ void mid(f32x4 (&acc)[2][2][4][2], const Unit& u, int wr, int wc, int fr, int fq) const {
        const PG8_LAS float* rt = rt_of(u, wr, fr);
#pragma unroll
        for (int ai = 0; ai < 2; ++ai)
#pragma unroll
            for (int m = 0; m < 4; ++m) { const float q = rt[(ai * HALF + m * 16) * 2];
#pragma unroll
                for (int bj = 0; bj < 2; ++bj)
#pragma unroll
                    for (int n = 0; n < 2; ++n) acc[ai][bj][m][n] *= q; }
    }
    __device__ __forceinline__ void operator()(const f32x4 (&acc)[2][2][4][2], const Unit& u, int wr, int wc, int fr, int fq) const {
        const int row0 = u.pm * BM + wr * 64 + fr, col0 = u.pn * BM + wc * 32 + 8 * fq;
        const PG8_LAS float* rt = rt_of(u, wr, fr);
        f32x4 xa[2][2], xb[2][2];
        { const float* xr = X + (size_t)row0 * 2048 + col0;
#pragma unroll
            for (int bj = 0; bj < 2; ++bj) { xa[bj][0] = *(const f32x4*)(xr + bj * HALF); xa[bj][1] = *(const f32x4*)(xr + bj * HALF + 4); } }
#pragma unroll
        for (int ai = 0; ai < 2; ++ai)
#pragma unroll
            for (int m = 0; m < 4; ++m) { const int row = row0 + ai * HALF + m * 16; const float rs = rt[(ai * HALF + m * 16) * 2 + 1];
                if (!(ai == 1 && m == 3)) { const int rn = row0 + (m == 3 ? HALF : ai * HALF + (m + 1) * 16); const float* xr = X + (size_t)rn * 2048 + col0;
#pragma unroll
                    for (int bj = 0; bj < 2; ++bj) { xb[bj][0] = *(const f32x4*)(xr + bj * HALF); xb[bj][1] = *(const f32x4*)(xr + bj * HALF + 4); } }
                bf16_t* hr = HB + (size_t)row * 2048 + col0; float ss = 0.f;
#pragma unroll
                for (int bj = 0; bj < 2; ++bj) { const f32x4 v0 = acc[ai][bj][m][0] * rs + xa[bj][0], v1 = acc[ai][bj][m][1] * rs + xa[bj][1];
                    ss += (v0[0] * v0[0] + v0[1] * v0[1]) + (v0[2] * v0[2] + v0[3] * v0[3]) + (v1[0] * v1[0] + v1[1] * v1[1]) + (v1[2] * v1[2] + v1[3] * v1[3]);
                    u32x4 w; w.x = cvt_pk_bf16(v0[0], v0[1]); w.y = cvt_pk_bf16(v0[2], v0[3]); w.z = cvt_pk_bf16(v1[0], v1[1]); w.w = cvt_pk_bf16(v1[2], v1[3]);
                    *(u32x4*)(hr + bj * HALF) = w;
                    *(unsigned long long*)(HB8 + (size_t)row * 2048 + col0 + bj * HALF) = (unsigned long long)pk_fp8x4(v0[0], v0[1], v0[2], v0[3]) | ((unsigned long long)pk_fp8x4(v1[0], v1[1], v1[2], v1[3]) << 32); }
                ss += __shfl_xor(ss, 16); ss += __shfl_xor(ss, 32);
                if (fq == 0) HSSQ[(size_t)row * 32 + u.pn * 4 + wc] = ss;
#pragma unroll
                for (int bj = 0; bj < 2; ++bj) { xa[bj][0] = xb[bj][0]; xa[bj][1] = xb[bj][1]; }
                __builtin_amdgcn_sched_barrier(0); }
    }
};
struct EpiGateUp {
    static constexpr bool PERM = true, AFTER_DRAIN = false, MID = false;
    unsigned char* HID; const float* rstd_s;
    static constexpr float WSC = 1.f / 64.f, HSC = 16.f;
    __device__ __forceinline__ void operator()(const f32x4 (&acc)[2][2][4][2], const Unit& u, int wr, int wc, int fr, int fq) const {
        const int row0 = u.pm * BM + wr * 64 + fr, col0 = u.pn * 128 + wc * 32 + 8 * fq;
        const __amdgpu_buffer_rsrc_t rsrc = __builtin_amdgcn_make_buffer_rsrc((void*)HID, 0, 40960 * 512, 0x00020000);
        float rsv[2][4];
#pragma unroll
        for (int ai = 0; ai < 2; ++ai)
#pragma unroll
            for (int m = 0; m < 4; ++m) rsv[ai][m] = rstd_s[row0 + ai * HALF + m * 16];
#pragma unroll
        for (int ai = 0; ai < 2; ++ai)
#pragma unroll
            for (int m = 0; m < 4; ++m) { const int row = row0 + ai * HALF + m * 16; const float rs = rsv[ai][m];
                float o[8];
#pragma unroll
                for (int n = 0; n < 2; ++n)
#pragma unroll
                    for (int j = 0; j < 4; ++j) { const float g = acc[ai][0][m][n][j] * rs * WSC, up = acc[ai][1][m][n][j] * rs * WSC;
                        const float sg = __builtin_amdgcn_rcpf(1.f + __builtin_amdgcn_exp2f(-g * 1.4426950408889634f)); o[n * 4 + j] = __builtin_amdgcn_fmed3f(g * sg * up, -28.f, 28.f); }
                typedef unsigned u32x2 __attribute__((ext_vector_type(2)));
                const u32x2 w = {pk_fp8x4(o[0] * HSC, o[1] * HSC, o[2] * HSC, o[3] * HSC), pk_fp8x4(o[4] * HSC, o[5] * HSC, o[6] * HSC, o[7] * HSC)};
                __builtin_amdgcn_raw_buffer_store_b64(w, rsrc, (int)((size_t)row * 512 + col0), 0, 16);
                __builtin_amdgcn_sched_barrier(0); }
    }
};
struct EpiDown {
    static constexpr bool PERM = true, AFTER_DRAIN = false, MID = false;
    unsigned char* YS; const int* rdst; const float* rwt;
    __device__ __forceinline__ void operator()(const f32x4 (&acc)[2][2][4][2], const Unit& u, int wr, int wc, int fr, int fq) const {
        const int row0 = u.pm * BM + wr * 64 + fr, col0 = u.pn * BM + wc * 32 + 8 * fq;
        int dv[2][4]; float wv[2][4];
#pragma unroll
        for (int ai = 0; ai < 2; ++ai)
#pragma unroll
            for (int m = 0; m < 4; ++m) { dv[ai][m] = rdst[row0 + ai * HALF + m * 16]; wv[ai][m] = rwt[row0 + ai * HALF + m * 16]; }
#pragma unroll
        for (int ai = 0; ai < 2; ++ai)
#pragma unroll
            for (int m = 0; m < 4; ++m) { const int d = dv[ai][m]; const float wt = wv[ai][m] * (1.f / 1024.f);
                if (d >= 0) { unsigned char* yr = YS + ((size_t)(d & 1) * 16384 + (size_t)(d >> 1)) * 2048 + col0;
#pragma unroll
                    for (int bj = 0; bj < 2; ++bj) { const f32x4 v0 = acc[ai][bj][m][0] * wt, v1 = acc[ai][bj][m][1] * wt;
                        *(unsigned long long*)(yr + bj * HALF) = (unsigned long long)pk_fp8x4(v0[0], v0[1], v0[2], v0[3]) | ((unsigned long long)pk_fp8x4(v1[0], v1[1], v1[2], v1[3]) << 32); } }
                __builtin_amdgcn_sched_barrier(0); }
    }
};
struct GroupedOrder {
    int ntiles, nN, G, c; const int* tile_expert; const int* rdst;
    __device__ __forceinline__ int arow(int pm, int h, int R) const { const int d = rdst[pm * BM + h * HALF + R]; return d < 0 ? 0 : (d >> 1); }
    __device__ __forceinline__ bool next(int i, Unit& u) const {
        const int L = i * G + c; if (L >= ntiles * nN) return false;
        u.pm = L / nN; u.pn = L % nN; u.koff = 0; u.kh = 1; u.bn = __hip_atomic_load(tile_expert + u.pm, __ATOMIC_RELAXED, __HIP_MEMORY_SCOPE_AGENT) * nN + u.pn; return true;
    }
    __device__ __forceinline__ void a_ready(const Unit&) const {}
    __device__ __forceinline__ void done(const Unit&) const {}
};

struct QueueOrder {
    int ntiles, nN; const int* tile_expert; const int* rdst;
    unsigned* head; PG8_LAS int* slot;
    const unsigned* ready; unsigned need; unsigned* publish; unsigned* tmo;
    __device__ __forceinline__ int arow(int pm, int h, int R) const { const int d = rdst[pm * BM + h * HALF + R]; return d < 0 ? 0 : (d >> 1); }
    __device__ __forceinline__ bool next(int i, Unit& u) const {
        if (threadIdx.x == 0) slot[i & 1] = i == 0 ? (int)blockIdx.x : (int)(__hip_atomic_fetch_add(head, 1u, __ATOMIC_RELAXED, __HIP_MEMORY_SCOPE_AGENT) + gridDim.x);
        asm volatile("s_waitcnt lgkmcnt(0)\n\ts_barrier" ::: "memory");
        const int L = __builtin_amdgcn_readfirstlane(slot[i & 1]);
        const int pm = L / nN;
        const int te = __hip_atomic_load(tile_expert + (pm < MAXROWS / 256 ? pm : 0), __ATOMIC_RELAXED, __HIP_MEMORY_SCOPE_AGENT);
        if (L >= ntiles * nN) return false;
        u.pm = pm; u.pn = L % nN; u.koff = 0; u.kh = 1; u.bn = te * nN + u.pn; return true;
    }
    __device__ __forceinline__ void a_ready(const Unit& u) const {
        if (need == 0u) return;
        if (threadIdx.x < 64) {
            unsigned polls = 0;
            while ((unsigned)__builtin_amdgcn_readfirstlane(__hip_atomic_load(ready + 64 * u.pm, __ATOMIC_RELAXED, __HIP_MEMORY_SCOPE_AGENT)) < need) {
                __builtin_amdgcn_s_sleep(2);
                if ((++polls & 255u) == 0u) { if (__builtin_amdgcn_readfirstlane(__hip_atomic_load(tmo, __ATOMIC_RELAXED, __HIP_MEMORY_SCOPE_AGENT)) != 0u) break;
                    if (polls > (1u << 20)) { if (threadIdx.x == 0) __hip_atomic_store(tmo, 1u, __ATOMIC_RELAXED, __HIP_MEMORY_SCOPE_AGENT); break; } } }
            __builtin_amdgcn_fence(__ATOMIC_ACQUIRE, "agent");
            asm volatile("s_waitcnt vmcnt(0)" ::: "memory");
        }
        asm volatile("" ::: "memory"); __builtin_amdgcn_s_barrier(); asm volatile("" ::: "memory");
    }
    __device__ __forceinline__ void done(const Unit& u) const {
        if (publish == nullptr) return;
        asm volatile("s_waitcnt vmcnt(0)" ::: "memory");
        if ((threadIdx.x & 63) == 0) (void)__hip_atomic_fetch_add(publish + 64 * u.pm, 1u, __ATOMIC_RELAXED, __HIP_MEMORY_SCOPE_AGENT);
    }
};
template <class Epi, class Sched, bool ALIGN_EPI = false, bool SP2 = false, bool FP8 = false>
__device__ __forceinline__ void gemm_phase(PG8_LAS unsigned char* lds, const Gemm g, const Sched& S, const Epi& E) {
    const int tid = threadIdx.x, wid = __builtin_amdgcn_readfirstlane(tid >> 6), lane = tid & 63, wr = wid >> 2, wc = wid & 3, fr = lane & 15, fq = lane >> 4;
    const int K = g.ld, nt = g.K / BK;
    unsigned voffA[2], voffB[2];
#pragma unroll
    for (int i = 0; i < 2; ++i) { int R, C; stage_rc(tid * 16 + i * 8192, R, C); const int Rb = Epi::PERM ? ((R & ~31) + perm32(R & 31)) : R;
        voffA[i] = (unsigned)(R * K + C) * 2u; voffB[i] = (unsigned)(Rb * K + C) * 2u; }
    const size_t kstep = (size_t)(BK * 2);
    const size_t hstep = (size_t)HALF * K * 2;
    const size_t tstep = 2 * hstep;
    const unsigned ldsw = (unsigned)wid * 1024u;
    const int aoff = lds_byte(wr * 64 + fr, fq * 8), boff = lds_byte(wc * 32 + fr, fq * 8);
#define PG8_SA(b, h) (((b) * 2 + (h)) * HTB)
#define PG8_SB(b, h) ((4 + (b) * 2 + (h)) * HTB)
#define PG8_STAGE(bufoff, gbase, voff) do { _Pragma("unroll") for (int _i = 0; _i < 2; ++_i) \
        __builtin_amdgcn_global_load_lds((const unsigned*)((const char*)(gbase) + (voff)[_i]), (PG8_LAS unsigned*)(lds + (bufoff) + ldsw + _i * 8192), 16, 0, 0); } while (0)
#define PG8_LDA(dst, b, h) do { _Pragma("unroll") for (int m = 0; m < 4; ++m) { FragT<FP8>::ld(dst[m], lds + PG8_SA(b, h) + aoff + m * 2048); } } while (0)
#define PG8_LDB(dst, b, h) do { _Pragma("unroll") for (int n = 0; n < 2; ++n) { FragT<FP8>::ld(dst[n], lds + PG8_SB(b, h) + boff + n * 2048); } } while (0)
#define PG8_MMA(ai, bj, At, Bt) do { __builtin_amdgcn_s_setprio(1); _Pragma("unroll") for (int m = 0; m < 4; ++m) _Pragma("unroll") for (int n = 0; n < 2; ++n) { \
        FragT<FP8>::mma(acc[ai][bj][m][n], Bt[n], At[m]); } \
        __builtin_amdgcn_s_setprio(0); } while (0)
#define PG8_WAIT_V(n) asm volatile("s_waitcnt vmcnt(" #n ")" ::: "memory")
#define PG8_WAIT_L(n) asm volatile("s_waitcnt lgkmcnt(" #n ")" ::: "memory")
#define PG8_BAR __builtin_amdgcn_s_barrier()
#define PG8_SCHED __builtin_amdgcn_sched_barrier(0)
    Unit cur, nxt; int ui = 0;
    if (!S.next(0, cur)) return;
    f32x4 acc[2][2][4][2];
#pragma unroll
    for (int a = 0; a < 2; ++a)
#pragma unroll
        for (int b = 0; b < 2; ++b)
#pragma unroll
            for (int m = 0; m < 4; ++m)
#pragma unroll
                for (int n = 0; n < 2; ++n) acc[a][b][m][n] = (f32x4){0.f, 0.f, 0.f, 0.f};
    typename FragT<FP8>::type At[4], B0[2], B1[2];
    const char* cA = (const char*)g.A + (size_t)cur.pm * tstep + (size_t)cur.koff * 2; const char* cB = (const char*)g.Bt + (size_t)cur.bn * tstep + (size_t)cur.koff * 2;
    S.a_ready(cur);
    if constexpr (SP2) {
        PG8_STAGE(PG8_SB(0, 0), cB, voffB); PG8_STAGE(PG8_SB(0, 1), cB + hstep, voffB); PG8_STAGE(PG8_SA(0, 0), cA, voffA); PG8_STAGE(PG8_SA(0, 1), cA + hstep, voffA);
        if (wr == 1) PG8_BAR;
        PG8_WAIT_V(2); PG8_BAR;
        PG8_STAGE(PG8_SB(1, 0), cB + kstep, voffB); PG8_STAGE(PG8_SA(1, 0), cA + kstep, voffA); PG8_STAGE(PG8_SB(1, 1), cB + hstep + kstep, voffB);
        PG8_WAIT_V(6); PG8_BAR;
    } else {
        PG8_STAGE(PG8_SB(0, 0), cB, voffB); PG8_STAGE(PG8_SA(0, 0), cA, voffA); PG8_STAGE(PG8_SB(0, 1), cB + hstep, voffB); PG8_STAGE(PG8_SA(0, 1), cA + hstep, voffA);
        if (wr == 1) PG8_BAR;
        PG8_WAIT_V(4); PG8_BAR;
        PG8_STAGE(PG8_SB(1, 0), cB + kstep, voffB); PG8_STAGE(PG8_SA(1, 0), cA + kstep, voffA); PG8_STAGE(PG8_SB(1, 1), cB + hstep + kstep, voffB);
        PG8_WAIT_V(6); PG8_BAR;
    }
    for (;;) {
        const bool has_next = S.next(ui + 1, nxt);
        const char* nA = has_next ? (const char*)g.A + (size_t)nxt.pm * tstep + (size_t)nxt.koff * 2 : cA; const char* nB = has_next ? (const char*)g.Bt + (size_t)nxt.bn * tstep + (size_t)nxt.koff * 2 : cB;
#pragma unroll 1
        for (int t = 0; t < nt; t += 2) {
            const bool last = (t == nt - 2);
            const char* a1 = cA + (size_t)(t + 1) * kstep;
            const char* a2 = last ? nA : cA + (size_t)(t + 2) * kstep; const char* b2 = last ? nB : cB + (size_t)(t + 2) * kstep;
            const char* a3 = a2 + kstep; const char* b3 = b2 + kstep;
            if (last && has_next) S.a_ready(nxt);
            if constexpr (SP2) {
            PG8_LDB(B0, 0, 0); PG8_LDB(B1, 0, 1); PG8_SCHED; PG8_LDA(At, 0, 0); PG8_STAGE(PG8_SA(1, 1), a1 + hstep, voffA);
            PG8_WAIT_V(8); PG8_WAIT_L(0); PG8_BAR; PG8_MMA(0, 0, At, B0); PG8_MMA(0, 1, At, B1); PG8_BAR; PG8_SCHED;
            PG8_LDA(At, 0, 1); PG8_STAGE(PG8_SB(0, 0), b2, voffB); PG8_STAGE(PG8_SB(0, 1), b2 + hstep, voffB); PG8_STAGE(PG8_SA(0, 0), a2, voffA);
            PG8_WAIT_V(8); PG8_WAIT_L(0); PG8_BAR; PG8_MMA(1, 0, At, B0); PG8_MMA(1, 1, At, B1); PG8_BAR; PG8_SCHED;
            PG8_LDB(B0, 1, 0); PG8_LDB(B1, 1, 1); PG8_SCHED; PG8_LDA(At, 1, 0); PG8_STAGE(PG8_SA(0, 1), a2 + hstep, voffA);
            PG8_WAIT_V(8); PG8_WAIT_L(0); PG8_BAR; PG8_MMA(0, 0, At, B0); PG8_MMA(0, 1, At, B1); PG8_BAR; PG8_SCHED;
            PG8_LDA(At, 1, 1); PG8_STAGE(PG8_SB(1, 0), b3, voffB); PG8_STAGE(PG8_SB(1, 1), b3 + hstep, voffB); PG8_STAGE(PG8_SA(1, 0), a3, voffA);
            PG8_WAIT_V(8); PG8_WAIT_L(0); PG8_BAR; PG8_MMA(1, 0, At, B0); PG8_MMA(1, 1, At, B1); PG8_BAR; PG8_SCHED;
            } else {
            PG8_LDB(B0, 0, 0); PG8_SCHED; PG8_LDA(At, 0, 0); PG8_STAGE(PG8_SA(1, 1), a1 + hstep, voffA);
            PG8_WAIT_L(8); PG8_BAR; PG8_WAIT_L(0); PG8_MMA(0, 0, At, B0); PG8_BAR; PG8_SCHED;
            PG8_LDB(B1, 0, 1); PG8_STAGE(PG8_SB(0, 0), b2, voffB);
            PG8_BAR; PG8_WAIT_L(0); PG8_MMA(0, 1, At, B1); PG8_BAR;
            PG8_LDA(At, 0, 1); PG8_STAGE(PG8_SA(0, 0), a2, voffA);
            PG8_BAR; PG8_WAIT_L(0); PG8_MMA(1, 0, At, B0); PG8_BAR; PG8_SCHED;
            PG8_STAGE(PG8_SB(0, 1), b2 + hstep, voffB);
            PG8_WAIT_V(6); PG8_BAR; PG8_MMA(1, 1, At, B1); PG8_BAR;
            PG8_LDB(B0, 1, 0); PG8_SCHED; PG8_LDA(At, 1, 0); PG8_STAGE(PG8_SA(0, 1), a2 + hstep, voffA);
            PG8_WAIT_L(8); PG8_BAR; PG8_WAIT_L(0); PG8_MMA(0, 0, At, B0); PG8_BAR; PG8_SCHED;
            PG8_LDB(B1, 1, 1); PG8_STAGE(PG8_SB(1, 0), b3, voffB);
            PG8_BAR; PG8_WAIT_L(0); PG8_MMA(0, 1, At, B1); PG8_BAR;
            PG8_LDA(At, 1, 1); PG8_STAGE(PG8_SA(1, 0), a3, voffA);
            PG8_BAR; PG8_WAIT_L(0); PG8_MMA(1, 0, At, B0); PG8_BAR; PG8_SCHED;
            PG8_STAGE(PG8_SB(1, 1), b3 + hstep, voffB);
            PG8_WAIT_V(6); PG8_BAR; PG8_MMA(1, 1, At, B1); PG8_BAR;
            }
        }
        if constexpr (FP8) asm volatile("s_nop 15\n\ts_nop 7" ::: "memory");
        bool keep = false;
        if constexpr (Epi::MID) keep = (cur.kh == 0);
        if constexpr (ALIGN_EPI) { if (wr == 0 && !keep) PG8_BAR; }
        if constexpr (Epi::MID) { if (keep) E.mid(acc, cur, wr, wc, fr, fq); }
        if constexpr (!Epi::AFTER_DRAIN) { if (!keep) { E(acc, cur, wr, wc, fr, fq); S.done(cur); } }
        if (!has_next) break;
        if (!keep) {
#pragma unroll
        for (int a = 0; a < 2; ++a)
#pragma unroll
            for (int b = 0; b < 2; ++b)
#pragma unroll
                for (int m = 0; m < 4; ++m)
#pragma unroll
                    for (int n = 0; n < 2; ++n) acc[a][b][m][n] = (f32x4){0.f, 0.f, 0.f, 0.f}; }
        cur = nxt; cA = nA; cB = nB; ++ui;
        if constexpr (ALIGN_EPI) { if (wr == 1 && !keep) PG8_BAR; }
    }
    PG8_WAIT_V(0);
    if constexpr (!ALIGN_EPI) { if (wr == 0) PG8_BAR; }
    PG8_BAR;
    if constexpr (Epi::AFTER_DRAIN) { E.fused(acc, cur, wr, wc, fr, fq, lds, wid, lane); S.done(cur); }
#undef PG8_SA
#undef PG8_SB
#undef PG8_STAGE
#undef PG8_LDA
#undef PG8_LDB
#undef PG8_MMA
#undef PG8_WAIT_V
#undef PG8_WAIT_L
#undef PG8_BAR
#undef PG8_SCHED
}
template <class Epi, class Sched, bool ALIGN_EPI = false, bool SP2 = false, bool FP8 = false>
__device__ __forceinline__ void gemm_phase_g(PG8_LAS unsigned char* lds, const Gemm g, const Sched& S, const Epi& E) {
    const int tid = threadIdx.x, wid = __builtin_amdgcn_readfirstlane(tid >> 6), lane = tid & 63, wr = wid >> 2, wc = wid & 3, fr = lane & 15, fq = lane >> 4;
    const int K = g.ld, nt = g.K / BK;
    unsigned voffA[2], voffB[2];
#pragma unroll
    for (int i = 0; i < 2; ++i) { int R, C; stage_rc(tid * 16 + i * 8192, R, C); const int Rb = Epi::PERM ? ((R & ~31) + perm32(R & 31)) : R;
        voffA[i] = (unsigned)(R * K + C) * 2u; voffB[i] = (unsigned)(Rb * K + C) * 2u; }
    unsigned vAc[2][2], vAn[2][2];
#define PG8_AOFF(dst, u) do { _Pragma("unroll") for (int _h = 0; _h < 2; ++_h) _Pragma("unroll") for (int _i = 0; _i < 2; ++_i) { int R, C; stage_rc(tid * 16 + _i * 8192, R, C); \
        dst[_h][_i] = (unsigned)(S.arow((u).pm, _h, R) * K + C) * 2u; } } while (0)
    const size_t kstep = (size_t)(BK * 2);
    const size_t hstep = (size_t)HALF * K * 2;
    const size_t tstep = 2 * hstep;
    const unsigned ldsw = (unsigned)wid * 1024u;
    const int aoff = lds_byte(wr * 64 + fr, fq * 8), boff = lds_byte(wc * 32 + fr, fq * 8);
#define PG8_SA(b, h) (((b) * 2 + (h)) * HTB)
#define PG8_SB(b, h) ((4 + (b) * 2 + (h)) * HTB)
#define PG8_STAGE(bufoff, gbase, voff) do { _Pragma("unroll") for (int _i = 0; _i < 2; ++_i) \
        __builtin_amdgcn_global_load_lds((const unsigned*)((const char*)(gbase) + (voff)[_i]), (PG8_LAS unsigned*)(lds + (bufoff) + ldsw + _i * 8192), 16, 0, 0); } while (0)
#define PG8_LDA(dst, b, h) do { _Pragma("unroll") for (int m = 0; m < 4; ++m) { FragT<FP8>::ld(dst[m], lds + PG8_SA(b, h) + aoff + m * 2048); } } while (0)
#define PG8_LDB(dst, b, h) do { _Pragma("unroll") for (int n = 0; n < 2; ++n) { FragT<FP8>::ld(dst[n], lds + PG8_SB(b, h) + boff + n * 2048); } } while (0)
#define PG8_MMA(ai, bj, At, Bt) do { __builtin_amdgcn_s_setprio(1); _Pragma("unroll") for (int m = 0; m < 4; ++m) _Pragma("unroll") for (int n = 0; n < 2; ++n) { \
        FragT<FP8>::mma(acc[ai][bj][m][n], Bt[n], At[m]); } \
        __builtin_amdgcn_s_setprio(0); } while (0)
#define PG8_WAIT_V(n) asm volatile("s_waitcnt vmcnt(" #n ")" ::: "memory")
#define PG8_WAIT_L(n) asm volatile("s_waitcnt lgkmcnt(" #n ")" ::: "memory")
#define PG8_BAR __builtin_amdgcn_s_barrier()
#define PG8_SCHED __builtin_amdgcn_sched_barrier(0)
    Unit cur, nxt; int ui = 0;
    if (!S.next(0, cur)) return;
    f32x4 acc[2][2][4][2];
#pragma unroll
    for (int a = 0; a < 2; ++a)
#pragma unroll
        for (int b = 0; b < 2; ++b)
#pragma unroll
            for (int m = 0; m < 4; ++m)
#pragma unroll
                for (int n = 0; n < 2; ++n) acc[a][b][m][n] = (f32x4){0.f, 0.f, 0.f, 0.f};
    typename FragT<FP8>::type At[4], B0[2], B1[2];
    PG8_AOFF(vAc, cur);
    const char* cA = (const char*)g.A; const char* cB = (const char*)g.Bt + (size_t)cur.bn * tstep;
    S.a_ready(cur);
    if constexpr (SP2) {
        PG8_STAGE(PG8_SB(0, 0), cB, voffB); PG8_STAGE(PG8_SB(0, 1), cB + hstep, voffB); PG8_STAGE(PG8_SA(0, 0), cA, vAc[0]); PG8_STAGE(PG8_SA(0, 1), cA, vAc[1]);
        if (wr == 1) PG8_BAR;
        PG8_WAIT_V(2); PG8_BAR;
        PG8_STAGE(PG8_SB(1, 0), cB + kstep, voffB); PG8_STAGE(PG8_SA(1, 0), cA + kstep, vAc[0]); PG8_STAGE(PG8_SB(1, 1), cB + hstep + kstep, voffB);
        PG8_WAIT_V(6); PG8_BAR;
    } else {
        PG8_STAGE(PG8_SB(0, 0), cB, voffB); PG8_STAGE(PG8_SA(0, 0), cA, vAc[0]); PG8_STAGE(PG8_SB(0, 1), cB + hstep, voffB); PG8_STAGE(PG8_SA(0, 1), cA, vAc[1]);
        if (wr == 1) PG8_BAR;
        PG8_WAIT_V(4); PG8_BAR;
        PG8_STAGE(PG8_SB(1, 0), cB + kstep, voffB); PG8_STAGE(PG8_SA(1, 0), cA + kstep, vAc[0]); PG8_STAGE(PG8_SB(1, 1), cB + hstep + kstep, voffB);
        PG8_WAIT_V(6); PG8_BAR;
    }
    for (;;) {
        const bool has_next = S.next(ui + 1, nxt);
        if (has_next) PG8_AOFF(vAn, nxt); else { _Pragma("unroll") for (int _h = 0; _h < 2; ++_h) _Pragma("unroll") for (int _i = 0; _i < 2; ++_i) vAn[_h][_i] = vAc[_h][_i]; }
        const char* nA = cA; const char* nB = has_next ? (const char*)g.Bt + (size_t)nxt.bn * tstep : cB;
#pragma unroll 1
        for (int t = 0; t < nt; t += 2) {
            const bool last = (t == nt - 2);
            const char* a1 = cA + (size_t)(t + 1) * kstep;
            const char* a2 = last ? nA : cA + (size_t)(t + 2) * kstep; const char* b2 = last ? nB : cB + (size_t)(t + 2) * kstep;
            const char* a3 = a2 + kstep; const char* b3 = b2 + kstep;
            unsigned vs0[2], vs1[2]; vs0[0] = last ? vAn[0][0] : vAc[0][0]; vs0[1] = last ? vAn[0][1] : vAc[0][1]; vs1[0] = last ? vAn[1][0] : vAc[1][0]; vs1[1] = last ? vAn[1][1] : vAc[1][1];
            if (last && has_next) S.a_ready(nxt);
            if constexpr (SP2) {
            PG8_LDB(B0, 0, 0); PG8_LDB(B1, 0, 1); PG8_SCHED; PG8_LDA(At, 0, 0); PG8_STAGE(PG8_SA(1, 1), a1, vAc[1]);
            PG8_WAIT_V(8); PG8_WAIT_L(0); PG8_BAR; PG8_MMA(0, 0, At, B0); PG8_MMA(0, 1, At, B1); PG8_BAR; PG8_SCHED;
            PG8_LDA(At, 0, 1); PG8_STAGE(PG8_SB(0, 0), b2, voffB); PG8_STAGE(PG8_SB(0, 1), b2 + hstep, voffB); PG8_STAGE(PG8_SA(0, 0), a2, vs0);
            PG8_WAIT_V(8); PG8_WAIT_L(0); PG8_BAR; PG8_MMA(1, 0, At, B0); PG8_MMA(1, 1, At, B1); PG8_BAR; PG8_SCHED;
            PG8_LDB(B0, 1, 0); PG8_LDB(B1, 1, 1); PG8_SCHED; PG8_LDA(At, 1, 0); PG8_STAGE(PG8_SA(0, 1), a2, vs1);
            PG8_WAIT_V(8); PG8_WAIT_L(0); PG8_BAR; PG8_MMA(0, 0, At, B0); PG8_MMA(0, 1, At, B1); PG8_BAR; PG8_SCHED;
            PG8_LDA(At, 1, 1); PG8_STAGE(PG8_SB(1, 0), b3, voffB); PG8_STAGE(PG8_SB(1, 1), b3 + hstep, voffB); PG8_STAGE(PG8_SA(1, 0), a3, vs0);
            PG8_WAIT_V(8); PG8_WAIT_L(0); PG8_BAR; PG8_MMA(1, 0, At, B0); PG8_MMA(1, 1, At, B1); PG8_BAR; PG8_SCHED;
            } else {
            PG8_LDB(B0, 0, 0); PG8_SCHED; PG8_LDA(At, 0, 0); PG8_STAGE(PG8_SA(1, 1), a1, vAc[1]);
            PG8_WAIT_L(8); PG8_BAR; PG8_WAIT_L(0); PG8_MMA(0, 0, At, B0); PG8_BAR; PG8_SCHED;
            PG8_LDB(B1, 0, 1); PG8_STAGE(PG8_SB(0, 0), b2, voffB);
            PG8_BAR; PG8_WAIT_L(0); PG8_MMA(0, 1, At, B1); PG8_BAR;
            PG8_LDA(At, 0, 1); PG8_STAGE(PG8_SA(0, 0), a2, vs0);
            PG8_BAR; PG8_WAIT_L(0); PG8_MMA(1, 0, At, B0); PG8_BAR; PG8_SCHED;
            PG8_STAGE(PG8_SB(0, 1), b2 + hstep, voffB);
            PG8_WAIT_V(6); PG8_BAR; PG8_MMA(1, 1, At, B1); PG8_BAR;
            PG8_LDB(B0, 1, 0); PG8_SCHED; PG8_LDA(At, 1, 0); PG8_STAGE(PG8_SA(0, 1), a2, vs1);
            PG8_WAIT_L(8); PG8_BAR; PG8_WAIT_L(0); PG8_MMA(0, 0, At, B0); PG8_BAR; PG8_SCHED;
            PG8_LDB(B1, 1, 1); PG8_STAGE(PG8_SB(1, 0), b3, voffB);
            PG8_BAR; PG8_WAIT_L(0); PG8_MMA(0, 1, At, B1); PG8_BAR;
            PG8_LDA(At, 1, 1); PG8_STAGE(PG8_SA(1, 0), a3, vs0);
            PG8_BAR; PG8_WAIT_L(0); PG8_MMA(1, 0, At, B0); PG8_BAR; PG8_SCHED;
            PG8_STAGE(PG8_SB(1, 1), b3 + hstep, voffB);
            PG8_WAIT_V(6); PG8_BAR; PG8_MMA(1, 1, At, B1); PG8_BAR;
            }
        }
        if constexpr (ALIGN_EPI) { if (wr == 0) PG8_BAR; }
        if constexpr (FP8) asm volatile("s_nop 15\n\ts_nop 7" ::: "memory");
        if constexpr (!Epi::AFTER_DRAIN) { E(acc, cur, wr, wc, fr, fq); S.done(cur); }
        if (!has_next) break;
#pragma unroll
        for (int a = 0; a < 2; ++a)
#pragma unroll
            for (int b = 0; b < 2; ++b)
#pragma unroll
                for (int m = 0; m < 4; ++m)
#pragma unroll
                    for (int n = 0; n < 2; ++n) acc[a][b][m][n] = (f32x4){0.f, 0.f, 0.f, 0.f};
        cur = nxt; cA = nA; cB = nB; ++ui;
        _Pragma("unroll") for (int _h = 0; _h < 2; ++_h) _Pragma("unroll") for (int _i = 0; _i < 2; ++_i) vAc[_h][_i] = vAn[_h][_i];
        if constexpr (ALIGN_EPI) { if (wr == 1) PG8_BAR; }
    }
    PG8_WAIT_V(0);
    if constexpr (!ALIGN_EPI) { if (wr == 0) PG8_BAR; }
    PG8_BAR;
    if constexpr (Epi::AFTER_DRAIN) { E.fused(acc, cur, wr, wc, fr, fq, lds, wid, lane); S.done(cur); }
#undef PG8_AOFF
#undef PG8_SA
#undef PG8_SB
#undef PG8_STAGE
#undef PG8_LDA
#undef PG8_LDB
#undef PG8_MMA
#undef PG8_WAIT_V
#undef PG8_WAIT_L
#undef PG8_BAR
#undef PG8_SCHED
}
}

#define GAS __attribute__((address_space(1)))
#define LAS __attribute__((address_space(3)))
typedef unsigned short bf16;
typedef unsigned v4u __attribute__((ext_vector_type(4)));
typedef float f32x4 __attribute__((ext_vector_type(4)));
typedef short bf16x8 __attribute__((ext_vector_type(8)));
typedef GAS unsigned gu32;
#define RLX_AGENT __ATOMIC_RELAXED, __HIP_MEMORY_SCOPE_AGENT
#define LDS_WAIT() asm volatile("s_waitcnt lgkmcnt(0)" ::: "memory")
#define VM_WAIT() asm volatile("s_waitcnt vmcnt(0)" ::: "memory")
__device__ __forceinline__ unsigned f2bf(float f) { unsigned u = __builtin_bit_cast(unsigned, f); return (u + 0x7fffu + ((u >> 16) & 1u)) >> 16; }
__device__ __forceinline__ unsigned pk2(float lo, float hi) { return f2bf(lo) | (f2bf(hi) << 16); }
__device__ __forceinline__ float bf2f(unsigned short b) { return __builtin_bit_cast(float, (unsigned)b << 16); }
__device__ __forceinline__ float bflo(unsigned w) { return __builtin_bit_cast(float, w << 16); }
__device__ __forceinline__ float bfhi(unsigned w) { return __builtin_bit_cast(float, w & 0xffff0000u); }
__device__ __forceinline__ int ld_i32(const int* p) { return __hip_atomic_load(p, __ATOMIC_RELAXED, __HIP_MEMORY_SCOPE_AGENT); }
__device__ __forceinline__ float wave_sum(float v) {
#pragma unroll
    for (int o = 1; o < 64; o <<= 1) v += __shfl_xor(v, o);
    return v;
}
__device__ __forceinline__ float wave_max(float v) {
#pragma unroll
    for (int o = 1; o < 64; o <<= 1) v = fmaxf(v, __shfl_xor(v, o));
    return v;
}
__device__ const unsigned char T5B[128] = {0,1,2,3,4,5,6,7,8,9,10,11,12,13,14,15,16,16,16,17,17,18,18,18,19,19,19,20,20,20,20,21,21,21,21,22,22,22,22,22,23,23,23,23,23,23,24,24,24,24,24,24,25,25,25,25,25,25,25,26,26,26,26,26,26,26,26,27,27,27,27,27,27,27,27,27,27,28,28,28,28,28,28,28,28,28,28,29,29,29,29,29,29,29,29,29,29,29,29,30,30,30,30,30,30,30,30,30,30,30,30,30,30,31,31,31,31,31,31,31,31,31,31,31,31,31,31,31};
__device__ __forceinline__ int t5_bucket(int dist) { return dist >= 128 ? 31 : (int)T5B[dist < 0 ? 0 : dist]; }
#define XB_TMO      128
#define XB_XCNT(j)  (256  + 64 * (j))
#define XB_XSUB(j)  (1280 + 64 * (j))
#define XB_XGEN(j)  (2304 + 64 * (j))
#define XB_TOP      3328
#define XB_TOPGEN   3392
#define XCD_BAR_WORDS 3456
#define XB_SPIN_CAP (1u << 18)

__device__ __forceinline__ unsigned xb_ld(unsigned* p)              { return __hip_atomic_load(p, __ATOMIC_RELAXED, __HIP_MEMORY_SCOPE_AGENT); }
__device__ __forceinline__ unsigned xb_add(unsigned* p, unsigned v) { return __hip_atomic_fetch_add(p, v, __ATOMIC_RELAXED, __HIP_MEMORY_SCOPE_AGENT); }
__device__ __forceinline__ unsigned xb_xcc_id() { return (unsigned)__builtin_amdgcn_s_getreg((3 << 11) | 20) & 0xFu; }
#define XB_SPIN(cond, bar) do { unsigned _sp = 0; while (cond) { __builtin_amdgcn_s_sleep(1); \
    if ((++_sp & 255u) == 0u) { if (xb_ld(&(bar)[XB_TMO])) break; if (_sp > XB_SPIN_CAP) { atomicAdd(&(bar)[XB_TMO], 1u); break; } } } } while (0)

struct XcdBarrier {
    unsigned* bar; unsigned x;
    volatile LAS unsigned* st;
};

__device__ __forceinline__ XcdBarrier xcd_barrier_post(unsigned* bar, volatile LAS unsigned* st) {
    XcdBarrier b; b.bar = bar; b.x = xb_xcc_id(); b.st = st;
    if (threadIdx.x == 0) (void)xb_add(&bar[XB_XCNT(b.x)], 1u);
    return b;
}
__device__ __forceinline__ void xcd_barrier_complete(unsigned* bar, unsigned x, unsigned& nloc, unsigned& nx) {
    const unsigned G = gridDim.x * gridDim.y * gridDim.z;
    unsigned sum, cnt, mine, sp = 0u;
    for (;;) {
        sum = 0u; cnt = 0u; mine = 0u;
#pragma unroll
        for (unsigned j = 0; j < 16; ++j) { const unsigned c = xb_ld(&bar[XB_XCNT(j)]); sum += c; cnt += (c > 0u) ? 1u : 0u; mine = (j == x) ? c : mine; }
        if (sum == G) break;
        __builtin_amdgcn_s_sleep(1);
        if ((++sp & 255u) == 0u) { if (xb_ld(&bar[XB_TMO])) break; if (sp > XB_SPIN_CAP) { atomicAdd(&bar[XB_TMO], 1u); break; } }
    }
    nloc = mine > 0u ? mine : 1u; nx = cnt > 0u ? cnt : 1u;
}

__device__ __forceinline__ void xcd_barrier(const XcdBarrier& b) {
    asm volatile("s_waitcnt vmcnt(0)" ::: "memory");
    __syncthreads();
    if (threadIdx.x == 0) {
        unsigned* bar = b.bar;
        __builtin_amdgcn_s_waitcnt(0);
        unsigned nloc = b.st[0], nx = b.st[1];
        if (nloc == 0u) { xcd_barrier_complete(bar, b.x, nloc, nx); b.st[0] = nloc; b.st[1] = nx; }
        const unsigned old = xb_add(&bar[XB_XSUB(b.x)], 1u);
        const unsigned gen = old / nloc;
        if (old + 1u == (gen + 1u) * nloc) {
            __builtin_amdgcn_fence(__ATOMIC_RELEASE, "agent");
            asm volatile("s_waitcnt vmcnt(0)" ::: "memory");
            const unsigned og = xb_add(&bar[XB_TOP], 1u);
            const unsigned tg = og / nx;
            if (og + 1u == (tg + 1u) * nx) xb_add(&bar[XB_TOPGEN], 1u);
            else XB_SPIN(xb_ld(&bar[XB_TOPGEN]) == tg, bar);
            __builtin_amdgcn_fence(__ATOMIC_ACQUIRE, "agent");
            xb_add(&bar[XB_XGEN(b.x)], 1u);
            asm volatile("s_waitcnt vmcnt(0)" ::: "memory");
        } else {
            XB_SPIN(xb_ld(&bar[XB_XGEN(b.x)]) == gen, bar);
            __builtin_amdgcn_fence(__ATOMIC_ACQUIRE, "agent");
            asm volatile("s_waitcnt vmcnt(0)" ::: "memory");
        }
    }
    __syncthreads();
}

#define WSYNC() asm volatile("s_waitcnt lgkmcnt(0)" ::: "memory")
constexpr int WSCR = 18432;
__device__ __forceinline__ float log_sigmoid(float x) { return fminf(x, 0.f) - log1pf(expf(-fabsf(x))); }
__device__ __forceinline__ float sigmoidf_(float x) { return 1.f / (1.f + expf(-x)); }

__device__ __forceinline__ void compress_item(int item, int lane, LAS float* scr, const bf16* PROJ, const float* pe_k, const float* pe_v, const float* w1k, const float* w2k, const float* w1v, const float* w2v, bf16* KC, bf16* VC) {
    const int kv = item & 1, g = (item >> 1) & 3, bc = item >> 3, c = bc & 127, b = bc >> 7;
    bf16* dst = (kv ? VC : KC) + ((size_t)(b * 128 + c) * 4 + g) * 64;
    if (c == 127) { dst[lane] = 0; return; }
    const float* pe = kv ? pe_v : pe_k; const float* w1 = kv ? w1v : w1k; const float* w2 = kv ? w2v : w2k;
    const int colbase = (kv ? C_VCMP : C_KCMP) + g * 64;
    LAS float* xin = scr; LAS float* hid = scr + 2048;
    for (int l = 0; l < 32; ++l) xin[l * 64 + lane] = bf2f(PROJ[(size_t)(b * 2048 + 16 * c + l) * NPROJ + colbase + lane]) + pe[l * 64 + lane];
    WSYNC();
    float s0 = 0.f, s1 = 0.f;
#pragma unroll 8
    for (int i = 0; i < 2048; ++i) { const float x = xin[i]; s0 += x * w1[(size_t)i * 128 + lane]; s1 += x * w1[(size_t)i * 128 + 64 + lane]; }
    hid[lane] = s0 / (1.f + expf(-s0)); hid[64 + lane] = s1 / (1.f + expf(-s1));
    WSYNC();
    float o = 0.f;
#pragma unroll 8
    for (int j = 0; j < 128; ++j) o += hid[j] * w2[j * 64 + lane];
    dst[lane] = (bf16)f2bf(o);
    WSYNC();
}

__device__ __forceinline__ void compress_mfma(int wg, int tid, int lane, int wave, LAS float* part, LAS float* hid, const bf16* PROJ, const bf16* W1T, const float* B1, const float* w2k, const float* w2v, bf16* KC, bf16* VC) {
    typedef float f32x16 __attribute__((ext_vector_type(16)));
    const int kv = wg / 127, blk = wg % 127; const int r32 = lane & 31, hi = lane >> 5;
    const int colbase = kv ? C_VCMP : C_KCMP;
    f32x4 w2r[4];
    { const f32x4* w2g = (const f32x4*)(kv ? w2v : w2k) + tid * 4;
#pragma unroll
        for (int i = 0; i < 4; ++i) w2r[i] = w2g[i]; }
    { const int rho = blk * 32 + r32; const int g = rho & 3, bc = rho >> 2, c = bc % 127, b = bc / 127;
        const bf16* arow = PROJ + (size_t)(b * 2048 + 16 * c + 4 * wave) * NPROJ + colbase + g * 64 + hi * 8;
        const bf16* brow = W1T + (size_t)(kv * 8 + wave) * 32768 + lane * 8;
        f32x16 acc[4];
#pragma unroll
        for (int j = 0; j < 4; ++j)
#pragma unroll
            for (int r = 0; r < 16; ++r) acc[j][r] = 0.f;
#pragma unroll 4
        for (int s = 0; s < 16; ++s) {
            const bf16x8 A = *(const bf16x8*)(arow + (size_t)(s >> 2) * NPROJ + (s & 3) * 16);
            bf16x8 B[4];
#pragma unroll
            for (int j = 0; j < 4; ++j) B[j] = *(const bf16x8*)(brow + s * 2048 + j * 512);
#pragma unroll
            for (int j = 0; j < 4; ++j) acc[j] = __builtin_amdgcn_mfma_f32_32x32x16_bf16(A, B[j], acc[j], 0, 0, 0);
        }
        LAS float* pw = part + wave * 4096;
#pragma unroll
        for (int j = 0; j < 4; ++j)
#pragma unroll
            for (int r = 0; r < 16; ++r) pw[((r & 3) + 8 * (r >> 2) + 4 * hi) * 128 + 32 * j + r32] = acc[j][r];
    }
    __syncthreads();
    for (int i = tid; i < 4096; i += 512) { float s = B1[kv * 128 + (i & 127)];
#pragma unroll
        for (int w = 0; w < 8; ++w) s += part[w * 4096 + i];
        hid[i] = s / (1.f + __expf(-s)); }
    __syncthreads();
    { LAS f32x4* w2l = (LAS f32x4*)part + tid * 4;
#pragma unroll
        for (int i = 0; i < 4; ++i) w2l[i] = w2r[i]; }
    __syncthreads();
    { const int row = tid >> 4, d4 = (tid & 15) * 4; f32x4 o = {0.f, 0.f, 0.f, 0.f};
#pragma unroll 8
        for (int j = 0; j < 128; ++j) { const float hv = hid[row * 128 + j]; const f32x4 w = *(const LAS f32x4*)(part + j * 64 + d4); o += w * hv; }
        const int rho = blk * 32 + row; const int g = rho & 3, bc = rho >> 2, c = bc % 127, b = bc / 127;
        bf16* dst = (kv ? VC : KC) + ((size_t)(b * 128 + c) * 4 + g) * 64 + d4;
        *(unsigned long long*)dst = (unsigned long long)pk2(o[0], o[1]) | ((unsigned long long)pk2(o[2], o[3]) << 32); }
    __syncthreads();
}
__device__ __forceinline__ float log_sigmoid_fast(float x) { return fminf(x, 0.f) - __logf(1.f + __expf(-fabsf(x))); }
__device__ __forceinline__ void cumsum_wg(int bh, int wave, int lane, const float* GF, const float* fb, float* CUM, LAS float* tot) {
    const int b = bh >> 4, h = bh & 15; const float bias = fb[h]; const int t0 = wave * 256 + lane * 4;
    float v[4];
#pragma unroll
    for (int i = 0; i < 4; ++i) v[i] = GF[(size_t)(b * 2048 + t0 + i) * 64 + 48 + h];
    float s = 0.f;
#pragma unroll
    for (int i = 0; i < 4; ++i) { s += log_sigmoid_fast(v[i] + bias); v[i] = s; }
    float incl = s;
#pragma unroll
    for (int o = 1; o < 64; o <<= 1) { const float u = __shfl_up(incl, o); if (lane >= o) incl += u; }
    if (lane == 63) tot[wave] = incl;
    __syncthreads();
    float ex = incl - s;
    for (int w = 0; w < wave; ++w) ex += tot[w];
    *(f32x4*)(CUM + (size_t)bh * 2048 + t0) = (f32x4){(ex + v[0]) * LOG2E, (ex + v[1]) * LOG2E, (ex + v[2]) * LOG2E, (ex + v[3]) * LOG2E};
}
__device__ __forceinline__ void knorm_item(int item, int lane, const bf16* PROJ, unsigned* KN2) {
    const int bh = item >> 4, ch = item & 15, b = bh >> 4, h = bh & 15; float mx = 0.f;
    const bf16* base = PROJ + (size_t)(b * 2048 + ch * 128 + (lane >> 3)) * NPROJ + C_FK + h * 64 + (lane & 7) * 8;
#pragma unroll 8
    for (int i = 0; i < 16; ++i) { const v4u w = *(const v4u*)(base + (size_t)i * 8 * NPROJ);
        float s = bflo(w.x) * bflo(w.x) + bfhi(w.x) * bfhi(w.x) + bflo(w.y) * bflo(w.y) + bfhi(w.y) * bfhi(w.y) + bflo(w.z) * bflo(w.z) + bfhi(w.z) * bfhi(w.z) + bflo(w.w) * bflo(w.w) + bfhi(w.w) * bfhi(w.w);
        s += __shfl_xor(s, 1); s += __shfl_xor(s, 2); s += __shfl_xor(s, 4); mx = fmaxf(mx, s); }
    mx = wave_max(mx);
    if (lane == 0) __hip_atomic_fetch_max(KN2 + bh, __builtin_bit_cast(unsigned, mx), __ATOMIC_RELAXED, __HIP_MEMORY_SCOPE_AGENT);
}
template <int MODE> __device__ __forceinline__ void attn_row(int b, int t, int hg, int lane, LAS float* scr, unsigned mask, const bf16* PROJ, const float* rel, const float* CUM, float* o) {
    constexpr int NH = MODE == 2 ? 1 : 4, MAXK = MODE == 2 ? 2048 : 1024;
    LAS float* qs = scr;
    LAS float* sb = scr + 256;
    LAS int* cb = (LAS int*)(scr + 256 + 4096);
    const size_t tok = (size_t)b * 2048 + t;
    const int qcol = MODE == 2 ? C_FQ + hg * 64 : C_NQ + hg * 256, kcol = (MODE == 0 ? C_KSLC : MODE == 1 ? C_KWIN : C_FK) + hg * 64, vcol = (MODE == 0 ? C_VSLC : MODE == 1 ? C_VWIN : C_FV) + hg * 64;
#pragma unroll
    for (int r = 0; r < NH; ++r) qs[r * 64 + lane] = bf2f(PROJ[tok * NPROJ + qcol + r * 64 + lane]);
    WSYNC();
    const float ct = MODE == 2 ? CUM[(size_t)(b * 16 + hg) * 2048 + t] : 0.f;
    const int nchunk = MODE == 0 ? 32 : (MODE == 1 ? 8 : (t >> 6) + 1);
    int nc = 0; float mx[NH];
#pragma unroll
    for (int r = 0; r < NH; ++r) mx[r] = -INFINITY;
#pragma unroll 1
    for (int ch = 0; ch < nchunk; ++ch) {
        if (MODE == 0 && !((mask >> ch) & 1u)) continue;
        const int p0 = MODE == 1 ? t - 511 + ch * 64 : ch * 64; const int pos = p0 + lane; const bool ok = pos >= 0 && pos <= t;
        float d[NH];
#pragma unroll
        for (int r = 0; r < NH; ++r) d[r] = 0.f;
        if (ok) { const v4u* kr = (const v4u*)(PROJ + (size_t)(b * 2048 + pos) * NPROJ + kcol);
#pragma unroll 2
            for (int i = 0; i < 8; ++i) { const v4u w = kr[i];
                const float k0 = bflo(w.x), k1 = bfhi(w.x), k2 = bflo(w.y), k3 = bfhi(w.y), k4 = bflo(w.z), k5 = bfhi(w.z), k6 = bflo(w.w), k7 = bfhi(w.w);
#pragma unroll
                for (int r = 0; r < NH; ++r) { const LAS float* q = qs + r * 64 + i * 8; d[r] += q[0] * k0 + q[1] * k1 + q[2] * k2 + q[3] * k3 + q[4] * k4 + q[5] * k5 + q[6] * k6 + q[7] * k7; } } }
#pragma unroll
        for (int r = 0; r < NH; ++r) { float bias;
            if (MODE == 2) bias = ok ? ct - CUM[(size_t)(b * 16 + hg) * 2048 + pos] : 0.f; else bias = rel[t5_bucket(t - pos) * 16 + hg * 4 + r] * LOG2E;
            const float s = ok ? d[r] + bias : -INFINITY; sb[r * MAXK + nc * 64 + lane] = s; mx[r] = fmaxf(mx[r], s); }
        if (lane == 0) cb[nc] = p0;
        ++nc;
    }
    WSYNC();
    const int nk = nc * 64; float inv[NH];
#pragma unroll
    for (int r = 0; r < NH; ++r) { const float m = wave_max(mx[r]); float sum = 0.f;
        for (int i = lane; i < nk; i += 64) { const float s = sb[r * MAXK + i]; const float e = (s == -INFINITY) ? 0.f : exp2f(s - m); sb[r * MAXK + i] = e; sum += e; }
        inv[r] = 1.f / fmaxf(wave_sum(sum), 1e-30f); }
    WSYNC();
#pragma unroll
    for (int r = 0; r < NH; ++r) o[r] = 0.f;
    for (int c = 0; c < nc; ++c) { const int p0 = cb[c];
#pragma unroll 4
        for (int j = 0; j < 64; ++j) { const int pos = p0 + j; if (pos < 0 || pos > t) continue;
            const float v = bf2f(PROJ[(size_t)(b * 2048 + pos) * NPROJ + vcol + lane]);
#pragma unroll
            for (int r = 0; r < NH; ++r) o[r] += sb[r * MAXK + c * 64 + j] * v; } }
#pragma unroll
    for (int r = 0; r < NH; ++r) o[r] *= inv[r];
    WSYNC();
}
__device__ __forceinline__ void nsa_item(int item, int lane, LAS float* scr, const bf16* PROJ, const bf16* KC, const bf16* VC, const float* rel, const float* GF, bf16* O, float* SSQ) {
    const int g = item & 3, bt = item >> 2, t = bt & 2047, b = bt >> 11; const size_t tok = (size_t)b * 2048 + t;
    LAS float* qs = scr; LAS float* ps = scr + 256; LAS float* pg = scr + 256 + 512; LAS float* sc = scr + 256 + 512 + 136;
#pragma unroll
    for (int r = 0; r < 4; ++r) qs[r * 64 + lane] = bf2f(PROJ[tok * NPROJ + C_NQ + (g * 4 + r) * 64 + lane]);
    WSYNC();
    const int nvalid = t >= 31 ? min(127, (t - 31) / 16 + 1) : 0;
    float s0[4], s1[4];
#pragma unroll
    for (int half = 0; half < 2; ++half) { const int c = lane + 64 * half; const v4u* kr = (const v4u*)(KC + ((size_t)(b * 128 + c) * 4 + g) * 64);
        float d0 = 0.f, d1 = 0.f, d2 = 0.f, d3 = 0.f;
#pragma unroll 1
        for (int i = 0; i < 8; ++i) { const v4u w = kr[i]; const float kk[8] = {bflo(w.x), bfhi(w.x), bflo(w.y), bfhi(w.y), bflo(w.z), bfhi(w.z), bflo(w.w), bfhi(w.w)};
#pragma unroll
            for (int j = 0; j < 8; ++j) { const int d = i * 8 + j; d0 += qs[d] * kk[j]; d1 += qs[64 + d] * kk[j]; d2 += qs[128 + d] * kk[j]; d3 += qs[192 + d] * kk[j]; } }
        const bool ok = c < nvalid; const int bk = t5_bucket(t - (16 * c + 31)); const float* rb = rel + bk * 16 + g * 4;
        const float v0 = ok ? d0 + rb[0] * LOG2E : -INFINITY, v1 = ok ? d1 + rb[1] * LOG2E : -INFINITY, v2 = ok ? d2 + rb[2] * LOG2E : -INFINITY, v3 = ok ? d3 + rb[3] * LOG2E : -INFINITY;
        if (half == 0) { s0[0] = v0; s0[1] = v1; s0[2] = v2; s0[3] = v3; } else { s1[0] = v0; s1[1] = v1; s1[2] = v2; s1[3] = v3; } }
    float pgl0 = 0.f, pgl1 = 0.f;
#pragma unroll
    for (int r = 0; r < 4; ++r) { const float m = wave_max(fmaxf(s0[r], s1[r]));
        const float e0 = (lane < nvalid) ? exp2f(s0[r] - m) : 0.f, e1 = (lane + 64 < nvalid) ? exp2f(s1[r] - m) : 0.f;
        const float sum = wave_sum(e0 + e1), inv = 1.f / fmaxf(sum, 1e-30f); const float p0 = e0 * inv, p1 = e1 * inv;
        ps[r * 128 + lane] = p0; ps[r * 128 + lane + 64] = p1; pgl0 += p0; pgl1 += p1; }
    pg[1 + lane] = pgl0; pg[65 + lane] = pgl1; if (lane == 0) pg[0] = 0.f;
    WSYNC();
    float oc[4] = {0.f, 0.f, 0.f, 0.f};
#pragma unroll 4
    for (int c = 0; c < nvalid; ++c) { const float v = bf2f(VC[((size_t)(b * 128 + c) * 4 + g) * 64 + lane]); oc[0] += ps[c] * v; oc[1] += ps[128 + c] * v; oc[2] += ps[256 + c] * v; oc[3] += ps[384 + c] * v; }
    const int cur = t >> 6, blk = lane & 31;
    const int c0 = 4 * blk;
    const float imp = pg[c0] + 2.f * (pg[c0 + 1] + pg[c0 + 2] + pg[c0 + 3]) + pg[c0 + 4];
    const bool valid = blk <= cur; const bool forced = (blk == 0) || (blk == cur) || (blk == cur - 1);
    const float score = valid ? imp + (forced ? 1e4f : 0.f) : -1e30f;
    if (lane < 32) sc[lane] = score;
    WSYNC();
    int rank = 0;
    for (int j = 0; j < 32; ++j) { const float o = sc[j]; rank += (o > score || (o == score && j < blk)) ? 1 : 0; }
    const bool sel = (lane < 32) && valid && rank < 16;
    const unsigned mask = (unsigned)__ballot(sel);
    WSYNC();
    float os[4], ow[4];
    attn_row<0>(b, t, g, lane, scr, mask, PROJ, rel, nullptr, os);
    attn_row<1>(b, t, g, lane, scr, 0u, PROJ, rel, nullptr, ow);
    float ss = 0.f;
#pragma unroll
    for (int r = 0; r < 4; ++r) { const float* gl = GF + tok * 64 + g * 12 + r * 3;
        const float v = sigmoidf_(gl[0]) * oc[r] + sigmoidf_(gl[1]) * os[r] + sigmoidf_(gl[2]) * ow[r];
        O[tok * 2048 + (g * 4 + r) * 64 + lane] = (bf16)f2bf(v); ss += v * v; }
    ss = wave_sum(ss); if (lane < 4) SSQ[tok * 32 + g * 4 + lane] = (lane == 0) ? ss : 0.f;
}
__device__ __forceinline__ void fox_item(int item, int lane, LAS float* scr, const bf16* PROJ, const float* CUM, bf16* O, float* SSQ) {
    const int h = item & 15, bt = item >> 4, t = bt & 2047, b = bt >> 11; const size_t tok = (size_t)b * 2048 + t;
    float o[1];
    attn_row<2>(b, t, h, lane, scr, 0u, PROJ, nullptr, CUM, o);
    O[tok * 2048 + 1024 + h * 64 + lane] = (bf16)f2bf(o[0]); const float ss = wave_sum(o[0] * o[0]); if (lane == 0) SSQ[tok * 32 + 16 + h] = ss;
}
__device__ __forceinline__ void normalize_item(size_t tok, int lane, const bf16* O, const float* SSQ, bf16* MIXED) {
    float a = 0.f, f = 0.f;
    for (int i = 0; i < 16; ++i) a += SSQ[tok * 32 + i];
    for (int i = 0; i < 16; ++i) f += SSQ[tok * 32 + 16 + i];
    const float ra = 1.f / sqrtf(a * (1.f / 1024.f) + NORM_EPS), rf = 1.f / sqrtf(f * (1.f / 1024.f) + NORM_EPS);
    const v4u* src = (const v4u*)(O + tok * 2048); v4u* dst = (v4u*)(MIXED + tok * 2048);
#pragma unroll
    for (int i = 0; i < 4; ++i) { const v4u w = src[i * 64 + lane]; const float r = (i < 2) ? ra : rf; v4u o;
        o.x = pk2(bflo(w.x) * r, bfhi(w.x) * r); o.y = pk2(bflo(w.y) * r, bfhi(w.y) * r); o.z = pk2(bflo(w.z) * r, bfhi(w.z) * r); o.w = pk2(bflo(w.w) * r, bfhi(w.w) * r); dst[i * 64 + lane] = o; }
}
__device__ __forceinline__ void router_token(size_t tok, int lane, LAS float* lg, const bf16* HB, const float* HSSQ, const float* ffn_w, const float* wg, const float* bg, const float* we, const float* be, int& e0, int& e1, float& w0, float& w1, float& rstd) {
    float ss = (lane < 32) ? HSSQ[tok * 32 + lane] : 0.f; ss = wave_sum(ss);
    rstd = 1.f / sqrtf(ss * (1.f / 2048.f) + NORM_EPS);
    float acc[36];
#pragma unroll
    for (int o = 0; o < 36; ++o) acc[o] = 0.f;
    for (int i = 0; i < 32; ++i) { const int k = i * 64 + lane; const float hn = bf2f(HB[tok * 2048 + k]) * rstd * ffn_w[k];
        const f32x4 g4 = *(const f32x4*)(wg + (size_t)k * 4);
        acc[0] += hn * g4[0]; acc[1] += hn * g4[1]; acc[2] += hn * g4[2]; acc[3] += hn * g4[3];
#pragma unroll
        for (int j = 0; j < 8; ++j) { const f32x4 e4 = *(const f32x4*)(we + (size_t)k * 32 + j * 4);
            acc[4 + j * 4 + 0] += hn * e4[0]; acc[4 + j * 4 + 1] += hn * e4[1]; acc[4 + j * 4 + 2] += hn * e4[2]; acc[4 + j * 4 + 3] += hn * e4[3]; } }
#pragma unroll
    for (int o = 0; o < 36; ++o) { const float v = wave_sum(acc[o]); if (lane == 0) lg[o] = v + (o < 4 ? bg[o] : be[o - 4]); }
    WSYNC();
    int gsel = 0; float gm = lg[0];
    for (int i = 1; i < 4; ++i) if (lg[i] > gm) { gm = lg[i]; gsel = i; }
    float den = 0.f; for (int i = 0; i < 4; ++i) den += expf(lg[i] - gm);
    const float pgs = 1.f / den;
    const LAS float* el = lg + 4 + gsel * 8;
    int i1 = 0; float v1 = el[0];
    for (int j = 1; j < 8; ++j) if (el[j] > v1) { v1 = el[j]; i1 = j; }
    int i2 = 0; float v2 = -INFINITY;
    for (int j = 0; j < 8; ++j) if (j != i1 && el[j] > v2) { v2 = el[j]; i2 = j; }
    const float ex = expf(v2 - v1), d2 = 1.f / (1.f + ex);
    e0 = gsel * 8 + i1; e1 = gsel * 8 + i2; w0 = d2 * pgs; w1 = ex * d2 * pgs;
    WSYNC();
}

__device__ __forceinline__ void router_mfma(int bx, int tid, int lane, int wave, LAS float* part, const bf16* HB, const bf16* WrT) {
    typedef float f32x16 __attribute__((ext_vector_type(16)));
    const int r32 = lane & 31, hi = lane >> 5;
    f32x16 acc[2][2];
#pragma unroll
    for (int i = 0; i < 2; ++i)
#pragma unroll
        for (int j = 0; j < 2; ++j)
#pragma unroll
            for (int r = 0; r < 16; ++r) acc[i][j][r] = 0.f;
    const bf16* a0 = HB + (size_t)(bx * 64 + r32) * 2048 + wave * 256 + hi * 8;
    const bf16* b0 = WrT + wave * 16384 + lane * 8;
#pragma unroll 4
    for (int s = 0; s < 16; ++s) {
        bf16x8 A[2], Bh[2], Bl[2];
#pragma unroll
        for (int i = 0; i < 2; ++i) { A[i] = *(const bf16x8*)(a0 + (size_t)i * 32 * 2048 + s * 16); Bh[i] = *(const bf16x8*)(b0 + s * 1024 + i * 512); Bl[i] = *(const bf16x8*)(b0 + 64 * 2048 + s * 1024 + i * 512); }
#pragma unroll
        for (int i = 0; i < 2; ++i)
#pragma unroll
            for (int j = 0; j < 2; ++j) { acc[i][j] = __builtin_amdgcn_mfma_f32_32x32x16_bf16(A[i], Bh[j], acc[i][j], 0, 0, 0); acc[i][j] = __builtin_amdgcn_mfma_f32_32x32x16_bf16(A[i], Bl[j], acc[i][j], 0, 0, 0); }
    }
    LAS float* pw = part + wave * 4096;
#pragma unroll
    for (int i = 0; i < 2; ++i)
#pragma unroll
        for (int j = 0; j < 2; ++j)
#pragma unroll
            for (int r = 0; r < 16; ++r) pw[(32 * i + (r & 3) + 8 * (r >> 2) + 4 * hi) * 64 + 32 * j + r32] = acc[i][j][r];
}
__device__ __forceinline__ float fp8f(unsigned w, int i) { return i == 0 ? __builtin_amdgcn_cvt_f32_fp8((int)w, 0) : i == 1 ? __builtin_amdgcn_cvt_f32_fp8((int)w, 1) : i == 2 ? __builtin_amdgcn_cvt_f32_fp8((int)w, 2) : __builtin_amdgcn_cvt_f32_fp8((int)w, 3); }
__device__ __forceinline__ void final_item(size_t tok, int lane, const bf16* HB, const unsigned char* YS, const float* fw, float* OUT) {
    float v[32]; float ss = 0.f;
    const v4u* h4 = (const v4u*)(HB + tok * 2048); const unsigned long long* y0 = (const unsigned long long*)(YS + tok * 2048); const unsigned long long* y1 = (const unsigned long long*)(YS + (size_t)16384 * 2048 + tok * 2048);
#pragma unroll
    for (int i = 0; i < 4; ++i) { const v4u a = h4[i * 64 + lane]; const unsigned long long p = y0[i * 64 + lane], q = y1[i * 64 + lane];
        const unsigned pl = (unsigned)p, ph = (unsigned)(p >> 32), ql = (unsigned)q, qh = (unsigned)(q >> 32);
        v[i * 8 + 0] = bflo(a.x) + fp8f(pl, 0) + fp8f(ql, 0); v[i * 8 + 1] = bfhi(a.x) + fp8f(pl, 1) + fp8f(ql, 1); v[i * 8 + 2] = bflo(a.y) + fp8f(pl, 2) + fp8f(ql, 2); v[i * 8 + 3] = bfhi(a.y) + fp8f(pl, 3) + fp8f(ql, 3);
        v[i * 8 + 4] = bflo(a.z) + fp8f(ph, 0) + fp8f(qh, 0); v[i * 8 + 5] = bfhi(a.z) + fp8f(ph, 1) + fp8f(qh, 1); v[i * 8 + 6] = bflo(a.w) + fp8f(ph, 2) + fp8f(qh, 2); v[i * 8 + 7] = bfhi(a.w) + fp8f(ph, 3) + fp8f(qh, 3); }
#pragma unroll
    for (int i = 0; i < 32; ++i) ss += v[i] * v[i];
    ss = wave_sum(ss); const float r = 1.f / sqrtf(ss * (1.f / 2048.f) + NORM_EPS);
#pragma unroll
    for (int i = 0; i < 4; ++i) { const int k = i * 512 + lane * 8; const f32x4 wa = *(const f32x4*)(fw + k), wb = *(const f32x4*)(fw + k + 4);
        f32x4 oa = {v[i * 8 + 0] * r * wa[0], v[i * 8 + 1] * r * wa[1], v[i * 8 + 2] * r * wa[2], v[i * 8 + 3] * r * wa[3]};
        f32x4 ob = {v[i * 8 + 4] * r * wb[0], v[i * 8 + 5] * r * wb[1], v[i * 8 + 6] * r * wb[2], v[i * 8 + 7] * r * wb[3]};
        *(f32x4*)(OUT + tok * 2048 + k) = oa; *(f32x4*)(OUT + tok * 2048 + k + 4) = ob; }
}

namespace att {
typedef float f32x16 __attribute__((ext_vector_type(16)));
typedef short s16x4 __attribute__((ext_vector_type(4)));
typedef short v4i16_t __attribute__((ext_vector_type(4)));
typedef float f32x2_t __attribute__((ext_vector_type(2))); typedef __bf16 bf16x2_t __attribute__((ext_vector_type(2)));
typedef unsigned u32x4w __attribute__((ext_vector_type(4)));
__device__ __forceinline__ int clamp127(int d) { return d < 0 ? 0 : (d > 127 ? 127 : d); }
constexpr int SLOTB = 8192;
constexpr int A_KR = 0, A_VR = 32768, A_WSF = 65536, A_OST = 67584, A_PG = 100352, A_SC = 133120, A_SELM = 141312, A_BTAB = 141568, A_GATE = 143616, A_QSLOT = 146688;
static_assert(A_QSLOT + 16 <= 8 * 18432, "attention LDS map");
constexpr int A_BTW = 8 * 18432 + 9216;
constexpr float THR = 8.f;
constexpr float FOX_CUT = 40.f;
#define SBAR() __builtin_amdgcn_sched_barrier(0)
#ifndef PIPE_SGB
#define PIPE_SGB() do { _Pragma("unroll") for (int i = 0; i < 8; ++i) { __builtin_amdgcn_sched_group_barrier(0x100, 2, 0); __builtin_amdgcn_sched_group_barrier(0x008, 1, 0); __builtin_amdgcn_sched_group_barrier(0x002, 10, 0); } } while (0)
#endif
#define WAIT_BAR0() asm volatile("s_waitcnt vmcnt(0) lgkmcnt(0)\n\ts_barrier" ::: "memory")
__device__ __forceinline__ int crow(int r, int hi) { return (r & 3) + 8 * (r >> 2) + 4 * hi; }
__device__ __forceinline__ void glds16(const void* gsrc, unsigned lds_dst) { unsigned keep;
    asm volatile("s_mov_b32 %0, m0\n\ts_mov_b32 m0, %2\n\ts_nop 0\n\tglobal_load_lds_dwordx4 %1, off\n\ts_mov_b32 m0, %0" : "=&s"(keep) : "v"(gsrc), "s"(lds_dst) : "memory"); }
__device__ __forceinline__ unsigned cvtpk_s(float lo, float hi) { f32x2_t v = {lo, hi}; bf16x2_t b = __builtin_convertvector(v, bf16x2_t); return __builtin_bit_cast(unsigned, b); }
__device__ __forceinline__ s16x4 vtr(const LAS char* p) { return __builtin_bit_cast(s16x4, __builtin_amdgcn_ds_read_tr16_b64_v4i16((LAS v4i16_t*)p)); }
__device__ __forceinline__ float swapmax(float m) { auto rr = __builtin_amdgcn_permlane32_swap(__float_as_uint(m), __float_as_uint(m), false, false); return fmaxf(__uint_as_float(rr[0]), __uint_as_float(rr[1])); }
__device__ __forceinline__ float swapsum(float m) { auto rr = __builtin_amdgcn_permlane32_swap(__float_as_uint(m), __float_as_uint(m), false, false); return __uint_as_float(rr[0]) + __uint_as_float(rr[1]); }

struct Ctx { int tid, lane, r32, hi, wid; LAS char* shm; unsigned lds0; };
struct FlashState { f32x16 o[2]; float mhat, l; bool started; };

__device__ __forceinline__ void dma_k(const Ctx& c, const bf16* Ktile, long pitch, int slot) {
    glds16(Ktile + (long)c.lane * pitch + c.wid * 8, (unsigned)__builtin_amdgcn_readfirstlane(c.lds0 + A_KR + slot * SLOTB + c.wid * 1024)); }
__device__ __forceinline__ void dma_v(const Ctx& c, const bf16* Vtile, long pitch, int slot) {
    glds16(Vtile + (long)(16 * (c.wid & 3) + (c.lane >> 2)) * pitch + (c.wid >> 2) * 32 + (c.lane & 3) * 8, (unsigned)__builtin_amdgcn_readfirstlane(c.lds0 + A_VR + slot * SLOTB + c.wid * 1024)); }

__device__ __forceinline__ void qkt(f32x16& p0, f32x16& p1, const Ctx& c, int slot, const bf16x8 (&qr)[4], float cinit) {
    const LAS char* kb = c.shm + A_KR + slot * SLOTB + c.hi * 1024 + c.r32 * 16;
#pragma unroll
    for (int r = 0; r < 16; ++r) { p0[r] = cinit; p1[r] = cinit; }
#pragma unroll
    for (int d0 = 0; d0 < 4; ++d0) {
        const bf16x8 b0 = *(const LAS bf16x8*)(kb + d0 * 2048), b1 = *(const LAS bf16x8*)(kb + d0 * 2048 + 512);
        p0 = __builtin_amdgcn_mfma_f32_32x32x16_bf16(b0, qr[d0], p0, 0, 0, 0); p1 = __builtin_amdgcn_mfma_f32_32x32x16_bf16(b1, qr[d0], p1, 0, 0, 0); }
}
__device__ __forceinline__ void pv(f32x16 (&o)[2], const Ctx& c, int slot, const f32x16& p0, const f32x16& p1) {
    u32x4w pw[4];
#pragma unroll
    for (int k = 0; k < 2; ++k) {
        pw[k] = (u32x4w){cvtpk_s(p0[8 * k + 0], p0[8 * k + 1]), cvtpk_s(p0[8 * k + 2], p0[8 * k + 3]), cvtpk_s(p0[8 * k + 4], p0[8 * k + 5]), cvtpk_s(p0[8 * k + 6], p0[8 * k + 7])};
        pw[2 + k] = (u32x4w){cvtpk_s(p1[8 * k + 0], p1[8 * k + 1]), cvtpk_s(p1[8 * k + 2], p1[8 * k + 3]), cvtpk_s(p1[8 * k + 4], p1[8 * k + 5]), cvtpk_s(p1[8 * k + 6], p1[8 * k + 7])}; }
    const LAS char* vp = c.shm + A_VR + slot * SLOTB + ((c.lane >> 4) & 1) * 32 + (c.lane & 3) * 8 + (4 * c.hi + ((c.lane & 15) >> 2)) * 64;
#pragma unroll
    for (int d0 = 0; d0 < 2; ++d0)
#pragma unroll
        for (int ks = 0; ks < 4; ++ks) { const s16x4 lo = vtr(vp + d0 * 4096 + ks * 1024), hi4 = vtr(vp + d0 * 4096 + ks * 1024 + 512);
            const bf16x8 vf = (bf16x8){lo[0], lo[1], lo[2], lo[3], hi4[0], hi4[1], hi4[2], hi4[3]};
            o[d0] = __builtin_amdgcn_mfma_f32_32x32x16_bf16(__builtin_bit_cast(bf16x8, pw[ks]), vf, o[d0], 0, 0, 0); }
}
__device__ __forceinline__ float max3f(float a, float b, float c) { float r; asm("v_max3_f32 %0, %1, %2, %3" : "=v"(r) : "v"(a), "v"(b), "v"(c)); return r; }
__device__ __forceinline__ float rowmax32(const f32x16& p0, const f32x16& p1) {
    float a = max3f(p0[0], p0[1], p1[0]), b = max3f(p0[2], p0[3], p1[1]); a = max3f(a, p1[2], p1[3]);
#pragma unroll
    for (int r = 4; r < 16; r += 4) { a = max3f(a, p0[r], p0[r + 1]); b = max3f(b, p0[r + 2], p0[r + 3]); a = max3f(a, p1[r], p1[r + 1]); b = max3f(b, p1[r + 2], p1[r + 3]); }
    return swapmax(max3f(a, b, b));
}
__device__ __forceinline__ void softmax_step(FlashState& s, f32x16& p0, f32x16& p1, const Ctx& c) {
    const float rm = rowmax32(p0, p1);
    const bool fin = rm > -INFINITY; const bool need = fin && (!s.started || rm > THR);
    if (__any(need)) {
        const float dl = need ? (s.started ? fmaxf(rm, 0.f) : rm) : 0.f; s.mhat += dl;
#pragma unroll
        for (int r = 0; r < 16; ++r) { p0[r] -= dl; p1[r] -= dl; }
        const float f = __builtin_amdgcn_exp2f(-dl); s.l *= f;
        LAS float* wsf = (LAS float*)(c.shm + A_WSF) + c.wid * 64;
        if (c.hi == 0) wsf[c.r32] = f;
        asm volatile("s_waitcnt lgkmcnt(0)" ::: "memory");
#pragma unroll
        for (int r = 0; r < 16; ++r) { const float fr = wsf[crow(r, c.hi)]; s.o[0][r] *= fr; s.o[1][r] *= fr; }
        asm volatile("s_waitcnt lgkmcnt(0)" ::: "memory");
    }
    s.started = s.started || fin;
    float sacc = 0.f;
#pragma unroll
    for (int r = 0; r < 16; ++r) { p0[r] = __builtin_amdgcn_exp2f(p0[r]); p1[r] = __builtin_amdgcn_exp2f(p1[r]); sacc += p0[r] + p1[r]; }
    s.l += sacc;
}
__device__ __forceinline__ float sm_decide(FlashState& s, f32x16& p0, f32x16& p1, bool& any) {
    const float rm = rowmax32(p0, p1);
    const bool fin = rm > -INFINITY; const bool need = fin && (!s.started || rm > THR);
    float f = 1.f; any = __any(need);
    if (any) {
        const float dl = need ? (s.started ? fmaxf(rm, 0.f) : rm) : 0.f; s.mhat += dl;
#pragma unroll
        for (int r = 0; r < 16; ++r) { p0[r] -= dl; p1[r] -= dl; }
        f = __builtin_amdgcn_exp2f(-dl); s.l *= f;
    }
    s.started = s.started || fin;
    return f;
}
__device__ __forceinline__ void sm_rescale_o(FlashState& s, float f, const Ctx& c) {
    LAS float* wsf = (LAS float*)(c.shm + A_WSF) + c.wid * 64;
    if (c.hi == 0) wsf[c.r32] = f;
    asm volatile("s_waitcnt lgkmcnt(0)" ::: "memory");
#pragma unroll
    for (int r = 0; r < 16; ++r) { const float fr = wsf[crow(r, c.hi)]; s.o[0][r] *= fr; s.o[1][r] *= fr; }
    asm volatile("s_waitcnt lgkmcnt(0)" ::: "memory");
}
__device__ __forceinline__ void sm_exp(FlashState& s, f32x16& p0, f32x16& p1) {
    float sacc = 0.f;
#pragma unroll
    for (int r = 0; r < 16; ++r) { p0[r] = __builtin_amdgcn_exp2f(p0[r]); p1[r] = __builtin_amdgcn_exp2f(p1[r]); sacc += p0[r] + p1[r]; }
    s.l += sacc;
}
__device__ __forceinline__ void sm_pack(const f32x16& p0, const f32x16& p1, u32x4w (&pw)[4]) {
#pragma unroll
    for (int k = 0; k < 2; ++k) {
        pw[k] = (u32x4w){cvtpk_s(p0[8 * k + 0], p0[8 * k + 1]), cvtpk_s(p0[8 * k + 2], p0[8 * k + 3]), cvtpk_s(p0[8 * k + 4], p0[8 * k + 5]), cvtpk_s(p0[8 * k + 6], p0[8 * k + 7])};
        pw[2 + k] = (u32x4w){cvtpk_s(p1[8 * k + 0], p1[8 * k + 1]), cvtpk_s(p1[8 * k + 2], p1[8 * k + 3]), cvtpk_s(p1[8 * k + 4], p1[8 * k + 5]), cvtpk_s(p1[8 * k + 6], p1[8 * k + 7])}; }
}
__device__ __forceinline__ void pv_packed(f32x16 (&o)[2], const Ctx& c, int slot, const u32x4w (&pw)[4]) {
    const LAS char* vp = c.shm + A_VR + slot * SLOTB + ((c.lane >> 4) & 1) * 32 + (c.lane & 3) * 8 + (4 * c.hi + ((c.lane & 15) >> 2)) * 64;
#pragma unroll
    for (int d0 = 0; d0 < 2; ++d0)
#pragma unroll
        for (int ks = 0; ks < 4; ++ks) { const s16x4 lo = vtr(vp + d0 * 4096 + ks * 1024), hi4 = vtr(vp + d0 * 4096 + ks * 1024 + 512);
            const bf16x8 vf = (bf16x8){lo[0], lo[1], lo[2], lo[3], hi4[0], hi4[1], hi4[2], hi4[3]};
            o[d0] = __builtin_amdgcn_mfma_f32_32x32x16_bf16(__builtin_bit_cast(bf16x8, pw[ks]), vf, o[d0], 0, 0, 0); }
}
__device__ __forceinline__ f32x16 splat(float v) { f32x16 x;
#pragma unroll
    for (int r = 0; r < 16; ++r) x[r] = v; return x; }

template <bool PIPE, class Next, class CInit, class Post, class Skip>
__device__ __forceinline__ int flash(FlashState& s, const Ctx& c, const bf16x8 (&qr)[4], const bf16* Kc, const bf16* Vc, long pitch, int first, Next next, CInit cinit, Post post, Skip skip,
                                     int pair0 = 0, bool pre = false, const bf16* tK = nullptr, const bf16* tV = nullptr, int tj0 = -1, int tj1 = -1) {
    if (first < 0) return pair0;
    int j0 = first, j1 = next(first), pair = pair0;
    if (!pre) { dma_k(c, Kc + (long)j0 * 64 * pitch, pitch, 2 * pair); dma_v(c, Vc + (long)j0 * 64 * pitch, pitch, 2 * pair);
        if (j1 >= 0) { dma_k(c, Kc + (long)j1 * 64 * pitch, pitch, 2 * pair + 1); dma_v(c, Vc + (long)j1 * 64 * pitch, pitch, 2 * pair + 1); } }
    while (j0 >= 0) {
        const int n0 = j1 >= 0 ? next(j1) : -1, n1 = n0 >= 0 ? next(n0) : -1;
        WAIT_BAR0();
        const int so = 2 * (pair ^ 1);
        if (n0 >= 0) { dma_k(c, Kc + (long)n0 * 64 * pitch, pitch, so); dma_v(c, Vc + (long)n0 * 64 * pitch, pitch, so);
            if (n1 >= 0) { dma_k(c, Kc + (long)n1 * 64 * pitch, pitch, so + 1); dma_v(c, Vc + (long)n1 * 64 * pitch, pitch, so + 1); } }
        else if (tj0 >= 0) { dma_k(c, tK + (long)tj0 * 64 * pitch, pitch, so); dma_v(c, tV + (long)tj0 * 64 * pitch, pitch, so);
            if (tj1 >= 0) { dma_k(c, tK + (long)tj1 * 64 * pitch, pitch, so + 1); dma_v(c, tV + (long)tj1 * 64 * pitch, pitch, so + 1); }
            tj0 = -1; }
        bool both = false;
        if constexpr (PIPE) both = j1 >= 0 && !skip(j0) && !skip(j1);
        if (both) {
            const int sl0 = 2 * pair, sl1 = 2 * pair + 1;
            f32x16 a0, a1, b0, b1; u32x4w pw[4]; bool any0, any1;
            qkt(a0, a1, c, sl0, qr, cinit(j0));
            asm volatile("s_nop 15\n\ts_nop 7" : "+v"(a0), "+v"(a1));
            post(j0, a0, a1);
            const float f0 = sm_decide(s, a0, a1, any0);
            if (any0) sm_rescale_o(s, f0, c);
            SBAR();
            qkt(b0, b1, c, sl1, qr, cinit(j1));
            sm_exp(s, a0, a1);
            PIPE_SGB();
            sm_pack(a0, a1, pw);
            asm volatile("s_nop 15\n\ts_nop 7" : "+v"(b0), "+v"(b1));
            post(j1, b0, b1);
            const float f1 = sm_decide(s, b0, b1, any1);
            SBAR();
            pv_packed(s.o, c, sl0, pw);
            sm_exp(s, b0, b1);
            PIPE_SGB();
            if (any1) sm_rescale_o(s, f1, c);
            sm_pack(b0, b1, pw);
            pv_packed(s.o, c, sl1, pw);
        } else
#pragma unroll
        for (int h = 0; h < 2; ++h) {
            const int j = h ? j1 : j0, slot = 2 * pair + h;
            if (j >= 0 && !skip(j)) {
                f32x16 p0, p1;
                qkt(p0, p1, c, slot, qr, cinit(j));
                asm volatile("s_nop 15\n\ts_nop 7" : "+v"(p0), "+v"(p1));
                post(j, p0, p1);
                softmax_step(s, p0, p1, c);
                pv(s.o, c, slot, p0, p1);
            }
        }
        pair ^= 1; j0 = n0; j1 = n1;
    }
    asm volatile("s_waitcnt lgkmcnt(0)\n\ts_barrier" ::: "memory");
    return pair;
}
__device__ __forceinline__ void load_q(bf16x8 (&qr)[4], const bf16* Qrow, int hi) {
#pragma unroll
    for (int d0 = 0; d0 < 4; ++d0) qr[d0] = *(const bf16x8*)(Qrow + d0 * 16 + hi * 8);
}
__device__ __forceinline__ void accum_branch(f32x16 (&ot)[2], const f32x16 (&o)[2], float fac, const Ctx& c) {
    LAS float* wsf = (LAS float*)(c.shm + A_WSF) + c.wid * 64;
    if (c.hi == 0) wsf[c.r32] = fac;
    asm volatile("s_waitcnt lgkmcnt(0)" ::: "memory");
#pragma unroll
    for (int r = 0; r < 16; ++r) { const float fr = wsf[crow(r, c.hi)]; ot[0][r] += o[0][r] * fr; ot[1][r] += o[1][r] * fr; }
    asm volatile("s_waitcnt lgkmcnt(0)" ::: "memory");
}
__device__ __forceinline__ void store_o(const f32x16 (&o)[2], const Ctx& c, bf16* Orow0, float* ssq0) {
    LAS bf16* stg = (LAS bf16*)(c.shm + A_OST) + c.wid * 2048;
#pragma unroll
    for (int r = 0; r < 16; ++r) { const int orow = crow(r, c.hi);
#pragma unroll
        for (int d0 = 0; d0 < 2; ++d0) stg[orow * 64 + d0 * 32 + c.r32] = (bf16)f2bf(o[d0][r]); }
    asm volatile("s_waitcnt lgkmcnt(0)" ::: "memory");
#pragma unroll
    for (int i = 0; i < 4; ++i) { const int row = i * 8 + (c.lane >> 3), ch = c.lane & 7; const v4u v = *(const LAS v4u*)(stg + row * 64 + ch * 8);
        *(v4u*)(Orow0 + (long)row * 2048 + ch * 8) = v;
        float ss = bflo(v.x) * bflo(v.x) + bfhi(v.x) * bfhi(v.x) + bflo(v.y) * bflo(v.y) + bfhi(v.y) * bfhi(v.y) + bflo(v.z) * bflo(v.z) + bfhi(v.z) * bfhi(v.z) + bflo(v.w) * bflo(v.w) + bfhi(v.w) * bfhi(v.w);
        ss += __shfl_xor(ss, 1); ss += __shfl_xor(ss, 2); ss += __shfl_xor(ss, 4);
        if (ch == 0) ssq0[(long)row * 32] = ss; }
    asm volatile("s_waitcnt lgkmcnt(0)" ::: "memory");
}

__device__ __forceinline__ void fox_unit(const Ctx& c, int b, int h, int qb, const bf16* PROJ, const float* CUM, const unsigned* KN2, bf16* O, float* SSQ, unsigned* NCNT) {
    const int q0 = qb * 256, NT = 4 * (qb + 1); const long rowbase = (long)b * 2048;
    const bf16* Kb = PROJ + rowbase * NPROJ + C_FK + h * 64; const bf16* Vb = PROJ + rowbase * NPROJ + C_FV + h * 64;
    dma_k(c, Kb + (long)(NT - 1) * 64 * NPROJ, NPROJ, 0); dma_v(c, Vb + (long)(NT - 1) * 64 * NPROJ, NPROJ, 0);
    dma_k(c, Kb + (long)(NT - 2) * 64 * NPROJ, NPROJ, 1); dma_v(c, Vb + (long)(NT - 2) * 64 * NPROJ, NPROJ, 1);
    LAS float* cumL = (LAS float*)(c.shm + A_PG);
    const float* cu = CUM + (size_t)(b * 16 + h) * 2048;
    float cv[4];
#pragma unroll
    for (int k = 0; k < 4; ++k) cv[k] = cu[c.tid + 512 * k];
    bf16x8 qr[4]; load_q(qr, PROJ + (rowbase + q0 + c.wid * 32 + c.r32) * NPROJ + C_FQ + h * 64, c.hi);
    const int qrel = c.wid * 32 + c.r32; const float cq = cu[q0 + qrel];
    const float kn2 = __builtin_bit_cast(float, __hip_atomic_load(KN2 + b * 16 + h, __ATOMIC_RELAXED, __HIP_MEMORY_SCOPE_AGENT));
#pragma unroll
    for (int k = 0; k < 4; ++k) cumL[c.tid + 512 * k] = cv[k];
    FlashState s; s.o[0] = splat(0.f); s.o[1] = splat(0.f); s.mhat = 0.f; s.l = 0.f; s.started = false;
    const int wid = c.wid, hi = c.hi;
    float qn2 = 0.f;
#pragma unroll
    for (int d0 = 0; d0 < 4; ++d0)
#pragma unroll
        for (int j = 0; j < 8; ++j) { const float x = bf2f((unsigned short)qr[d0][j]); qn2 += x * x; }
    qn2 = swapsum(qn2);
    const float qkb = sqrtf(qn2 * kn2) * 1.0001f;
    auto cinit = [&](int) { return cq - s.mhat; };
    auto post = [&](int j, f32x16& p0, f32x16& p1) {
            const LAS f32x4* ck = (const LAS f32x4*)(cumL + 64 * j + 4 * hi);
#pragma unroll
            for (int k = 0; k < 4; ++k) { const f32x4 a = ck[2 * k];
#pragma unroll
                for (int i = 0; i < 4; ++i) p0[4 * k + i] -= a[i]; }
            SBAR();
#pragma unroll
            for (int k = 0; k < 4; ++k) { const f32x4 bq = ck[2 * k + 8];
#pragma unroll
                for (int i = 0; i < 4; ++i) p1[4 * k + i] -= bq[i]; }
            SBAR();
            const int jb = j - (NT - 4);
            if (jb >= 0) { const int kb = 64 * jb + 4 * hi;
#pragma unroll
                for (int r = 0; r < 16; ++r) { const int kv = kb + (r & 3) + 8 * (r >> 2); if (kv > qrel) p0[r] = -INFINITY; if (kv + 32 > qrel) p1[r] = -INFINITY; } }
        };
    auto skip = [&](int j) { const int jb = j - (NT - 4); return jb >= 0 && 64 * jb > 32 * wid + 31; };
    flash<false>(s, c, qr, Kb, Vb, (long)NPROJ, NT - 1, [&](int j) { return j > NT - 4 ? j - 1 : -1; }, cinit, post, skip, 0, true, Kb, Vb, NT > 4 ? NT - 5 : -1, NT - 6);
    if (NT > 4) {
        LAS float* wmx = (LAS float*)(c.shm + A_SC);
        const float ub = wave_max(qkb + cq - s.mhat);
        if (c.lane == 0) wmx[c.wid] = ub;
        __syncthreads();
        float A = wmx[0];
#pragma unroll
        for (int w = 1; w < 8; ++w) A = fmaxf(A, wmx[w]);
        A = __builtin_bit_cast(float, __builtin_amdgcn_readfirstlane(__builtin_bit_cast(int, A)));
        auto alive = [&](int j) { return j >= 0 && A - cumL[64 * j + 63] >= -FOX_CUT; };
        flash<false>(s, c, qr, Kb, Vb, (long)NPROJ, alive(NT - 5) ? NT - 5 : -1, [&](int j) { return alive(j - 1) ? j - 1 : -1; }, cinit, post, [](int) { return false; }, 0, true);
    }
    const float lt = swapsum(s.l);
    f32x16 ot[2]; ot[0] = splat(0.f); ot[1] = splat(0.f);
    accum_branch(ot, s.o, 1.f / lt, c);
    store_o(ot, c, O + (rowbase + q0 + c.wid * 32) * 2048 + 1024 + h * 64, SSQ + (rowbase + q0 + c.wid * 32) * 32 + 16 + h);
    asm volatile("s_waitcnt lgkmcnt(0)\n\ts_barrier" ::: "memory");
}

__device__ __forceinline__ void nsa_unit(const Ctx& c, int b, int g, int qt, const bf16* PROJ, const bf16* KC, const bf16* VC, const float* rel, const float* GF, bf16* O, float* SSQ, unsigned* NCNT) {
    const long rowbase = (long)b * 2048; const int t0 = 64 * qt;
    const int head = c.wid >> 1, a = 32 * (c.wid & 1) + c.r32;
    const int t = t0 + a, hi = c.hi;
    LAS float* pg = (LAS float*)(c.shm + A_PG); LAS float* sc = (LAS float*)(c.shm + A_SC); LAS unsigned* selm = (LAS unsigned*)(c.shm + A_SELM);
    LAS float* btab = (LAS float*)(c.shm + A_BTAB); LAS float* gate = (LAS float*)(c.shm + A_GATE);
    const bool two = qt >= 16;
    { const bf16* Kc = KC + ((size_t)b * 128 * 4 + g) * 64; const bf16* Vc = VC + ((size_t)b * 128 * 4 + g) * 64;
        dma_k(c, Kc, 256, 0); dma_v(c, Vc, 256, 0);
        if (two) { dma_k(c, Kc + 64 * 256, 256, 1); dma_v(c, Vc + 64 * 256, 256, 1); } }
    const bf16* Ks = PROJ + rowbase * NPROJ + C_KSLC + g * 64; const bf16* Vs = PROJ + rowbase * NPROJ + C_VSLC + g * 64;
    dma_k(c, Ks + (long)qt * 64 * NPROJ, NPROJ, 2); dma_v(c, Vs + (long)qt * 64 * NPROJ, NPROJ, 2);
    if (qt > 0) { dma_k(c, Ks + (long)(qt - 1) * 64 * NPROJ, NPROJ, 3); dma_v(c, Vs + (long)(qt - 1) * 64 * NPROJ, NPROJ, 3); }
    bf16x8 qr[4]; load_q(qr, PROJ + (rowbase + t) * NPROJ + C_NQ + (g * 4 + head) * 64, hi);
    { const int hh = c.tid >> 7, d = c.tid & 127; const int hq = g * 4 + hh; const float r31 = rel[31 * 16 + hq];
        const float rb = rel[t5_bucket(d) * 16 + hq];
        const int i1 = c.tid + 512, h0 = c.tid >> 8, h1 = i1 >> 8, d0 = (c.tid & 255) - 64, d1 = (i1 & 255) - 64;
        const float w0 = rel[t5_bucket(clamp127(d0)) * 16 + g * 4 + h0], w0r = rel[31 * 16 + g * 4 + h0], w1 = rel[t5_bucket(clamp127(d1)) * 16 + g * 4 + h1], w1r = rel[31 * 16 + g * 4 + h1];
        const int ga = c.tid, gb = c.tid < 256 ? c.tid + 512 : c.tid;
        const float gv0 = GF[(size_t)(rowbase + t0 + (ga % 192) / 3) * 64 + g * 12 + (ga / 192) * 3 + (ga % 192) % 3], gv1 = GF[(size_t)(rowbase + t0 + (gb % 192) / 3) * 64 + g * 12 + (gb / 192) * 3 + (gb % 192) % 3];
        btab[c.tid] = (rb - r31) * LOG2E;
        LAS float* bw = (LAS float*)(c.shm + A_BTW);
        bw[c.tid] = (d0 >= 0 && d0 < 127) ? (w0 - w0r) * LOG2E : 0.f; bw[i1] = (d1 >= 0 && d1 < 127) ? (w1 - w1r) * LOG2E : 0.f;
        gate[ga] = sigmoidf_(gv0); if (c.tid < 256) gate[gb] = sigmoidf_(gv1); }
    if (c.tid < 64) selm[c.tid] = 0u;
    f32x16 ot[2]; ot[0] = splat(0.f); ot[1] = splat(0.f);
    const LAS float* bt = btab + head * 128;
    __syncthreads();
    {
        WAIT_BAR0();
        f32x16 p0, p1, p2, p3;
        qkt(p0, p1, c, 0, qr, 0.f);
        if (two) qkt(p2, p3, c, 1, qr, 0.f); else { p2 = splat(-INFINITY); p3 = splat(-INFINITY); }
        const int cmax = t >= 31 ? (t - 31) >> 4 : -1;
        auto cmp_post = [&](f32x16& p, int cbase) {
#pragma unroll
            for (int q4 = 0; q4 < 4; ++q4) {
                float bv[4];
#pragma unroll
                for (int i = 0; i < 4; ++i) { const int c0 = crow(4 * q4 + i, hi) + cbase; bv[i] = bt[clamp127(t - 16 * c0 - 31)]; }
                asm volatile("" : "+v"(bv[0]), "+v"(bv[1]), "+v"(bv[2]), "+v"(bv[3]));
#pragma unroll
                for (int i = 0; i < 4; ++i) { const int r = 4 * q4 + i; const int c0 = crow(r, hi) + cbase; p[r] = (c0 <= cmax) ? p[r] + bv[i] : -INFINITY; }
            }
        };
        cmp_post(p0, 0); cmp_post(p1, 32);
        if (two) { cmp_post(p2, 64); cmp_post(p3, 96); }
        float rm = fmaxf(rowmax32(p0, p1), rowmax32(p2, p3)); if (!(rm > -INFINITY)) rm = 0.f;
        float sum = 0.f;
#pragma unroll
        for (int r = 0; r < 16; ++r) { p0[r] = __builtin_amdgcn_exp2f(p0[r] - rm); p1[r] = __builtin_amdgcn_exp2f(p1[r] - rm); p2[r] = __builtin_amdgcn_exp2f(p2[r] - rm); p3[r] = __builtin_amdgcn_exp2f(p3[r] - rm); sum += (p0[r] + p1[r]) + (p2[r] + p3[r]); }
        sum = swapsum(sum); const float inv = 1.f / fmaxf(sum, 1e-30f);
#pragma unroll
        for (int r = 0; r < 16; ++r) { p0[r] *= inv; p1[r] *= inv; p2[r] *= inv; p3[r] *= inv; }
        if (qt >= 16) {
#pragma unroll 1
            for (int hh = 0; hh < 4; ++hh) {
                if (head == hh) {
#pragma unroll
                    for (int r = 0; r < 16; ++r) { const int cc = crow(r, hi);
                        if (hh == 0) { pg[(cc) * 64 + a] = p0[r]; pg[(cc + 32) * 64 + a] = p1[r]; pg[(cc + 64) * 64 + a] = p2[r]; pg[(cc + 96) * 64 + a] = p3[r]; }
                        else { pg[(cc) * 64 + a] += p0[r]; pg[(cc + 32) * 64 + a] += p1[r]; pg[(cc + 64) * 64 + a] += p2[r]; pg[(cc + 96) * 64 + a] += p3[r]; } } }
                __syncthreads();
            }
        }
        { const float g0 = gate[(head * 64 + a) * 3 + 0];
#pragma unroll
            for (int r = 0; r < 16; ++r) { p0[r] *= g0; p1[r] *= g0; p2[r] *= g0; p3[r] *= g0; } }
        pv(ot, c, 0, p0, p1);
        if (two) pv(ot, c, 1, p2, p3);
        asm volatile("s_waitcnt lgkmcnt(0)\n\ts_barrier" ::: "memory");
    }
    unsigned mymask;
    if (qt >= 16) {
        const int tk = c.tid & 63, grp = c.tid >> 6; float sv[4];
#pragma unroll
        for (int i = 0; i < 4; ++i) { const int blk = 4 * grp + i, c0 = 4 * blk;
            const float imp = (c0 > 0 ? pg[(c0 - 1) * 64 + tk] : 0.f) + 2.f * (pg[c0 * 64 + tk] + pg[(c0 + 1) * 64 + tk] + pg[(c0 + 2) * 64 + tk]) + pg[(c0 + 3) * 64 + tk];
            const bool valid = blk <= qt, forced = (blk == 0) || (blk == qt) || (blk == qt - 1);
            sv[i] = valid ? imp + (forced ? 1e4f : 0.f) : -1e30f; sc[blk * 64 + tk] = sv[i]; }
        __syncthreads();
        int rk[4] = {0, 0, 0, 0};
#pragma unroll 8
        for (int j = 0; j < 32; ++j) { const float o = sc[j * 64 + tk];
#pragma unroll
            for (int i = 0; i < 4; ++i) rk[i] += (int)(o > sv[i]) + (int)((o == sv[i]) & (j < 4 * grp + i)); }
        unsigned bits = 0u;
#pragma unroll
        for (int i = 0; i < 4; ++i) if (rk[i] < 16 && 4 * grp + i <= qt) bits |= 1u << (4 * grp + i);
        if (bits) __hip_atomic_fetch_or(selm + tk, bits, __ATOMIC_RELAXED, __HIP_MEMORY_SCOPE_WORKGROUP);
        __syncthreads();
        mymask = selm[a];
    } else mymask = (qt == 31) ? 0xffffffffu : ((1u << (qt + 1)) - 1u);
    unsigned um = mymask;
    if (qt >= 16) { um = 0u; for (int i = 0; i < 64; ++i) um |= selm[i]; }
    um = (unsigned)__builtin_amdgcn_readfirstlane((int)um);
    const int awave = 32 * (c.wid & 1);
    const LAS float* bwin = (const LAS float*)(c.shm + A_BTW) + head * 256 + (a - 4 * hi + 5);
    auto near_post = [&](int delta, f32x16& p0, f32x16& p1) {
        const LAS float* tb = bwin + 64 * delta;
        const int lim2 = delta == 0 ? a - 4 * hi : 1000;
#pragma unroll
        for (int q4 = 0; q4 < 4; ++q4) {
            float b0[4], b1[4];
#pragma unroll
            for (int i = 0; i < 4; ++i) { b0[i] = tb[59 - 8 * q4 - i]; b1[i] = tb[27 - 8 * q4 - i]; }
            asm volatile("" : "+v"(b0[0]), "+v"(b0[1]), "+v"(b0[2]), "+v"(b0[3]), "+v"(b1[0]), "+v"(b1[1]), "+v"(b1[2]), "+v"(b1[3]));
#pragma unroll
            for (int i = 0; i < 4; ++i) { const int r = 4 * q4 + i, kv = 8 * q4 + i;
                p0[r] = (kv <= lim2) ? p0[r] + b0[i] : -INFINITY; p1[r] = (kv + 32 <= lim2) ? p1[r] + b1[i] : -INFINITY; }
        }
    };
    const bf16* Kw = PROJ + rowbase * NPROJ + C_KWIN + g * 64; const bf16* Vw = PROJ + rowbase * NPROJ + C_VWIN + g * 64;
    const int jlo = qt >= 8 ? qt - 8 : 0; int wpar;
    {
        FlashState s; s.o[0] = splat(0.f); s.o[1] = splat(0.f); s.mhat = 0.f; s.l = 0.f; s.started = false;
        wpar = flash<false>(s, c, qr, Ks, Vs, (long)NPROJ, qt,
            [&](int j) { const unsigned below = j > 0 ? (um & ((1u << j) - 1u)) : 0u; return below ? 31 - __builtin_clz(below) : -1; },
            [&](int j) { return ((mymask >> j) & 1u) ? -s.mhat : -INFINITY; },
            [&](int j, f32x16& p0, f32x16& p1) { const int delta = qt - j; if (delta < 3) near_post(delta, p0, p1); },
            [&](int j) { return qt - j == 0 && false; },
            1, true, Kw, Vw, qt, qt > jlo ? qt - 1 : -1);
        const float lt = swapsum(s.l);
        accum_branch(ot, s.o, gate[(head * 64 + a) * 3 + 1] / lt, c);
    }
    {
        FlashState s; s.o[0] = splat(0.f); s.o[1] = splat(0.f); s.mhat = 0.f; s.l = 0.f; s.started = false;
        flash<false>(s, c, qr, Kw, Vw, (long)NPROJ, qt,
            [&](int j) { return j > jlo ? j - 1 : -1; },
            [&](int) { return -s.mhat; },
            [&](int j, f32x16& p0, f32x16& p1) {
                const int delta = qt - j;
                if (delta < 3) near_post(delta, p0, p1);
                else if (delta == 8) {
#pragma unroll
                    for (int r = 0; r < 16; ++r) { const int kb = crow(r, hi); if (!(kb > a)) p0[r] = -INFINITY; if (!(kb + 32 > a)) p1[r] = -INFINITY; } }
            },
            [&](int j) { return qt - j == 8 && awave == 32 && false; }, wpar, true);
        const float lt = swapsum(s.l);
        accum_branch(ot, s.o, gate[(head * 64 + a) * 3 + 2] / lt, c);
    }
    store_o(ot, c, O + (rowbase + t0 + awave) * 2048 + (g * 4 + head) * 64, SSQ + (rowbase + t0 + awave) * 32 + g * 4 + head);
    asm volatile("s_waitcnt lgkmcnt(0)\n\ts_barrier" ::: "memory");
}
#undef SBAR
#undef WAIT_BAR0
}

constexpr int NWAVES = 8;
constexpr int RING_BYTES = 131072;
constexpr int LDSCTL_OFF = 8 * WSCR, MISC_OFF = LDSCTL_OFF + 320;
constexpr int LDS_BYTES = 163840;
static_assert(LDSCTL_OFF >= RING_BYTES && MISC_OFF + 128 <= LDS_BYTES, "LDS map");
constexpr int CW_BAR = 4096;
constexpr int N_BAR_REGIONS = 12;
constexpr int CW_KN2 = 1024;
constexpr int CW_Q8 = 49152, CW_Q9 = 53248;
constexpr int CW_TMO2 = 57344;
constexpr int CW_RDY = 65536;
constexpr int CW_CQ = 58368, CW_DONE1 = 59392, CW_DONE3 = 60416;
constexpr int CW_NCNT = 81920;
constexpr int I_DLATE = 5632;
constexpr int CW_QUEUE = 2048;
static_assert((CW_BAR + N_BAR_REGIONS * XCD_BAR_WORDS) * 4 <= (int)CTL_ZERO_BYTES, "barrier words inside the memset region");

struct Args { const float* in[23]; float* out; unsigned char* ws; int ph_lo, ph_hi, li, pad; };

template <class ColOf, class RowOf, class ScaleOf>
__device__ __forceinline__ void tr_item(const float* W, size_t pitch, int k0, int n0, LAS float* scr, int lane, bf16* WT, int Kdst, const float* ks, ColOf colof, RowOf rowof, ScaleOf scaleof) {
    const int nl = lane & 31; const int sc = colof(n0 + nl);
#pragma unroll 8
    for (int i = 0; i < 32; ++i) { const int kk = 2 * i + (lane >> 5); scr[kk * 33 + nl] = W[(size_t)(k0 + kk) * pitch + sc]; }
    LDS_WAIT(); asm volatile("" ::: "memory");
    const int c = lane & 7; float kf[8];
#pragma unroll
    for (int j = 0; j < 8; ++j) kf[j] = ks ? ks[k0 + 8 * c + j] : 1.f;
#pragma unroll
    for (int j = 0; j < 4; ++j) { const int n = (lane >> 3) + 8 * j; const LAS float* s = scr + (8 * c) * 33 + n; const float cs = scaleof(n0 + n);
        v4u o; o.x = pk2(s[0 * 33] * kf[0] * cs, s[1 * 33] * kf[1] * cs); o.y = pk2(s[2 * 33] * kf[2] * cs, s[3 * 33] * kf[3] * cs);
        o.z = pk2(s[4 * 33] * kf[4] * cs, s[5 * 33] * kf[5] * cs); o.w = pk2(s[6 * 33] * kf[6] * cs, s[7 * 33] * kf[7] * cs);
        *(GAS v4u*)(WT + (size_t)rowof(n0 + n) * Kdst + k0 + 8 * c) = o; }
    LDS_WAIT(); asm volatile("" ::: "memory");
}
template <class DstOf>
__device__ __forceinline__ void tr_item_chunks(const float* W, size_t pitch, int k0, int n0, LAS float* scr, int lane, bf16* WT, DstOf dstof) {
    const int nl = lane & 31;
#pragma unroll 8
    for (int i = 0; i < 32; ++i) { const int kk = 2 * i + (lane >> 5); scr[kk * 33 + nl] = W[(size_t)(k0 + kk) * pitch + n0 + nl]; }
    LDS_WAIT(); asm volatile("" ::: "memory");
    const int c = lane & 7;
#pragma unroll
    for (int j = 0; j < 4; ++j) { const int n = (lane >> 3) + 8 * j; const LAS float* s = scr + (8 * c) * 33 + n;
        v4u o; o.x = pk2(s[0 * 33], s[1 * 33]); o.y = pk2(s[2 * 33], s[3 * 33]); o.z = pk2(s[4 * 33], s[5 * 33]); o.w = pk2(s[6 * 33], s[7 * 33]);
        *(GAS v4u*)(WT + dstof(n0 + n, k0 + 8 * c)) = o; }
    LDS_WAIT(); asm volatile("" ::: "memory");
}
__device__ __forceinline__ void tr8_load(f32x4 (&v)[8], const float* W, size_t pitch, int k0, int n0, int lane) {
    const int r8 = lane >> 3, c4 = (lane & 7) * 4;
#pragma unroll
    for (int i = 0; i < 8; ++i) v[i] = *(const GAS f32x4*)(W + (size_t)(k0 + 8 * i + r8) * pitch + n0 + c4);
}
template <class RowOf>
__device__ __forceinline__ void tr8_finish(const f32x4 (&v)[8], int k0, int n0, LAS float* scr, int lane, unsigned char* WT, int Kdst, const float* ks, RowOf rowof) {
    { const int r8 = lane >> 3, c4 = (lane & 7) * 4;
#pragma unroll
        for (int i = 0; i < 8; ++i) { LAS float* d = scr + (8 * i + r8) * 33 + c4; d[0] = v[i][0]; d[1] = v[i][1]; d[2] = v[i][2]; d[3] = v[i][3]; } }
    LDS_WAIT(); asm volatile("" ::: "memory");
    const int c = lane & 3; float kf[16];
#pragma unroll
    for (int j = 0; j < 16; ++j) kf[j] = (ks ? ks[k0 + 16 * c + j] : 1.f) * 64.f;
#pragma unroll
    for (int j = 0; j < 2; ++j) { const int n = (lane >> 2) + 16 * j; const LAS float* s = scr + (16 * c) * 33 + n;
        v4u o;
#define W8(i) __builtin_amdgcn_fmed3f(s[(i) * 33] * kf[i], -448.f, 448.f)
        o.x = pg8::pk_fp8x4(W8(0), W8(1), W8(2), W8(3)); o.y = pg8::pk_fp8x4(W8(4), W8(5), W8(6), W8(7));
        o.z = pg8::pk_fp8x4(W8(8), W8(9), W8(10), W8(11)); o.w = pg8::pk_fp8x4(W8(12), W8(13), W8(14), W8(15));
#undef W8
        *(GAS v4u*)(WT + (size_t)rowof(n0 + n) * Kdst + k0 + 16 * c) = o; }
    LDS_WAIT(); asm volatile("" ::: "memory");
}
template <class RowOf>
__device__ __forceinline__ void tr_item8(const float* W, size_t pitch, int k0, int n0, LAS float* scr, int lane, unsigned char* WT, int Kdst, const float* ks, RowOf rowof) {
    f32x4 v[8]; tr8_load(v, W, pitch, k0, n0, lane); tr8_finish(v, k0, n0, scr, lane, WT, Kdst, ks, rowof);
}
__device__ __forceinline__ void rms_row_load(f32x4 (&v)[8], const float* xrow, int lane) {
    const GAS f32x4* xr = (const GAS f32x4*)xrow + lane;
#pragma unroll
    for (int j = 0; j < 8; ++j) v[j] = xr[64 * j];
}
__device__ __forceinline__ void rms_row_finish(const f32x4 (&v)[8], const float* w, bf16* orow, int lane) {
    const GAS f32x4* wr = (const GAS f32x4*)w + lane; float s = 0.f;
#pragma unroll
    for (int j = 0; j < 8; ++j) s += (v[j].x * v[j].x + v[j].y * v[j].y) + (v[j].z * v[j].z + v[j].w * v[j].w);
    const float r = 1.f / sqrtf(wave_sum(s) * (1.f / 2048.f) + NORM_EPS);
    GAS unsigned long long* o8 = (GAS unsigned long long*)orow + lane;
#pragma unroll
    for (int j = 0; j < 8; ++j) { const f32x4 ww = wr[64 * j]; o8[64 * j] = (unsigned long long)pk2(v[j].x * r * ww.x, v[j].y * r * ww.y) | ((unsigned long long)pk2(v[j].z * r * ww.z, v[j].w * r * ww.w) << 32); }
}

constexpr int N_PHASES = 11;
#ifndef MK_N_LAUNCHES
#define MK_N_LAUNCHES 1
#endif

#ifndef CODE_PF_BYTES
#define CODE_PF_BYTES 139264
#endif
__device__ __forceinline__ void code_prefetch(unsigned long long pc0, int lane, unsigned lds_dummy) {
#if defined(__HIP_DEVICE_COMPILE__)
    const char* p = (const char*)(pc0 & ~127ull) + lane * 128;
    unsigned keep;
#pragma unroll 1
    for (int off = 0; off < CODE_PF_BYTES; off += 8192)
        asm volatile("s_mov_b32 %0, m0\n\ts_mov_b32 m0, %2\n\ts_nop 0\n\tglobal_load_lds_dword %1, off\n\ts_mov_b32 m0, %0" : "=&s"(keep) : "v"(p + off), "s"(lds_dummy) : "memory");
#endif
}
__global__ void __launch_bounds__(NWAVES * 64, 2) mk(Args args) {
    unsigned long long pc0 = 0;
#if defined(__HIP_DEVICE_COMPILE__)
    asm volatile("s_getpc_b64 %0" : "=s"(pc0));
#endif
    extern __shared__ __attribute__((aligned(16))) unsigned char lds[];
    LAS unsigned char* L = (LAS unsigned char*)lds;
    volatile LAS unsigned* MISC = (volatile LAS unsigned*)(L + MISC_OFF);
    const int tid = threadIdx.x, lane = tid & 63, wave = __builtin_amdgcn_readfirstlane(tid >> 6);
    const int G = gridDim.x; const int bx = blockIdx.x; const int vcu = (G % 8 == 0) ? (bx % 8) * (G / 8) + bx / 8 : bx;
    const int gw = vcu * NWAVES + wave, NGW = G * NWAVES;
    unsigned char* ws = args.ws;
    gu32* ctl = (gu32*)(ws + WS_CTL);
    for (int u = tid; u < (LDS_BYTES - LDSCTL_OFF) / 4; u += NWAVES * 64) ((LAS unsigned*)(L + LDSCTL_OFF))[u] = 0u;
    __syncthreads();
    XcdBarrier bar = xcd_barrier_post((unsigned*)(ctl + CW_BAR) + args.li * XCD_BAR_WORDS, MISC + 8);
    const int lo = args.ph_lo, hi = args.ph_hi;
#ifdef ONLY_PHASE
#define IN(k) ((k) == ONLY_PHASE && lo <= (k) && (k) < hi)
#else
#define IN(k) (lo <= (k) && (k) < hi)
#endif
#ifndef CODE_PF_ON
#define CODE_PF() do { } while (0)
#else
#define CODE_PF() do { if (wave == NWAVES - 1) code_prefetch(pc0, lane, (unsigned)__builtin_amdgcn_readfirstlane((unsigned)(unsigned long long)(L + LDSCTL_OFF + 15360))); } while (0)
#endif
    CODE_PF();
#define SEAM(k) do { if (IN(k) && IN((k) + 1)) { xcd_barrier(bar); CODE_PF(); } } while (0)
    bf16* WinT = (bf16*)(ws + WS_WIN_T); bf16* WoutT = (bf16*)(ws + WS_WOUT_T); bf16* WguT = (bf16*)(ws + WS_WGU_T); bf16* WdT = (bf16*)(ws + WS_WD_T);
    bf16* XN = (bf16*)(ws + WS_XN); bf16* PROJ = (bf16*)(ws + WS_PROJ); float* GF = (float*)(ws + WS_GF); bf16* HB = (bf16*)(ws + WS_HB);
    bf16* O = (bf16*)(ws + WS_XN); bf16* MIXED = (bf16*)(ws + WS_PROJ); bf16* XS = (bf16*)(ws + WS_PROJ); bf16* YS = (bf16*)(ws + WS_PROJ); bf16* HID = (bf16*)(ws + WS_XN);
    unsigned char* Wgu8 = ws + WS_WGU_T; unsigned char* Wd8 = ws + WS_WD_T; unsigned char* HB8 = ws + WS_WGU_T + 64 * MiB; unsigned char* HID8 = ws + WS_XN;
    bf16* WrT = (bf16*)(ws + WS_WRT); bf16* W1T = (bf16*)(ws + WS_W1T); float* B1 = (float*)(ws + WS_B1);
    bf16* KC = (bf16*)(ws + WS_KC); bf16* VC = (bf16*)(ws + WS_VC); float* CUM = (float*)(ws + WS_CUM);
    float* SSQ = (float*)(ws + WS_SSQ); float* HSSQ = (float*)(ws + WS_HSSQ);
    int* EID = (int*)(ws + WS_ROUTE); float* WT = (float*)(ws + WS_ROUTE + 131072); float* RSTD = (float*)(ws + WS_ROUTE + 262144); int* LRANK = (int*)(ws + WS_ROUTE + 393216);
    int* CNTW = (int*)(ws + WS_SORT + 2 * MiB);
    int* NTp = (int*)(ws + WS_SORT + 512); int* TEXP = (int*)(ws + WS_SORT + 1024);
    int* RDST = (int*)(ws + WS_SORT + 65536); float* RWT = (float*)(ws + WS_SORT + 262144); float* RSTDS = (float*)(ws + WS_SORT + 458752);
    LAS float* wscr = (LAS float*)(L + wave * WSCR);

    if (IN(0)) {
        LAS float* scr = wscr;
        const float* w_in = args.in[2]; const float* w_out = args.in[13]; const float* wgate = args.in[19]; const float* wup = args.in[20]; const float* wdown = args.in[21];
        const float* nsa_w = args.in[11]; const float* fox_w = args.in[12]; const float* ffn_w = args.in[14];
        constexpr int I_IN = 32 * 178, I_OUT = 32 * 64, I_GU = 32 * 32 * 16, I_D = 32 * 8 * 64;
        constexpr int NITEMS = I_IN + I_OUT + 2 * I_GU + I_D;
        for (int it = gw; it < NITEMS; it += NGW) {
            int r = it;
            if (r < 2 * I_GU) { const int up = r >= I_GU; if (up) r -= I_GU; const int e = r / 512, q = r % 512, kb = q / 16, nb = q % 16;
                const float* src = (up ? wup : wgate) + (size_t)e * 2048 * 512; const int rb = e * 1024 + (up ? 128 : 0);
                tr_item8(src, 512, 64 * kb, 32 * nb, scr, lane, Wgu8, 2048, ffn_w, [rb](int j) { return rb + (j >> 7) * 256 + (j & 127); });
                continue; } r -= 2 * I_GU;
            if (r < I_D) { if (G == 256 && r < I_DLATE) continue;
                const int e = r / 512, q = r % 512, kb = q / 64, nb = q % 64; const float* src = wdown + (size_t)e * 512 * 2048; const int rb = e * 2048;
                tr_item8(src, 2048, 64 * kb, 32 * nb, scr, lane, Wd8, 512, nullptr, [rb](int j) { return rb + j; });
                continue; } r -= I_D;
            if (r < I_OUT) { const int kb = r / 64, nb = r % 64; const float* ks = (kb < 16) ? nsa_w : fox_w - 1024;
                tr_item(w_out, 2048, 64 * kb, 32 * nb, scr, lane, WoutT, 2048, ks, [](int j) { return j; }, [](int j) { return j; }, [](int) { return 1.f; });
                continue; } r -= I_OUT;
            { const int kb = r / 178, nb = r % 178;
                tr_item(w_in, 5696, 64 * kb, 32 * nb, scr, lane, WinT, 2048, nullptr,
                        [](int j) { return j < 2560 ? j : (j < 5632 ? j + 48 : (j < 5680 ? j - 5632 + 2560 : j)); }, [](int j) { return j; },
                        [](int j) { return (j < 1024 || (j >= 2560 && j < 3584)) ? C2 : 1.f; }); }
        }
        for (int i = gw * 64 + lane; i < 192 * 256; i += NGW * 64) ((GAS v4u*)(WinT + (size_t)5696 * 2048))[i] = (v4u){0u, 0u, 0u, 0u};
        for (int it = gw; it < 2 * 128; it += NGW) { const int kvv = it >> 7, q = it & 127, kb = q >> 2, nb = q & 3; const float* src = kvv ? args.in[7] : args.in[5];
            tr_item_chunks(src, 128, 64 * kb, 32 * nb, scr, lane, W1T, [kvv](int n, int k) { return (size_t)(kvv * 8 + (k >> 8)) * 32768 + ((k >> 4) & 15) * 2048 + (n >> 5) * 512 + ((k >> 3) & 1) * 256 + (n & 31) * 8; }); }
        for (int it = gw; it < 2 * 128; it += NGW) { const int kvv = it >> 7, j = it & 127; const float* w1 = kvv ? args.in[7] : args.in[5]; const float* pe = kvv ? args.in[4] : args.in[3];
            float s = 0.f; for (int i = lane; i < 2048; i += 64) s += pe[i] * w1[(size_t)i * 128 + j];
            s = wave_sum(s); if (lane == 0) B1[it] = s; }
        for (int i = gw * 64 + lane; i < 64 * 2048; i += NGW * 64) { const int o = i >> 11, k = i & 2047;
            const float v = (o < 4 ? args.in[15][(size_t)k * 4 + o] : (o < 36 ? args.in[17][(size_t)k * 32 + (o - 4)] : 0.f)) * ffn_w[k];
            const int f = (((k >> 8) * 16 + ((k >> 4) & 15)) * 2 + (o >> 5)) * 512 + ((k >> 3) & 1) * 256 + (o & 31) * 8 + (k & 7);
            const unsigned short h = (unsigned short)f2bf(v); WrT[f] = h; WrT[64 * 2048 + f] = (unsigned short)f2bf(v - bf2f(h)); }
        for (int m = gw; m < NTOK; m += NGW) { f32x4 v[8]; rms_row_load(v, args.in[0] + (size_t)m * DM, lane); rms_row_finish(v, args.in[1], XN + (size_t)m * DM, lane); }
    }
    SEAM(0);
    if (IN(1)) {
        pg8::Gemm g{XN, WinT, NTOK, NPROJ_PAD, DM, DM}; pg8::StaticOrder S; S.init(NTOK, NPROJ_PAD, G, bx);
        pg8::EpiProj E{PROJ, GF};
        pg8::gemm_phase<pg8::EpiProj, pg8::StaticOrder, true, true>(L, g, S, E);
        if (G == 256 && bx >= 192) { const float* wdown = args.in[21];
            for (int r = (bx - 192) * NWAVES + wave; r < I_DLATE; r += 64 * NWAVES) { const int e = r / 512, q = r % 512, kb = q / 64, nb = q % 64; const float* src = wdown + (size_t)e * 512 * 2048; const int rb = e * 2048;
                tr_item8(src, 2048, 64 * kb, 32 * nb, wscr, lane, Wd8, 512, nullptr, [rb](int j) { return rb + j; }); } }
    }
    SEAM(1);
    if (IN(2)) {
#ifndef P2SKIP
#define P2SKIP 0
#endif
        if (!((P2SKIP & 1) && args.li == 1)) if (bx < 128) cumsum_wg(bx, wave, lane, GF, args.in[10], CUM, (LAS float*)(L + LDSCTL_OFF + 4096));
        if (!((P2SKIP & 2) && args.li == 1)) knorm_item(bx * 8 + wave, lane, PROJ, (unsigned*)(ctl + CW_KN2));
        if (!((P2SKIP & 4) && args.li == 1)) {
#ifdef COMPRESS_NAIVE
        for (int it = gw; it < 8 * 128 * 4 * 2; it += NGW) compress_item(it, lane, wscr, PROJ, args.in[3], args.in[4], args.in[5], args.in[6], args.in[7], args.in[8], KC, VC);
#else
        if (bx < 254) compress_mfma(bx, tid, lane, wave, (LAS float*)L, (LAS float*)(L + RING_BYTES), PROJ, W1T, B1, args.in[6], args.in[8], KC, VC);
        else if (tid < 256) { bf16* z = (bx == 254 ? KC : VC) + ((size_t)((tid >> 5) * 128 + 127) * 4) * 64 + (tid & 31) * 8; *(v4u*)z = (v4u){0u, 0u, 0u, 0u}; }
#endif
        }
    }
    SEAM(2);
    if (IN(3)) {
#ifdef ATTN_NAIVE
        for (int it = gw; it < NTOK * 4; it += NGW) nsa_item(it, lane, wscr, PROJ, KC, VC, args.in[9], GF, O, SSQ);
        for (int it = gw; it < NTOK * 16; it += NGW) fox_item(it, lane, wscr, PROJ, CUM, O, SSQ);
#else
        LAS int* qslot = (LAS int*)(L + att::A_QSLOT);
        unsigned* qhead = (unsigned*)(ctl + CW_QUEUE + 64 * args.li);
        int u = bx; unsigned pend = 0u;
#ifdef Q3_AHEAD
        if (tid == 0) pend = __hip_atomic_fetch_add(qhead, 1u, __ATOMIC_RELAXED, __HIP_MEMORY_SCOPE_AGENT) + (unsigned)G;
#endif
        for (;; ) {
            if (u >= 2048) break;
            const int k = 7 - (u >> 8), off = u & 255;
            int tid_ = tid; asm volatile("" : "+v"(tid_));
            const att::Ctx c{tid_, tid_ & 63, tid_ & 31, (tid_ >> 5) & 1, wave, (LAS char*)L, (unsigned)(unsigned long)L};
#ifndef PROBE_ATT
#define PROBE_ATT 0
#endif
#ifndef DBG_NO_FOX
            if (off < 128) { if (!(PROBE_ATT == 2 && args.li == 1)) att::fox_unit(c, off >> 4, off & 15, k, PROJ, CUM, (const unsigned*)(ctl + CW_KN2), O, SSQ, (unsigned*)(ctl + CW_NCNT)); }
#else
            if (off < 128) {}
#endif
#ifndef DBG_NO_NSA
            else if (!(PROBE_ATT == 1 && args.li == 1)) { const int o2 = off - 128; att::nsa_unit(c, (o2 & 31) >> 2, o2 & 3, 4 * k + 3 - (o2 >> 5), PROJ, KC, VC, args.in[9], GF, O, SSQ, (unsigned*)(ctl + CW_NCNT)); }
#endif
#ifndef Q3_AHEAD
            if (tid == 0) pend = __hip_atomic_fetch_add(qhead, 1u, __ATOMIC_RELAXED, __HIP_MEMORY_SCOPE_AGENT) + (unsigned)G;
#endif
            if (tid == 0) *qslot = (int)pend;
            __syncthreads();
            u = __builtin_amdgcn_readfirstlane(*qslot);
#ifdef Q3_AHEAD
            if (tid == 0 && u < 2048) pend = __hip_atomic_fetch_add(qhead, 1u, __ATOMIC_RELAXED, __HIP_MEMORY_SCOPE_AGENT) + (unsigned)G;
#endif
        }
#endif
    }
    SEAM(3);
#ifdef NORM_PASS
    if (IN(4)) { for (int m = gw; m < NTOK; m += NGW) normalize_item((size_t)m, lane, O, SSQ, MIXED); }
#endif
#ifdef NORM_PASS
    SEAM(4);
#endif
    if (IN(5)) {
        pg8::Gemm g{O, WoutT, NTOK, DM, DM / 2, DM}; pg8::StaticOrder2 S; S.S.init(NTOK, DM, G, bx); S.khalf = DM / 2;
        LAS float* RT = (LAS float*)(L + RING_BYTES);
        pg8::Unit u0, u1; const bool h0 = S.S.next(0, u0), h1 = S.S.next(1, u1);
        { const pg8::Unit& ut = (tid < 256) ? u0 : u1; const bool hv = (tid < 256) ? h0 : h1;
            if (hv) { const float* sp = SSQ + ((size_t)ut.pm * 256 + (tid & 255)) * 32; float sa = 0.f, sf = 0.f;
#pragma unroll
                for (int i = 0; i < 4; ++i) { const f32x4 a4 = *(const f32x4*)(sp + 4 * i), f4 = *(const f32x4*)(sp + 16 + 4 * i); sa += (a4[0] + a4[1]) + (a4[2] + a4[3]); sf += (f4[0] + f4[1]) + (f4[2] + f4[3]); }
                const float ra = 1.f / sqrtf(sa * (1.f / 1024.f) + NORM_EPS), rf = 1.f / sqrtf(sf * (1.f / 1024.f) + NORM_EPS);
                RT[tid * 2] = ra / rf; RT[tid * 2 + 1] = rf; } }
        __syncthreads();
        pg8::EpiOut E{args.in[0], HB, HSSQ, SSQ, HB8, RT, u0.pm, u0.pn};
        pg8::gemm_phase<pg8::EpiOut, pg8::StaticOrder2, true, true>(L, g, S, E);
    }
    SEAM(5);
    const int TPW = NTOK / G;
    LAS int* elist = (LAS int*)(L + LDSCTL_OFF + 4096);
    if (IN(6)) {
#ifdef P6REP
#pragma unroll 1
      for (int rep6 = 0; rep6 < (args.li == 1 ? 2 : 1); ++rep6) { const int bx6 = rep6 ? ((bx + 128) & 255) : bx;
#else
      { const int bx6 = bx;
#endif
#ifdef P6WARM
        if (args.li == 1) { for (int i = tid; i < 256 * 1024 / 16; i += 512) { v4u v = ((const v4u*)(HB + (size_t)bx6 * 64 * 2048))[i]; asm volatile("" :: "v"(v.x)); }
            for (int i = tid; i < 512 * 1024 / 16; i += 512) { v4u v = ((const v4u*)WrT)[i]; asm volatile("" :: "v"(v.x)); }
            __syncthreads(); }
#endif
        LAS float* part = (LAS float*)L;
        const float bias_r = tid < 4 ? args.in[16][tid] : (tid < 36 ? args.in[18][tid - 4] : 0.f);
        const f32x4 hs4 = *(const f32x4*)(HSSQ + (size_t)bx6 * TPW * 32 + tid * 4);
#ifndef P6SKIP
#define P6SKIP 0
#endif
        if (!((P6SKIP & 1) && args.li == 1)) router_mfma(bx6, tid, lane, wave, part, HB, WrT);
        __syncthreads();
        if (!((P6SKIP & 2) && args.li == 1)) {
        LAS float* lgt = (LAS float*)(L + RING_BYTES);
        LAS float* ssl = lgt + TPW * 36;
        LAS float* bsl = ssl + TPW; if (tid < 36) bsl[tid] = bias_r;
        { float ss = (hs4[0] + hs4[1]) + (hs4[2] + hs4[3]); ss += __shfl_xor(ss, 1); ss += __shfl_xor(ss, 2); ss += __shfl_xor(ss, 4); if ((tid & 7) == 0) ssl[tid >> 3] = ss; }
        for (int i = tid; i < TPW * 36; i += NWAVES * 64) { const int tk = i / 36, o = i % 36; float s = 0.f;
#pragma unroll
            for (int w = 0; w < 8; ++w) s += part[w * 4096 + tk * 64 + o];
            lgt[i] = s; }
        __syncthreads();
        if (tid < TPW) { const size_t tok = (size_t)bx6 * TPW + tid; const LAS float* lg = lgt + tid * 36;
            const float ss = ssl[tid];
            const float rstd = 1.f / sqrtf(ss * (1.f / 2048.f) + NORM_EPS);
            const LAS float* bg = bsl; const LAS float* be = bsl + 4;
            float gl[4]; int gsel = 0;
#pragma unroll
            for (int i = 0; i < 4; ++i) gl[i] = lg[i] * rstd + bg[i];
            float gm = gl[0];
#pragma unroll
            for (int i = 1; i < 4; ++i) if (gl[i] > gm) { gm = gl[i]; gsel = i; }
            float den = 0.f;
#pragma unroll
            for (int i = 0; i < 4; ++i) den += expf(gl[i] - gm);
            const float pgs = 1.f / den;
            int i1 = 0, i2 = 0; float v1 = -INFINITY, v2 = -INFINITY;
            for (int j = 0; j < 8; ++j) { const float v = lg[4 + gsel * 8 + j] * rstd + be[gsel * 8 + j];
                if (v > v1) { v2 = v1; i2 = i1; v1 = v; i1 = j; } else if (v > v2) { v2 = v; i2 = j; } }
            const float ex = expf(v2 - v1), d2 = 1.f / (1.f + ex);
            const int e0 = gsel * 8 + i1, e1 = gsel * 8 + i2;
            EID[tok * 2] = e0; EID[tok * 2 + 1] = e1; WT[tok * 2] = d2 * pgs; WT[tok * 2 + 1] = ex * d2 * pgs; RSTD[tok] = rstd; elist[tid * 2] = e0; elist[tid * 2 + 1] = e1; }
        __syncthreads();
        LAS int* cntl = elist + 2 * TPW; int e = 0, rk = 0;
        if (tid < 2 * TPW) { e = elist[tid]; int cnt = 0;
#ifdef P6ROLL
#pragma unroll 1
#endif
            for (int ee = 0; ee < 32; ++ee) { const unsigned long long m = __ballot(e == ee); if (e == ee) rk = __popcll(m & ((1ull << lane) - 1ull)); if (lane == ee) cnt = __popcll(m); }
            if (lane < 32) cntl[wave * 32 + lane] = cnt; }
        __syncthreads();
        if (tid < 2 * TPW) LRANK[(size_t)bx6 * 2 * TPW + tid] = rk + (wave ? cntl[e] : 0);
        if (tid < 32) CNTW[bx6 * 32 + tid] = cntl[tid] + cntl[32 + tid];
        __syncthreads();
        }
      }
    }
    SEAM(6);
    if (IN(7)) {
        LAS int* cw = (LAS int*)L;
        LAS int* tot = (LAS int*)(L + 65536); LAS int* mine = tot + 32; LAS int* base = tot + 64; LAS int* rowof = tot + 128;
        int e7 = 0, lr7 = 0; float wt7 = 0.f, rs7 = 0.f;
        { int cv[16];
#pragma unroll
            for (int k = 0; k < 16; ++k) cv[k] = CNTW[tid + 512 * k];
            if (tid < 2 * TPW) { const int entry = bx * 2 * TPW + tid; e7 = EID[entry]; lr7 = LRANK[entry]; wt7 = WT[entry]; rs7 = RSTD[entry >> 1]; }
#pragma unroll
            for (int k = 0; k < 16; ++k) cw[tid + 512 * k] = cv[k]; }
        __syncthreads();
        if (tid < 32) { int t = 0, m = 0; for (int w = 0; w < G; ++w) { const int c = cw[w * 32 + tid]; t += c; m += (w < bx) ? c : 0; } tot[tid] = t; mine[tid] = m; }
        __syncthreads();
        if (tid == 0) { int acc = 0; for (int e = 0; e < 32; ++e) { base[e] = acc; acc += (tot[e] + 255) & ~255; } base[32] = acc; }
        __syncthreads();
        if (bx == 0) { if (tid == 0) NTp[0] = base[32] >> 8; if (tid < 32) for (int tl = base[tid] >> 8; tl < (base[tid + 1] >> 8); ++tl) TEXP[tl] = tid; }
        if (tid < 2 * TPW) { const int entry = bx * 2 * TPW + tid; const int row = base[e7] + mine[e7] + lr7;
            RDST[row] = entry; RWT[row] = wt7; RSTDS[row] = rs7; }
        if (bx < 32) { const int e = bx; for (int row = base[e] + tot[e] + tid; row < base[e + 1]; row += NWAVES * 64) { RDST[row] = -1; RWT[row] = 0.f; RSTDS[row] = 0.f; } }
        __syncthreads();
    }
    SEAM(7);
    LAS int* qsl = (LAS int*)(L + LDSCTL_OFF + 8192);
    unsigned* RDY = (unsigned*)(ctl + CW_RDY); unsigned* TMO2 = (unsigned*)(ctl + CW_TMO2);
    if (IN(8)) {
        const int nt = ld_i32(NTp);
        pg8::Gemm g{(const bf16*)HB8, (const bf16*)Wgu8, MAXROWS, 1024, DM / 2, DM / 2}; pg8::QueueOrder S{nt, 4, TEXP, RDST, (unsigned*)(ctl + CW_Q8 + 64 * args.li), qsl, nullptr, 0u, RDY, TMO2};
        pg8::EpiGateUp E{HID8, RSTDS};
        pg8::gemm_phase_g<pg8::EpiGateUp, pg8::QueueOrder, true, true, true>(L, g, S, E);
    }
    if (IN(9)) {
        const int nt = ld_i32(NTp);
        pg8::Gemm g{(const bf16*)HID8, (const bf16*)Wd8, MAXROWS, 2048, EFF / 2, EFF / 2}; pg8::QueueOrder S{nt, 8, TEXP, RDST, (unsigned*)(ctl + CW_Q9 + 64 * args.li), qsl + 4, RDY, 32u, nullptr, TMO2};
        pg8::EpiDown E{(unsigned char*)YS, RDST, RWT};
        pg8::gemm_phase<pg8::EpiDown, pg8::QueueOrder, true, true, true>(L, g, S, E);
    }
    SEAM(9);
    if (IN(10)) { for (int m = gw; m < NTOK; m += NGW) final_item((size_t)m, lane, HB, (const unsigned char*)YS, args.in[22], args.out); }
#undef IN
#undef SEAM
}

extern "C" void kernel_launch(void* const* d_in, const int* in_sizes, int n_in, void* d_out, int out_size, void* d_ws, size_t ws_size, hipStream_t stream) {
    static int grid = 0;
    if (grid == 0) {
        if (n_in != 23 || in_sizes[0] != NTOK * DM || out_size != NTOK * DM || ws_size < WS_END) { fprintf(stderr, "kernel_launch: unexpected shapes (n_in %d, in0 %d, out %d, ws %zu < %zu)\n", n_in, n_in > 0 ? in_sizes[0] : -1, out_size, ws_size, (size_t)WS_END); grid = -1; return; }
        int dev = 0, cus = 0;
        if (hipGetDevice(&dev) != hipSuccess || hipDeviceGetAttribute(&cus, hipDeviceAttributeMultiprocessorCount, dev) != hipSuccess) { grid = -1; return; }
        if (hipFuncSetAttribute((const void*)mk, hipFuncAttributeMaxDynamicSharedMemorySize, LDS_BYTES) != hipSuccess) { fprintf(stderr, "kernel_launch: hipFuncSetAttribute failed\n"); grid = -1; return; }
        int per_cu = 0;
        if (hipOccupancyMaxActiveBlocksPerMultiprocessor(&per_cu, (const void*)mk, NWAVES * 64, LDS_BYTES) != hipSuccess || per_cu < 1) fprintf(stderr, "kernel_launch: occupancy query says %d\n", per_cu);
        (void)hipGetLastError();
        if (cus != 256) { fprintf(stderr, "kernel_launch: built for a 256-CU device, found %d CUs; nothing launched\n", cus); grid = -1; return; }
        grid = cus;
    }
    if (grid < 0) return;
    unsigned char* ws = (unsigned char*)d_ws;
    (void)hipMemsetAsync(ws + WS_CTL, 0, CTL_ZERO_BYTES, stream);
    Args a{};
    for (int i = 0; i < 23; ++i) a.in[i] = (const float*)d_in[i];
    a.out = (float*)d_out; a.ws = ws;
#ifdef PROBE_PREFIX
    a.ph_lo = 0; a.ph_hi = N_PHASES; a.li = 0; hipLaunchKernelGGL(mk, dim3(grid), dim3(NWAVES * 64), LDS_BYTES, stream, a);
    a.ph_lo = 0; a.ph_hi = PROBE_PREFIX; a.li = 1; hipLaunchKernelGGL(mk, dim3(grid), dim3(NWAVES * 64), LDS_BYTES, stream, a);
#elif defined(PROBE_PHASE)
#ifndef PROBE_END
#define PROBE_END (PROBE_PHASE + 1)
#endif
    { const int cuts[4] = {0, PROBE_END, PROBE_END, N_PHASES}; const int los[3] = {0, PROBE_PHASE, PROBE_END};
      for (int i = 0; i < 3; ++i) { a.ph_lo = los[i]; a.ph_hi = cuts[i + 1] == PROBE_END && i == 0 ? PROBE_END : (i == 1 ? PROBE_END : N_PHASES); a.li = i; if (a.ph_lo < a.ph_hi) hipLaunchKernelGGL(mk, dim3(grid), dim3(NWAVES * 64), LDS_BYTES, stream, a); } }
#else
    if (MK_N_LAUNCHES == 1) { a.ph_lo = 0; a.ph_hi = N_PHASES; a.li = 0; hipLaunchKernelGGL(mk, dim3(grid), dim3(NWAVES * 64), LDS_BYTES, stream, a); }
    else for (int p = 0; p < N_PHASES; ++p) { a.ph_lo = p; a.ph_hi = p + 1; a.li = p; hipLaunchKernelGGL(mk, dim3(grid), dim3(NWAVES * 64), LDS_BYTES, stream, a); }
#endif
}
```

```cpp
#include <hip/hip_runtime.h>
#include <cstdio>
#include <cstdint>

constexpr int BATCH = 8, SEQ = 2048, DM = 2048, NTOK = BATCH * SEQ;
constexpr int NPROJ = 5632, NPROJ_PAD = 5888;
constexpr int C_NQ = 0, C_KCMP = 1024, C_VCMP = 1280, C_KSLC = 1536, C_VSLC = 1792, C_KWIN = 2048, C_VWIN = 2304, C_FQ = 2560, C_FK = 3584, C_FV = 4608;
constexpr int NEXP = 32, EFF = 512;
constexpr int MAXROWS = 40960;
constexpr float NORM_EPS = 1e-6f;
constexpr float LOG2E = 1.4426950408889634f;
constexpr float C2 = 0.125f * LOG2E;

constexpr size_t MiB = 1u << 20;
constexpr size_t WS_CTL = 0, CTL_ZERO_BYTES = 1 * MiB;
constexpr size_t WS_WIN_T = 1 * MiB;
constexpr size_t WS_WOUT_T = 24 * MiB;
constexpr size_t WS_WGU_T = 32 * MiB;
constexpr size_t WS_WD_T = 160 * MiB;
constexpr size_t WS_W1T = 224 * MiB;
constexpr size_t WS_KC = 225 * MiB;
constexpr size_t WS_VC = WS_KC + 512 * 1024;
constexpr size_t WS_CUM = 226 * MiB;
constexpr size_t WS_GF = 227 * MiB;
constexpr size_t WS_SSQ = 231 * MiB;
constexpr size_t WS_HSSQ = 233 * MiB;
constexpr size_t WS_B1 = 235 * MiB;
constexpr size_t WS_WRT = 235 * MiB + 512 * 1024;
constexpr size_t WS_ROUTE = 236 * MiB;
constexpr size_t WS_SORT = 237 * MiB;
constexpr size_t WS_XN = 244 * MiB;
constexpr size_t WS_PROJ = 308 * MiB;
constexpr size_t WS_HB = 484 * MiB;
constexpr size_t WS_END = 548 * MiB;
namespace pg8 {
#define PG8_LAS __attribute__((address_space(3)))
typedef unsigned short bf16_t;
typedef short bf16x8 __attribute__((ext_vector_type(8)));
typedef float f32x4 __attribute__((ext_vector_type(4)));
typedef unsigned u32x4 __attribute__((ext_vector_type(4)));
constexpr int BM = 256, BK = 64, HALF = 128, HTB = HALF * BK * 2  , STAGE_BYTES = 8 * HTB, NXCD = 8, WGM = 8;

__host__ __device__ __forceinline__ int lds_byte(int r, int c) { const int st = (r >> 4) * 2 + (c >> 5), rr = r & 15, cc = c & 31, ob = rr * 64 + cc * 2; return st * 1024 + (ob ^ (((ob >> 9) & 1) << 5)); }
__host__ __device__ __forceinline__ void stage_rc(int b, int& R, int& C) { const int st = b / 1024, sb = b % 1024, swz = sb ^ (((sb >> 9) & 1) << 5); R = (st >> 1) * 16 + swz / 64; C = (st & 1) * 32 + (swz % 64) / 2; }
__host__ __device__ __forceinline__ int perm32(int rho) { const int n = rho >> 4, i = rho & 15; return 8 * (i >> 2) + 4 * n + (i & 3); }

typedef int v8i32 __attribute__((ext_vector_type(8)));
__device__ __forceinline__ v8i32 cat8(bf16x8 lo, bf16x8 hi) { typedef int v4i __attribute__((ext_vector_type(4))); const v4i a = __builtin_bit_cast(v4i, lo), b = __builtin_bit_cast(v4i, hi); return (v8i32){a[0], a[1], a[2], a[3], b[0], b[1], b[2], b[3]}; }
typedef int v4i32 __attribute__((ext_vector_type(4)));
template <bool FP8> struct FragT;
template <> struct FragT<false> {
    struct type { bf16x8 k0, k1; };
    static __device__ __forceinline__ void ld(type& f, const PG8_LAS unsigned char* p) { f.k0 = *(const PG8_LAS bf16x8*)p; f.k1 = *(const PG8_LAS bf16x8*)(p + 1024); }
    static __device__ __forceinline__ void mma(f32x4& acc, const type& b, const type& a) { acc = __builtin_amdgcn_mfma_f32_16x16x32_bf16(b.k0, a.k0, acc, 0, 0, 0); acc = __builtin_amdgcn_mfma_f32_16x16x32_bf16(b.k1, a.k1, acc, 0, 0, 0); }
};
template <> struct FragT<true> {
    typedef v8i32 type;
    static __device__ __forceinline__ void ld(type& f, const PG8_LAS unsigned char* p) { f.lo = *(const PG8_LAS v4i32*)p; f.hi = *(const PG8_LAS v4i32*)(p + 1024); }
    static __device__ __forceinline__ void mma(f32x4& acc, const type& b, const type& a) {
#if defined(__HIP_DEVICE_COMPILE__)
        int sc = 0x7F7F7F7F;
        asm volatile("v_mfma_scale_f32_16x16x128_f8f6f4 %0, %1, %2, %0, %3, %3 op_sel_hi:[0,0,0]" : "+v"(acc) : "v"(b), "v"(a), "v"(sc));
#endif
    }
};
struct Unit { int pm, pn, bn, koff, kh; };
struct Gemm { const bf16_t* A; const bf16_t* Bt; int M, N, K, ld; };

struct StaticOrder {
    int nM, nN, nwg, G, c;
    __host__ __device__ void init(int M, int N, int G_, int c_) { nM = M / BM; nN = N / BM; nwg = nM * nN; G = G_; c = c_; }
    __host__ __device__ bool next(int i, Unit& u) const {
        const long L = (long)i * G + c; if (L >= nwg) return false;
        int wgid = (int)L; { const int q = nwg / NXCD, r = nwg % NXCD, xcd = wgid % NXCD, off = wgid / NXCD; wgid = (xcd < r ? xcd * (q + 1) : r * (q + 1) + (xcd - r) * q) + off; }
        const int nig = WGM * nN, gid = wgid / nig, fm = gid * WGM, gsz = (nM - fm) < WGM ? (nM - fm) : WGM;
        u.pm = fm + ((wgid % nig) % gsz); u.pn = (wgid % nig) / gsz; u.bn = u.pn; u.koff = 0; u.kh = 1; return true;
    }
    __device__ __forceinline__ void a_ready(const Unit&) const {}
    __device__ __forceinline__ void done(const Unit&) const {}
};

struct StaticOrder2 {
    StaticOrder S; int khalf;
    __host__ __device__ bool next(int i, Unit& u) const { if (!S.next(i >> 1, u)) return false; u.kh = i & 1; u.koff = (i & 1) * khalf; return true; }
    __device__ __forceinline__ void a_ready(const Unit&) const {}
    __device__ __forceinline__ void done(const Unit&) const {}
};

__device__ __forceinline__ unsigned cvt_pk_bf16(float lo, float hi) { unsigned r; asm volatile("v_cvt_pk_bf16_f32 %0, %1, %2" : "=v"(r) : "v"(lo), "v"(hi)); return r; }
typedef float f32x2 __attribute__((ext_vector_type(2)));

__device__ __forceinline__ unsigned pk_fp8x4(float a, float b, float c, float d) { unsigned w = 0u; w = (unsigned)__builtin_amdgcn_cvt_pk_fp8_f32(a, b, (int)w, false); w = (unsigned)__builtin_amdgcn_cvt_pk_fp8_f32(c, d, (int)w, true); return w; }
struct EpiProj {
    static constexpr bool PERM = true, AFTER_DRAIN = false, MID = false;
    bf16_t* P; float* GF;
    __device__ __forceinline__ void operator()(const f32x4 (&acc)[2][2][4][2], const Unit& u, int wr, int wc, int fr, int fq) const {
        const int row0 = u.pm * BM + wr * 64 + fr;
        if (u.pn < 22) {
            const int col0 = u.pn * BM + wc * 32 + 8 * fq;
#pragma unroll
            for (int ai = 0; ai < 2; ++ai)
#pragma unroll
                for (int m = 0; m < 4; ++m) { bf16_t* rowp = P + (size_t)(row0 + ai * HALF + m * 16) * 5632 + col0;
#pragma unroll
                    for (int bj = 0; bj < 2; ++bj) { const f32x4 v0 = acc[ai][bj][m][0], v1 = acc[ai][bj][m][1];
                        u32x4 w; w.x = cvt_pk_bf16(v0[0], v0[1]); w.y = cvt_pk_bf16(v0[2], v0[3]); w.z = cvt_pk_bf16(v1[0], v1[1]); w.w = cvt_pk_bf16(v1[2], v1[3]);
                        *(u32x4*)(rowp + bj * HALF) = w; } }
        } else {
            const int col0 = wc * 32 + 8 * fq;
            if (col0 < 64) {
#pragma unroll
                for (int ai = 0; ai < 2; ++ai)
#pragma unroll
                    for (int m = 0; m < 4; ++m) { float* rowp = GF + (size_t)(row0 + ai * HALF + m * 16) * 64 + col0;
                        *(f32x4*)(rowp) = acc[ai][0][m][0]; *(f32x4*)(rowp + 4) = acc[ai][0][m][1]; }
            }
        }
    }
};
struct EpiOut {
    static constexpr bool PERM = true, AFTER_DRAIN = false, MID = true;
    const float* X; bf16_t* HB; float* HSSQ; const float* SSQ; unsigned char* HB8;
    const PG8_LAS float* RT; int pm0, pn0;
    __device__ __forceinline__ const PG8_LAS float* rt_of(const Unit& u, int wr, int fr) const { return RT + ((u.pm == pm0 && u.pn == pn0) ? 0 : 512) + (wr * 64 + fr) * 2; }
    __device__ __forceinline__ void mid(f32x4 (&acc)[2][2][4][2], const Unit& u, int wr, int wc, int fr, int fq) const {
        const PG8_LAS float* rt = rt_of(u, wr, fr);
#pragma unroll
        for (int ai = 0; ai < 2; ++ai)
#pragma unroll
            for (int m = 0; m < 4; ++m) { const float q = rt[(ai * HALF + m * 16) * 2];
#pragma unroll
                for (int bj = 0; bj < 2; ++bj)
#pragma unroll
                    for (int n = 0; n < 2; ++n) acc[ai][bj][m][n] *= q; }
    }
    __device__ __forceinline__ void operator()(const f32x4 (&acc)[2][2][4][2], const Unit& u, int wr, int wc, int fr, int fq) const {
        const int row0 = u.pm * BM + wr * 64 + fr, col0 = u.pn * BM + wc * 32 + 8 * fq;
        const PG8_LAS float* rt = rt_of(u, wr, fr);
        f32x4 xa[2][2], xb[2][2];
        { const float* xr = X + (size_t)row0 * 2048 + col0;
#pragma unroll
            for (int bj = 0; bj < 2; ++bj) { xa[bj][0] = *(const f32x4*)(xr + bj * HALF); xa[bj][1] = *(const f32x4*)(xr + bj * HALF + 4); } }
#pragma unroll
        for (int ai = 0; ai < 2; ++ai)
#pragma unroll
            for (int m = 0; m < 4; ++m) { const int row = row0 + ai * HALF + m * 16; const float rs = rt[(ai * HALF + m * 16) * 2 + 1];
                if (!(ai == 1 && m == 3)) { const int rn = row0 + (m == 3 ? HALF : ai * HALF + (m + 1) * 16); const float* xr = X + (size_t)rn * 2048 + col0;
#pragma unroll
                    for (int bj = 0; bj < 2; ++bj) { xb[bj][0] = *(const f32x4*)(xr + bj * HALF); xb[bj][1] = *(const f32x4*)(xr + bj * HALF + 4); } }
                bf16_t* hr = HB + (size_t)row * 2048 + col0; float ss = 0.f;
#pragma unroll
                for (int bj = 0; bj < 2; ++bj) { const f32x4 v0 = acc[ai][bj][m][0] * rs + xa[bj][0], v1 = acc[ai][bj][m][1] * rs + xa[bj][1];
                    ss += (v0[0] * v0[0] + v0[1] * v0[1]) + (v0[2] * v0[2] + v0[3] * v0[3]) + (v1[0] * v1[0] + v1[1] * v1[1]) + (v1[2] * v1[2] + v1[3] * v1[3]);
                    u32x4 w; w.x = cvt_pk_bf16(v0[0], v0[1]); w.y = cvt_pk_bf16(v0[2], v0[3]); w.z = cvt_pk_bf16(v1[0], v1[1]); w.w = cvt_pk_bf16(v1[2], v1[3]);
                    *(u32x4*)(hr + bj * HALF) = w;
                    *(unsigned long long*)(HB8 + (size_t)row * 2048 + col0 + bj * HALF) = (unsigned long long)pk_fp8x4(v0[0], v0[1], v0[2], v0[3]) | ((unsigned long long)pk_fp8x4(v1[0], v1[1], v1[2], v1[3]) << 32); }
                ss += __shfl_xor(ss, 16); ss += __shfl_xor(ss, 32);
                if (fq == 0) HSSQ[(size_t)row * 32 + u.pn * 4 + wc] = ss;
#pragma unroll
                for (int bj = 0; bj < 2; ++bj) { xa[bj][0] = xb[bj][0]; xa[bj][1] = xb[bj][1]; }
                __builtin_amdgcn_sched_barrier(0); }
    }
};
struct EpiGateUp {
    static constexpr bool PERM = true, AFTER_DRAIN = false, MID = false;
    unsigned char* HID; const float* rstd_s;
    static constexpr float WSC = 1.f / 64.f, HSC = 16.f;
    __device__ __forceinline__ void operator()(const f32x4 (&acc)[2][2][4][2], const Unit& u, int wr, int wc, int fr, int fq) const {
        const int row0 = u.pm * BM + wr * 64 + fr, col0 = u.pn * 128 + wc * 32 + 8 * fq;
        const __amdgpu_buffer_rsrc_t rsrc = __builtin_amdgcn_make_buffer_rsrc((void*)HID, 0, 40960 * 512, 0x00020000);
        float rsv[2][4];
#pragma unroll
        for (int ai = 0; ai < 2; ++ai)
#pragma unroll
            for (int m = 0; m < 4; ++m) rsv[ai][m] = rstd_s[row0 + ai * HALF + m * 16];
#pragma unroll
        for (int ai = 0; ai < 2; ++ai)
#pragma unroll
            for (int m = 0; m < 4; ++m) { const int row = row0 + ai * HALF + m * 16; const float rs = rsv[ai][m];
                float o[8];
#pragma unroll
                for (int n = 0; n < 2; ++n)
#pragma unroll
                    for (int j = 0; j < 4; ++j) { const float g = acc[ai][0][m][n][j] * rs * WSC, up = acc[ai][1][m][n][j] * rs * WSC;
                        const float sg = __builtin_amdgcn_rcpf(1.f + __builtin_amdgcn_exp2f(-g * 1.4426950408889634f)); o[n * 4 + j] = __builtin_amdgcn_fmed3f(g * sg * up, -28.f, 28.f); }
                typedef unsigned u32x2 __attribute__((ext_vector_type(2)));
                const u32x2 w = {pk_fp8x4(o[0] * HSC, o[1] * HSC, o[2] * HSC, o[3] * HSC), pk_fp8x4(o[4] * HSC, o[5] * HSC, o[6] * HSC, o[7] * HSC)};
                __builtin_amdgcn_raw_buffer_store_b64(w, rsrc, (int)((size_t)row * 512 + col0), 0, 16);
                __builtin_amdgcn_sched_barrier(0); }
    }
};
struct EpiDown {
    static constexpr bool PERM = true, AFTER_DRAIN = false, MID = false;
    unsigned char* YS; const int* rdst; const float* rwt;
    __device__ __forceinline__ void operator()(const f32x4 (&acc)[2][2][4][2], const Unit& u, int wr, int wc, int fr, int fq) const {
        const int row0 = u.pm * BM + wr * 64 + fr, col0 = u.pn * BM + wc * 32 + 8 * fq;
        int dv[2][4]; float wv[2][4];
#pragma unroll
        for (int ai = 0; ai < 2; ++ai)
#pragma unroll
            for (int m = 0; m < 4; ++m) { dv[ai][m] = rdst[row0 + ai * HALF + m * 16]; wv[ai][m] = rwt[row0 + ai * HALF + m * 16]; }
#pragma unroll
        for (int ai = 0; ai < 2; ++ai)
#pragma unroll
            for (int m = 0; m < 4; ++m) { const int d = dv[ai][m]; const float wt = wv[ai][m] * (1.f / 1024.f);
                if (d >= 0) { unsigned char* yr = YS + ((size_t)(d & 1) * 16384 + (size_t)(d >> 1)) * 2048 + col0;
#pragma unroll
                    for (int bj = 0; bj < 2; ++bj) { const f32x4 v0 = acc[ai][bj][m][0] * wt, v1 = acc[ai][bj][m][1] * wt;
                        *(unsigned long long*)(yr + bj * HALF) = (unsigned long long)pk_fp8x4(v0[0], v0[1], v0[2], v0[3]) | ((unsigned long long)pk_fp8x4(v1[0], v1[1], v1[2], v1[3]) << 32); } }
                __builtin_amdgcn_sched_barrier(0); }
    }
};
struct GroupedOrder {
    int ntiles, nN, G, c; const int* tile_expert; const int* rdst;
    __device__ __forceinline__ int arow(int pm, int h, int R) const { const int d = rdst[pm * BM + h * HALF + R]; return d < 0 ? 0 : (d >> 1); }
    __device__ __forceinline__ bool next(int i, Unit& u) const {
        const int L = i * G + c; if (L >= ntiles * nN) return false;
        u.pm = L / nN; u.pn = L % nN; u.koff = 0; u.kh = 1; u.bn = __hip_atomic_load(tile_expert + u.pm, __ATOMIC_RELAXED, __HIP_MEMORY_SCOPE_AGENT) * nN + u.pn; return true;
    }
    __device__ __forceinline__ void a_ready(const Unit&) const {}
    __device__ __forceinline__ void done(const Unit&) const {}
};

struct QueueOrder {
    int ntiles, nN; const int* tile_expert; const int* rdst;
    unsigned* head; PG8_LAS int* slot;
    const unsigned* ready; unsigned need; unsigned* publish; unsigned* tmo;
    __device__ __forceinline__ int arow(int pm, int h, int R) const { const int d = rdst[pm * BM + h * HALF + R]; return d < 0 ? 0 : (d >> 1); }
    __device__ __forceinline__ bool next(int i, Unit& u) const {
        if (threadIdx.x == 0) slot[i & 1] = i == 0 ? (int)blockIdx.x : (int)(__hip_atomic_fetch_add(head, 1u, __ATOMIC_RELAXED, __HIP_MEMORY_SCOPE_AGENT) + gridDim.x);
        asm volatile("s_waitcnt lgkmcnt(0)\n\ts_barrier" ::: "memory");
        const int L = __builtin_amdgcn_readfirstlane(slot[i & 1]);
        const int pm = L / nN;
        const int te = __hip_atomic_load(tile_expert + (pm < MAXROWS / 256 ? pm : 0), __ATOMIC_RELAXED, __HIP_MEMORY_SCOPE_AGENT);
        if (L >= ntiles * nN) return false;
        u.pm = pm; u.pn = L % nN; u.koff = 0; u.kh = 1; u.bn = te * nN + u.pn; return true;
    }
    __device__ __forceinline__ void a_ready(const Unit& u) const {
        if (need == 0u) return;
        if (threadIdx.x < 64) {
            unsigned polls = 0;
            while ((unsigned)__builtin_amdgcn_readfirstlane(__hip_atomic_load(ready + 64 * u.pm, __ATOMIC_RELAXED, __HIP_MEMORY_SCOPE_AGENT)) < need) {
                __builtin_amdgcn_s_sleep(2);
                if ((++polls & 255u) == 0u) { if (__builtin_amdgcn_readfirstlane(__hip_atomic_load(tmo, __ATOMIC_RELAXED, __HIP_MEMORY_SCOPE_AGENT)) != 0u) break;
                    if (polls > (1u << 20)) { if (threadIdx.x == 0) __hip_atomic_store(tmo, 1u, __ATOMIC_RELAXED, __HIP_MEMORY_SCOPE_AGENT); break; } } }
            __builtin_amdgcn_fence(__ATOMIC_ACQUIRE, "agent");
            asm volatile("s_waitcnt vmcnt(0)" ::: "memory");
        }
        asm volatile("" ::: "memory"); __builtin_amdgcn_s_barrier(); asm volatile("" ::: "memory");
    }
    __device__ __forceinline__ void done(const Unit& u) const {
        if (publish == nullptr) return;
        asm volatile("s_waitcnt vmcnt(0)" ::: "memory");
        if ((threadIdx.x & 63) == 0) (void)__hip_atomic_fetch_add(publish + 64 * u.pm, 1u, __ATOMIC_RELAXED, __HIP_MEMORY_SCOPE_AGENT);
    }
};
template <class Epi, class Sched, bool ALIGN_EPI = false, bool SP2 = false, bool FP8 = false>
__device__ __forceinline__ void gemm_phase(PG8_LAS unsigned char* lds, const Gemm g, const Sched& S, const Epi& E) {
    const int tid = threadIdx.x, wid = __builtin_amdgcn_readfirstlane(tid >> 6), lane = tid & 63, wr = wid >> 2, wc = wid & 3, fr = lane & 15, fq = lane >> 4;
    const int K = g.ld, nt = g.K / BK;
    unsigned voffA[2], voffB[2];
#pragma unroll
    for (int i = 0; i < 2; ++i) { int R, C; stage_rc(tid * 16 + i * 8192, R, C); const int Rb = Epi::PERM ? ((R & ~31) + perm32(R & 31)) : R;
        voffA[i] = (unsigned)(R * K + C) * 2u; voffB[i] = (unsigned)(Rb * K + C) * 2u; }
    const size_t kstep = (size_t)(BK * 2);
    const size_t hstep = (size_t)HALF * K * 2;
    const size_t tstep = 2 * hstep;
    const unsigned ldsw = (unsigned)wid * 1024u;
    const int aoff = lds_byte(wr * 64 + fr, fq * 8), boff = lds_byte(wc * 32 + fr, fq * 8);
#define PG8_SA(b, h) (((b) * 2 + (h)) * HTB)
#define PG8_SB(b, h) ((4 + (b) * 2 + (h)) * HTB)
#define PG8_STAGE(bufoff, gbase, voff) do { _Pragma("unroll") for (int _i = 0; _i < 2; ++_i) \
        __builtin_amdgcn_global_load_lds((const unsigned*)((const char*)(gbase) + (voff)[_i]), (PG8_LAS unsigned*)(lds + (bufoff) + ldsw + _i * 8192), 16, 0, 0); } while (0)
#define PG8_LDA(dst, b, h) do { _Pragma("unroll") for (int m = 0; m < 4; ++m) { FragT<FP8>::ld(dst[m], lds + PG8_SA(b, h) + aoff + m * 2048); } } while (0)
#define PG8_LDB(dst, b, h) do { _Pragma("unroll") for (int n = 0; n < 2; ++n) { FragT<FP8>::ld(dst[n], lds + PG8_SB(b, h) + boff + n * 2048); } } while (0)
#define PG8_MMA(ai, bj, At, Bt) do { __builtin_amdgcn_s_setprio(1); _Pragma("unroll") for (int m = 0; m < 4; ++m) _Pragma("unroll") for (int n = 0; n < 2; ++n) { \
        FragT<FP8>::mma(acc[ai][bj][m][n], Bt[n], At[m]); } \
        __builtin_amdgcn_s_setprio(0); } while (0)
#define PG8_WAIT_V(n) asm volatile("s_waitcnt vmcnt(" #n ")" ::: "memory")
#define PG8_WAIT_L(n) asm volatile("s_waitcnt lgkmcnt(" #n ")" ::: "memory")
#define PG8_BAR __builtin_amdgcn_s_barrier()
#define PG8_SCHED __builtin_amdgcn_sched_barrier(0)
    Unit cur, nxt; int ui = 0;
    if (!S.next(0, cur)) return;
    f32x4 acc[2][2][4][2];
#pragma unroll
    for (int a = 0; a < 2; ++a)
#pragma unroll
        for (int b = 0; b < 2; ++b)
#pragma unroll
            for (int m = 0; m < 4; ++m)
#pragma unroll
                for (int n = 0; n < 2; ++n) acc[a][b][m][n] = (f32x4){0.f, 0.f, 0.f, 0.f};
    typename FragT<FP8>::type At[4], B0[2], B1[2];
    const char* cA = (const char*)g.A + (size_t)cur.pm * tstep + (size_t)cur.koff * 2; const char* cB = (const char*)g.Bt + (size_t)cur.bn * tstep + (size_t)cur.koff * 2;
    S.a_ready(cur);
    if constexpr (SP2) {
        PG8_STAGE(PG8_SB(0, 0), cB, voffB); PG8_STAGE(PG8_SB(0, 1), cB + hstep, voffB); PG8_STAGE(PG8_SA(0, 0), cA, voffA); PG8_STAGE(PG8_SA(0, 1), cA + hstep, voffA);
        if (wr == 1) PG8_BAR;
        PG8_WAIT_V(2); PG8_BAR;
        PG8_STAGE(PG8_SB(1, 0), cB + kstep, voffB); PG8_STAGE(PG8_SA(1, 0), cA + kstep, voffA); PG8_STAGE(PG8_SB(1, 1), cB + hstep + kstep, voffB);
        PG8_WAIT_V(6); PG8_BAR;
    } else {
        PG8_STAGE(PG8_SB(0, 0), cB, voffB); PG8_STAGE(PG8_SA(0, 0), cA, voffA); PG8_STAGE(PG8_SB(0, 1), cB + hstep, voffB); PG8_STAGE(PG8_SA(0, 1), cA + hstep, voffA);
        if (wr == 1) PG8_BAR;
        PG8_WAIT_V(4); PG8_BAR;
        PG8_STAGE(PG8_SB(1, 0), cB + kstep, voffB); PG8_STAGE(PG8_SA(1, 0), cA + kstep, voffA); PG8_STAGE(PG8_SB(1, 1), cB + hstep + kstep, voffB);
        PG8_WAIT_V(6); PG8_BAR;
    }
    for (;;) {
        const bool has_next = S.next(ui + 1, nxt);
        const char* nA = has_next ? (const char*)g.A + (size_t)nxt.pm * tstep + (size_t)nxt.koff * 2 : cA; const char* nB = has_next ? (const char*)g.Bt + (size_t)nxt.bn * tstep + (size_t)nxt.koff * 2 : cB;
#pragma unroll 1
        for (int t = 0; t < nt; t += 2) {
            const bool last = (t == nt - 2);
            const char* a1 = cA + (size_t)(t + 1) * kstep;
            const char* a2 = last ? nA : cA + (size_t)(t + 2) * kstep; const char* b2 = last ? nB : cB + (size_t)(t + 2) * kstep;
            const char* a3 = a2 + kstep; const char* b3 = b2 + kstep;
            if (last && has_next) S.a_ready(nxt);
            if constexpr (SP2) {
            PG8_LDB(B0, 0, 0); PG8_LDB(B1, 0, 1); PG8_SCHED; PG8_LDA(At, 0, 0); PG8_STAGE(PG8_SA(1, 1), a1 + hstep, voffA);
            PG8_WAIT_V(8); PG8_WAIT_L(0); PG8_BAR; PG8_MMA(0, 0, At, B0); PG8_MMA(0, 1, At, B1); PG8_BAR; PG8_SCHED;
            PG8_LDA(At, 0, 1); PG8_STAGE(PG8_SB(0, 0), b2, voffB); PG8_STAGE(PG8_SB(0, 1), b2 + hstep, voffB); PG8_STAGE(PG8_SA(0, 0), a2, voffA);
            PG8_WAIT_V(8); PG8_WAIT_L(0); PG8_BAR; PG8_MMA(1, 0, At, B0); PG8_MMA(1, 1, At, B1); PG8_BAR; PG8_SCHED;
            PG8_LDB(B0, 1, 0); PG8_LDB(B1, 1, 1); PG8_SCHED; PG8_LDA(At, 1, 0); PG8_STAGE(PG8_SA(0, 1), a2 + hstep, voffA);
            PG8_WAIT_V(8); PG8_WAIT_L(0); PG8_BAR; PG8_MMA(0, 0, At, B0); PG8_MMA(0, 1, At, B1); PG8_BAR; PG8_SCHED;
            PG8_LDA(At, 1, 1); PG8_STAGE(PG8_SB(1, 0), b3, voffB); PG8_STAGE(PG8_SB(1, 1), b3 + hstep, voffB); PG8_STAGE(PG8_SA(1, 0), a3, voffA);
            PG8_WAIT_V(8); PG8_WAIT_L(0); PG8_BAR; PG8_MMA(1, 0, At, B0); PG8_MMA(1, 1, At, B1); PG8_BAR; PG8_SCHED;
            } else {
            PG8_LDB(B0, 0, 0); PG8_SCHED; PG8_LDA(At, 0, 0); PG8_STAGE(PG8_SA(1, 1), a1 + hstep, voffA);
            PG8_WAIT_L(8); PG8_BAR; PG8_WAIT_L(0); PG8_MMA(0, 0, At, B0); PG8_BAR; PG8_SCHED;
            PG8_LDB(B1, 0, 1); PG8_STAGE(PG8_SB(0, 0), b2, voffB);
            PG8_BAR; PG8_WAIT_L(0); PG8_MMA(0, 1, At, B1); PG8_BAR;
            PG8_LDA(At, 0, 1); PG8_STAGE(PG8_SA(0, 0), a2, voffA);
            PG8_BAR; PG8_WAIT_L(0); PG8_MMA(1, 0, At, B0); PG8_BAR; PG8_SCHED;
            PG8_STAGE(PG8_SB(0, 1), b2 + hstep, voffB);
            PG8_WAIT_V(6); PG8_BAR; PG8_MMA(1, 1, At, B1); PG8_BAR;
            PG8_LDB(B0, 1, 0); PG8_SCHED; PG8_LDA(At, 1, 0); PG8_STAGE(PG8_SA(0, 1), a2 + hstep, voffA);
            PG8_WAIT_L(8); PG8_BAR; PG8_WAIT_L(0); PG8_MMA(0, 0, At, B0); PG8_BAR; PG8_SCHED;
            PG8_LDB(B1, 1, 1); PG8_STAGE(PG8_SB(1, 0), b3, voffB);
            PG8_BAR; PG8_WAIT_L(0); PG8_MMA(0, 1, At, B1); PG8_BAR;
            PG8_LDA(At, 1, 1); PG8_STAGE(PG8_SA(1, 0), a3, voffA);
            PG8_BAR; PG8_WAIT_L(0); PG8_MMA(1, 0, At, B0); PG8_BAR; PG8_SCHED;
            PG8_STAGE(PG8_SB(1, 1), b3 + hstep, voffB);
            PG8_WAIT_V(6); PG8_BAR; PG8_MMA(1, 1, At, B1); PG8_BAR;
            }
        }
        if constexpr (FP8) asm volatile("s_nop 15\n\ts_nop 7" ::: "memory");
        bool keep = false;
        if constexpr (Epi::MID) keep = (cur.kh == 0);
        if constexpr (ALIGN_EPI) { if (wr == 0 && !keep) PG8_BAR; }
        if constexpr (Epi::MID) { if (keep) E.mid(acc, cur, wr, wc, fr, fq); }
        if constexpr (!Epi::AFTER_DRAIN) { if (!keep) { E(acc, cur, wr, wc, fr, fq); S.done(cur); } }
        if (!has_next) break;
        if (!keep) {
#pragma unroll
        for (int a = 0; a < 2; ++a)
#pragma unroll
            for (int b = 0; b < 2; ++b)
#pragma unroll
                for (int m = 0; m < 4; ++m)
#pragma unroll
                    for (int n = 0; n < 2; ++n) acc[a][b][m][n] = (f32x4){0.f, 0.f, 0.f, 0.f}; }
        cur = nxt; cA = nA; cB = nB; ++ui;
        if constexpr (ALIGN_EPI) { if (wr == 1 && !keep) PG8_BAR; }
    }
    PG8_WAIT_V(0);
    if constexpr (!ALIGN_EPI) { if (wr == 0) PG8_BAR; }
    PG8_BAR;
    if constexpr (Epi::AFTER_DRAIN) { E.fused(acc, cur, wr, wc, fr, fq, lds, wid, lane); S.done(cur); }
#undef PG8_SA
#undef PG8_SB
#undef PG8_STAGE
#undef PG8_LDA
#undef PG8_LDB
#undef PG8_MMA
#undef PG8_WAIT_V
#undef PG8_WAIT_L
#undef PG8_BAR
#undef PG8_SCHED
}
template <class Epi, class Sched, bool ALIGN_EPI = false, bool SP2 = false, bool FP8 = false>
__device__ __forceinline__ void gemm_phase_g(PG8_LAS unsigned char* lds, const Gemm g, const Sched& S, const Epi& E) {
    const int tid = threadIdx.x, wid = __builtin_amdgcn_readfirstlane(tid >> 6), lane = tid & 63, wr = wid >> 2, wc = wid & 3, fr = lane & 15, fq = lane >> 4;
    const int K = g.ld, nt = g.K / BK;
    unsigned voffA[2], voffB[2];
#pragma unroll
    for (int i = 0; i < 2; ++i) { int R, C; stage_rc(tid * 16 + i * 8192, R, C); const int Rb = Epi::PERM ? ((R & ~31) + perm32(R & 31)) : R;
        voffA[i] = (unsigned)(R * K + C) * 2u; voffB[i] = (unsigned)(Rb * K + C) * 2u; }
    unsigned vAc[2][2], vAn[2][2];
#define PG8_AOFF(dst, u) do { _Pragma("unroll") for (int _h = 0; _h < 2; ++_h) _Pragma("unroll") for (int _i = 0; _i < 2; ++_i) { int R, C; stage_rc(tid * 16 + _i * 8192, R, C); \
        dst[_h][_i] = (unsigned)(S.arow((u).pm, _h, R) * K + C) * 2u; } } while (0)
    const size_t kstep = (size_t)(BK * 2);
    const size_t hstep = (size_t)HALF * K * 2;
    const size_t tstep = 2 * hstep;
    const unsigned ldsw = (unsigned)wid * 1024u;
    const int aoff = lds_byte(wr * 64 + fr, fq * 8), boff = lds_byte(wc * 32 + fr, fq * 8);
#define PG8_SA(b, h) (((b) * 2 + (h)) * HTB)
#define PG8_SB(b, h) ((4 + (b) * 2 + (h)) * HTB)
#define PG8_STAGE(bufoff, gbase, voff) do { _Pragma("unroll") for (int _i = 0; _i < 2; ++_i) \
        __builtin_amdgcn_global_load_lds((const unsigned*)((const char*)(gbase) + (voff)[_i]), (PG8_LAS unsigned*)(lds + (bufoff) + ldsw + _i * 8192), 16, 0, 0); } while (0)
#define PG8_LDA(dst, b, h) do { _Pragma("unroll") for (int m = 0; m < 4; ++m) { FragT<FP8>::ld(dst[m], lds + PG8_SA(b, h) + aoff + m * 2048); } } while (0)
#define PG8_LDB(dst, b, h) do { _Pragma("unroll") for (int n = 0; n < 2; ++n) { FragT<FP8>::ld(dst[n], lds + PG8_SB(b, h) + boff + n * 2048); } } while (0)
#define PG8_MMA(ai, bj, At, Bt) do { __builtin_amdgcn_s_setprio(1); _Pragma("unroll") for (int m = 0; m < 4; ++m) _Pragma("unroll") for (int n = 0; n < 2; ++n) { \
        FragT<FP8>::mma(acc[ai][bj][m][n], Bt[n], At[m]); } \
        __builtin_amdgcn_s_setprio(0); } while (0)
#define PG8_WAIT_V(n) asm volatile("s_waitcnt vmcnt(" #n ")" ::: "memory")
#define PG8_WAIT_L(n) asm volatile("s_waitcnt lgkmcnt(" #n ")" ::: "memory")
#define PG8_BAR __builtin_amdgcn_s_barrier()
#define PG8_SCHED __builtin_amdgcn_sched_barrier(0)
    Unit cur, nxt; int ui = 0;
    if (!S.next(0, cur)) return;
    f32x4 acc[2][2][4][2];
#pragma unroll
    for (int a = 0; a < 2; ++a)
#pragma unroll
        for (int b = 0; b < 2; ++b)
#pragma unroll
            for (int m = 0; m < 4; ++m)
#pragma unroll
                for (int n = 0; n < 2; ++n) acc[a][b][m][n] = (f32x4){0.f, 0.f, 0.f, 0.f};
    typename FragT<FP8>::type At[4], B0[2], B1[2];
    PG8_AOFF(vAc, cur);
    const char* cA = (const char*)g.A; const char* cB = (const char*)g.Bt + (size_t)cur.bn * tstep;
    S.a_ready(cur);
    if constexpr (SP2) {
        PG8_STAGE(PG8_SB(0, 0), cB, voffB); PG8_STAGE(PG8_SB(0, 1), cB + hstep, voffB); PG8_STAGE(PG8_SA(0, 0), cA, vAc[0]); PG8_STAGE(PG8_SA(0, 1), cA, vAc[1]);
        if (wr == 1) PG8_BAR;
        PG8_WAIT_V(2); PG8_BAR;
        PG8_STAGE(PG8_SB(1, 0), cB + kstep, voffB); PG8_STAGE(PG8_SA(1, 0), cA + kstep, vAc[0]); PG8_STAGE(PG8_SB(1, 1), cB + hstep + kstep, voffB);
        PG8_WAIT_V(6); PG8_BAR;
    } else {
        PG8_STAGE(PG8_SB(0, 0), cB, voffB); PG8_STAGE(PG8_SA(0, 0), cA, vAc[0]); PG8_STAGE(PG8_SB(0, 1), cB + hstep, voffB); PG8_STAGE(PG8_SA(0, 1), cA, vAc[1]);
        if (wr == 1) PG8_BAR;
        PG8_WAIT_V(4); PG8_BAR;
        PG8_STAGE(PG8_SB(1, 0), cB + kstep, voffB); PG8_STAGE(PG8_SA(1, 0), cA + kstep, vAc[0]); PG8_STAGE(PG8_SB(1, 1), cB + hstep + kstep, voffB);
        PG8_WAIT_V(6); PG8_BAR;
    }
    for (;;) {
        const bool has_next = S.next(ui + 1, nxt);
        if (has_next) PG8_AOFF(vAn, nxt); else { _Pragma("unroll") for (int _h = 0; _h < 2; ++_h) _Pragma("unroll") for (int _i = 0; _i < 2; ++_i) vAn[_h][_i] = vAc[_h][_i]; }
        const char* nA = cA; const char* nB = has_next ? (const char*)g.Bt + (size_t)nxt.bn * tstep : cB;
#pragma unroll 1
        for (int t = 0; t < nt; t += 2) {
            const bool last = (t == nt - 2);
            const char* a1 = cA + (size_t)(t + 1) * kstep;
            const char* a2 = last ? nA : cA + (size_t)(t + 2) * kstep; const char* b2 = last ? nB : cB + (size_t)(t + 2) * kstep;
            const char* a3 = a2 + kstep; const char* b3 = b2 + kstep;
            unsigned vs0[2], vs1[2]; vs0[0] = last ? vAn[0][0] : vAc[0][0]; vs0[1] = last ? vAn[0][1] : vAc[0][1]; vs1[0] = last ? vAn[1][0] : vAc[1][0]; vs1[1] = last ? vAn[1][1] : vAc[1][1];
            if (last && has_next) S.a_ready(nxt);
            if constexpr (SP2) {
            PG8_LDB(B0, 0, 0); PG8_LDB(B1, 0, 1); PG8_SCHED; PG8_LDA(At, 0, 0); PG8_STAGE(PG8_SA(1, 1), a1, vAc[1]);
            PG8_WAIT_V(8); PG8_WAIT_L(0); PG8_BAR; PG8_MMA(0, 0, At, B0); PG8_MMA(0, 1, At, B1); PG8_BAR; PG8_SCHED;
            PG8_LDA(At, 0, 1); PG8_STAGE(PG8_SB(0, 0), b2, voffB); PG8_STAGE(PG8_SB(0, 1), b2 + hstep, voffB); PG8_STAGE(PG8_SA(0, 0), a2, vs0);
            PG8_WAIT_V(8); PG8_WAIT_L(0); PG8_BAR; PG8_MMA(1, 0, At, B0); PG8_MMA(1, 1, At, B1); PG8_BAR; PG8_SCHED;
            PG8_LDB(B0, 1, 0); PG8_LDB(B1, 1, 1); PG8_SCHED; PG8_LDA(At, 1, 0); PG8_STAGE(PG8_SA(0, 1), a2, vs1);
            PG8_WAIT_V(8); PG8_WAIT_L(0); PG8_BAR; PG8_MMA(0, 0, At, B0); PG8_MMA(0, 1, At, B1); PG8_BAR; PG8_SCHED;
            PG8_LDA(At, 1, 1); PG8_STAGE(PG8_SB(1, 0), b3, voffB); PG8_STAGE(PG8_SB(1, 1), b3 + hstep, voffB); PG8_STAGE(PG8_SA(1, 0), a3, vs0);
            PG8_WAIT_V(8); PG8_WAIT_L(0); PG8_BAR; PG8_MMA(1, 0, At, B0); PG8_MMA(1, 1, At, B1); PG8_BAR; PG8_SCHED;
            } else {
            PG8_LDB(B0, 0, 0); PG8_SCHED; PG8_LDA(At, 0, 0); PG8_STAGE(PG8_SA(1, 1), a1, vAc[1]);
            PG8_WAIT_L(8); PG8_BAR; PG8_WAIT_L(0); PG8_MMA(0, 0, At, B0); PG8_BAR; PG8_SCHED;
            PG8_LDB(B1, 0, 1); PG8_STAGE(PG8_SB(0, 0), b2, voffB);
            PG8_BAR; PG8_WAIT_L(0); PG8_MMA(0, 1, At, B1); PG8_BAR;
            PG8_LDA(At, 0, 1); PG8_STAGE(PG8_SA(0, 0), a2, vs0);
            PG8_BAR; PG8_WAIT_L(0); PG8_MMA(1, 0, At, B0); PG8_BAR; PG8_SCHED;
            PG8_STAGE(PG8_SB(0, 1), b2 + hstep, voffB);
            PG8_WAIT_V(6); PG8_BAR; PG8_MMA(1, 1, At, B1); PG8_BAR;
            PG8_LDB(B0, 1, 0); PG8_SCHED; PG8_LDA(At, 1, 0); PG8_STAGE(PG8_SA(0, 1), a2, vs1);
            PG8_WAIT_L(8); PG8_BAR; PG8_WAIT_L(0); PG8_MMA(0, 0, At, B0); PG8_BAR; PG8_SCHED;
            PG8_LDB(B1, 1, 1); PG8_STAGE(PG8_SB(1, 0), b3, voffB);
            PG8_BAR; PG8_WAIT_L(0); PG8_MMA(0, 1, At, B1); PG8_BAR;
            PG8_LDA(At, 1, 1); PG8_STAGE(PG8_SA(1, 0), a3, vs0);
            PG8_BAR; PG8_WAIT_L(0); PG8_MMA(1, 0, At, B0); PG8_BAR; PG8_SCHED;
            PG8_STAGE(PG8_SB(1, 1), b3 + hstep, voffB);
            PG8_WAIT_V(6); PG8_BAR; PG8_MMA(1, 1, At, B1); PG8_BAR;
            }
        }
        if constexpr (ALIGN_EPI) { if (wr == 0) PG8_BAR; }
        if constexpr (FP8) asm volatile("s_nop 15\n\ts_nop 7" ::: "memory");
        if constexpr (!Epi::AFTER_DRAIN) { E(acc, cur, wr, wc, fr, fq); S.done(cur); }
        if (!has_next) break;
#pragma unroll
        for (int a = 0; a < 2; ++a)
#pragma unroll
            for (int b = 0; b < 2; ++b)
#pragma unroll
                for (int m = 0; m < 4; ++m)
#pragma unroll
                    for (int n = 0; n < 2; ++n) acc[a][b][m][n] = (f32x4){0.f, 0.f, 0.f, 0.f};
        cur = nxt; cA = nA; cB = nB; ++ui;
        _Pragma("unroll") for (int _h = 0; _h < 2; ++_h) _Pragma("unroll") for (int _i = 0; _i < 2; ++_i) vAc[_h][_i] = vAn[_h][_i];
        if constexpr (ALIGN_EPI) { if (wr == 1) PG8_BAR; }
    }
    PG8_WAIT_V(0);
    if constexpr (!ALIGN_EPI) { if (wr == 0) PG8_BAR; }
    PG8_BAR;
    if constexpr (Epi::AFTER_DRAIN) { E.fused(acc, cur, wr, wc, fr, fq, lds, wid, lane); S.done(cur); }
#undef PG8_AOFF
#undef PG8_SA
#undef PG8_SB
#undef PG8_STAGE
#undef PG8_LDA
#undef PG8_LDB
#undef PG8_MMA
#undef PG8_WAIT_V
#undef PG8_WAIT_L
#undef PG8_BAR
#undef PG8_SCHED
}
}

#define GAS __attribute__((address_space(1)))
#define LAS __attribute__((address_space(3)))
typedef unsigned short bf16;
typedef unsigned v4u __attribute__((ext_vector_type(4)));
typedef float f32x4 __attribute__((ext_vector_type(4)));
typedef short bf16x8 __attribute__((ext_vector_type(8)));
typedef GAS unsigned gu32;
#define RLX_AGENT __ATOMIC_RELAXED, __HIP_MEMORY_SCOPE_AGENT
#define LDS_WAIT() asm volatile("s_waitcnt lgkmcnt(0)" ::: "memory")
#define VM_WAIT() asm volatile("s_waitcnt vmcnt(0)" ::: "memory")
__device__ __forceinline__ unsigned f2bf(float f) { unsigned u = __builtin_bit_cast(unsigned, f); return (u + 0x7fffu + ((u >> 16) & 1u)) >> 16; }
__device__ __forceinline__ unsigned pk2(float lo, float hi) { return f2bf(lo) | (f2bf(hi) << 16); }
__device__ __forceinline__ float bf2f(unsigned short b) { return __builtin_bit_cast(float, (unsigned)b << 16); }
__device__ __forceinline__ float bflo(unsigned w) { return __builtin_bit_cast(float, w << 16); }
__device__ __forceinline__ float bfhi(unsigned w) { return __builtin_bit_cast(float, w & 0xffff0000u); }
__device__ __forceinline__ int ld_i32(const int* p) { return __hip_atomic_load(p, __ATOMIC_RELAXED, __HIP_MEMORY_SCOPE_AGENT); }
__device__ __forceinline__ float wave_sum(float v) {
#pragma unroll
    for (int o = 1; o < 64; o <<= 1) v += __shfl_xor(v, o);
    return v;
}
__device__ __forceinline__ float wave_max(float v) {
#pragma unroll
    for (int o = 1; o < 64; o <<= 1) v = fmaxf(v, __shfl_xor(v, o));
    return v;
}
__device__ const unsigned char T5B[128] = {0,1,2,3,4,5,6,7,8,9,10,11,12,13,14,15,16,16,16,17,17,18,18,18,19,19,19,20,20,20,20,21,21,21,21,22,22,22,22,22,23,23,23,23,23,23,24,24,24,24,24,24,25,25,25,25,25,25,25,26,26,26,26,26,26,26,26,27,27,27,27,27,27,27,27,27,27,28,28,28,28,28,28,28,28,28,28,29,29,29,29,29,29,29,29,29,29,29,29,30,30,30,30,30,30,30,30,30,30,30,30,30,30,31,31,31,31,31,31,31,31,31,31,31,31,31,31,31};
__device__ __forceinline__ int t5_bucket(int dist) { return dist >= 128 ? 31 : (int)T5B[dist < 0 ? 0 : dist]; }
#define XB_TMO      128
#define XB_XCNT(j)  (256  + 64 * (j))
#define XB_XSUB(j)  (1280 + 64 * (j))
#define XB_XGEN(j)  (2304 + 64 * (j))
#define XB_TOP      3328
#define XB_TOPGEN   3392
#define XCD_BAR_WORDS 3456
#define XB_SPIN_CAP (1u << 18)

__device__ __forceinline__ unsigned xb_ld(unsigned* p)              { return __hip_atomic_load(p, __ATOMIC_RELAXED, __HIP_MEMORY_SCOPE_AGENT); }
__device__ __forceinline__ unsigned xb_add(unsigned* p, unsigned v) { return __hip_atomic_fetch_add(p, v, __ATOMIC_RELAXED, __HIP_MEMORY_SCOPE_AGENT); }
__device__ __forceinline__ unsigned xb_xcc_id() { return (unsigned)__builtin_amdgcn_s_getreg((3 << 11) | 20) & 0xFu; }
#define XB_SPIN(cond, bar) do { unsigned _sp = 0; while (cond) { __builtin_amdgcn_s_sleep(1); \
    if ((++_sp & 255u) == 0u) { if (xb_ld(&(bar)[XB_TMO])) break; if (_sp > XB_SPIN_CAP) { atomicAdd(&(bar)[XB_TMO], 1u); break; } } } } while (0)

struct XcdBarrier {
    unsigned* bar; unsigned x;
    volatile LAS unsigned* st;
};

__device__ __forceinline__ XcdBarrier xcd_barrier_post(unsigned* bar, volatile LAS unsigned* st) {
    XcdBarrier b; b.bar = bar; b.x = xb_xcc_id(); b.st = st;
    if (threadIdx.x == 0) (void)xb_add(&bar[XB_XCNT(b.x)], 1u);
    return b;
}
__device__ __forceinline__ void xcd_barrier_complete(unsigned* bar, unsigned x, unsigned& nloc, unsigned& nx) {
    const unsigned G = gridDim.x * gridDim.y * gridDim.z;
    unsigned sum, cnt, mine, sp = 0u;
    for (;;) {
        sum = 0u; cnt = 0u; mine = 0u;
#pragma unroll
        for (unsigned j = 0; j < 16; ++j) { const unsigned c = xb_ld(&bar[XB_XCNT(j)]); sum += c; cnt += (c > 0u) ? 1u : 0u; mine = (j == x) ? c : mine; }
        if (sum == G) break;
        __builtin_amdgcn_s_sleep(1);
        if ((++sp & 255u) == 0u) { if (xb_ld(&bar[XB_TMO])) break; if (sp > XB_SPIN_CAP) { atomicAdd(&bar[XB_TMO], 1u); break; } }
    }
    nloc = mine > 0u ? mine : 1u; nx = cnt > 0u ? cnt : 1u;
}

__device__ __forceinline__ void xcd_barrier(const XcdBarrier& b) {
    asm volatile("s_waitcnt vmcnt(0)" ::: "memory");
    __syncthreads();
    if (threadIdx.x == 0) {
        unsigned* bar = b.bar;
        __builtin_amdgcn_s_waitcnt(0);
        unsigned nloc = b.st[0], nx = b.st[1];
        if (nloc == 0u) { xcd_barrier_complete(bar, b.x, nloc, nx); b.st[0] = nloc; b.st[1] = nx; }
        const unsigned old = xb_add(&bar[XB_XSUB(b.x)], 1u);
        const unsigned gen = old / nloc;
        if (old + 1u == (gen + 1u) * nloc) {
            __builtin_amdgcn_fence(__ATOMIC_RELEASE, "agent");
            asm volatile("s_waitcnt vmcnt(0)" ::: "memory");
            const unsigned og = xb_add(&bar[XB_TOP], 1u);
            const unsigned tg = og / nx;
            if (og + 1u == (tg + 1u) * nx) xb_add(&bar[XB_TOPGEN], 1u);
            else XB_SPIN(xb_ld(&bar[XB_TOPGEN]) == tg, bar);
            __builtin_amdgcn_fence(__ATOMIC_ACQUIRE, "agent");
            xb_add(&bar[XB_XGEN(b.x)], 1u);
            asm volatile("s_waitcnt vmcnt(0)" ::: "memory");
        } else {
            XB_SPIN(xb_ld(&bar[XB_XGEN(b.x)]) == gen, bar);
            __builtin_amdgcn_fence(__ATOMIC_ACQUIRE, "agent");
            asm volatile("s_waitcnt vmcnt(0)" ::: "memory");
        }
    }
    __syncthreads();
}

#define WSYNC() asm volatile("s_waitcnt lgkmcnt(0)" ::: "memory")
constexpr int WSCR = 18432;
__device__ __forceinline__ float log_sigmoid(float x) { return fminf(x, 0.f) - log1pf(expf(-fabsf(x))); }
__device__ __forceinline__ float sigmoidf_(float x) { return 1.f / (1.f + expf(-x)); }

__device__ __forceinline__ void compress_item(int item, int lane, LAS float* scr, const bf16* PROJ, const float* pe_k, const float* pe_v, const float* w1k, const float* w2k, const float* w1v, const float* w2v, bf16* KC, bf16* VC) {
    const int kv = item & 1, g = (item >> 1) & 3, bc = item >> 3, c = bc & 127, b = bc >> 7;
    bf16* dst = (kv ? VC : KC) + ((size_t)(b * 128 + c) * 4 + g) * 64;
    if (c == 127) { dst[lane] = 0; return; }
    const float* pe = kv ? pe_v : pe_k; const float* w1 = kv ? w1v : w1k; const float* w2 = kv ? w2v : w2k;
    const int colbase = (kv ? C_VCMP : C_KCMP) + g * 64;
    LAS float* xin = scr; LAS float* hid = scr + 2048;
    for (int l = 0; l < 32; ++l) xin[l * 64 + lane] = bf2f(PROJ[(size_t)(b * 2048 + 16 * c + l) * NPROJ + colbase + lane]) + pe[l * 64 + lane];
    WSYNC();
    float s0 = 0.f, s1 = 0.f;
#pragma unroll 8
    for (int i = 0; i < 2048; ++i) { const float x = xin[i]; s0 += x * w1[(size_t)i * 128 + lane]; s1 += x * w1[(size_t)i * 128 + 64 + lane]; }
    hid[lane] = s0 / (1.f + expf(-s0)); hid[64 + lane] = s1 / (1.f + expf(-s1));
    WSYNC();
    float o = 0.f;
#pragma unroll 8
    for (int j = 0; j < 128; ++j) o += hid[j] * w2[j * 64 + lane];
    dst[lane] = (bf16)f2bf(o);
    WSYNC();
}

__device__ __forceinline__ void compress_mfma(int wg, int tid, int lane, int wave, LAS float* part, LAS float* hid, const bf16* PROJ, const bf16* W1T, const float* B1, const float* w2k, const float* w2v, bf16* KC, bf16* VC) {
    typedef float f32x16 __attribute__((ext_vector_type(16)));
    const int kv = wg / 127, blk = wg % 127; const int r32 = lane & 31, hi = lane >> 5;
    const int colbase = kv ? C_VCMP : C_KCMP;
    f32x4 w2r[4];
    { const f32x4* w2g = (const f32x4*)(kv ? w2v : w2k) + tid * 4;
#pragma unroll
        for (int i = 0; i < 4; ++i) w2r[i] = w2g[i]; }
    { const int rho = blk * 32 + r32; const int g = rho & 3, bc = rho >> 2, c = bc % 127, b = bc / 127;
        const bf16* arow = PROJ + (size_t)(b * 2048 + 16 * c + 4 * wave) * NPROJ + colbase + g * 64 + hi * 8;
        const bf16* brow = W1T + (size_t)(kv * 8 + wave) * 32768 + lane * 8;
        f32x16 acc[4];
#pragma unroll
        for (int j = 0; j < 4; ++j)
#pragma unroll
            for (int r = 0; r < 16; ++r) acc[j][r] = 0.f;
#pragma unroll 8
        for (int s = 0; s < 16; ++s) {
            const bf16x8 A = *(const bf16x8*)(arow + (size_t)(s >> 2) * NPROJ + (s & 3) * 16);
            bf16x8 B[4];
#pragma unroll
            for (int j = 0; j < 4; ++j) B[j] = *(const bf16x8*)(brow + s * 2048 + j * 512);
#pragma unroll
            for (int j = 0; j < 4; ++j) acc[j] = __builtin_amdgcn_mfma_f32_32x32x16_bf16(A, B[j], acc[j], 0, 0, 0);
        }
        LAS float* pw = part + wave * 4096;
#pragma unroll
        for (int j = 0; j < 4; ++j)
#pragma unroll
            for (int r = 0; r < 16; ++r) pw[((r & 3) + 8 * (r >> 2) + 4 * hi) * 128 + 32 * j + r32] = acc[j][r];
    }
    __syncthreads();
    for (int i = tid; i < 4096; i += 512) { float s = B1[kv * 128 + (i & 127)];
#pragma unroll
        for (int w = 0; w < 8; ++w) s += part[w * 4096 + i];
        hid[i] = s / (1.f + __expf(-s)); }
    __syncthreads();
    { LAS f32x4* w2l = (LAS f32x4*)part + tid * 4;
#pragma unroll
        for (int i = 0; i < 4; ++i) w2l[i] = w2r[i]; }
    __syncthreads();
    { const int row = tid >> 4, d4 = (tid & 15) * 4; f32x4 o = {0.f, 0.f, 0.f, 0.f};
#pragma unroll 8
        for (int j = 0; j < 128; ++j) { const float hv = hid[row * 128 + j]; const f32x4 w = *(const LAS f32x4*)(part + j * 64 + d4); o += w * hv; }
        const int rho = blk * 32 + row; const int g = rho & 3, bc = rho >> 2, c = bc % 127, b = bc / 127;
        bf16* dst = (kv ? VC : KC) + ((size_t)(b * 128 + c) * 4 + g) * 64 + d4;
        *(unsigned long long*)dst = (unsigned long long)pk2(o[0], o[1]) | ((unsigned long long)pk2(o[2], o[3]) << 32); }
    __syncthreads();
}
__device__ __forceinline__ float log_sigmoid_fast(float x) { return fminf(x, 0.f) - __logf(1.f + __expf(-fabsf(x))); }
__device__ __forceinline__ void cumsum_wg(int bh, int wave, int lane, const float* GF, const float* fb, float* CUM, LAS float* tot) {
    const int b = bh >> 4, h = bh & 15; const float bias = fb[h]; const int t0 = wave * 256 + lane * 4;
    float v[4];
#pragma unroll
    for (int i = 0; i < 4; ++i) v[i] = GF[(size_t)(b * 2048 + t0 + i) * 64 + 48 + h];
    float s = 0.f;
#pragma unroll
    for (int i = 0; i < 4; ++i) { s += log_sigmoid_fast(v[i] + bias); v[i] = s; }
    float incl = s;
#pragma unroll
    for (int o = 1; o < 64; o <<= 1) { const float u = __shfl_up(incl, o); if (lane >= o) incl += u; }
    if (lane == 63) tot[wave] = incl;
    __syncthreads();
    float ex = incl - s;
    for (int w = 0; w < wave; ++w) ex += tot[w];
    *(f32x4*)(CUM + (size_t)bh * 2048 + t0) = (f32x4){(ex + v[0]) * LOG2E, (ex + v[1]) * LOG2E, (ex + v[2]) * LOG2E, (ex + v[3]) * LOG2E};
}
__device__ __forceinline__ void knorm_item(int item, int lane, const bf16* PROJ, unsigned* KN2) {
    const int bh = item >> 4, ch = item & 15, b = bh >> 4, h = bh & 15; float mx = 0.f;
    const bf16* base = PROJ + (size_t)(b * 2048 + ch * 128 + (lane >> 3)) * NPROJ + C_FK + h * 64 + (lane & 7) * 8;
#pragma unroll 8
    for (int i = 0; i < 16; ++i) { const v4u w = *(const v4u*)(base + (size_t)i * 8 * NPROJ);
        float s = bflo(w.x) * bflo(w.x) + bfhi(w.x) * bfhi(w.x) + bflo(w.y) * bflo(w.y) + bfhi(w.y) * bfhi(w.y) + bflo(w.z) * bflo(w.z) + bfhi(w.z) * bfhi(w.z) + bflo(w.w) * bflo(w.w) + bfhi(w.w) * bfhi(w.w);
        s += __shfl_xor(s, 1); s += __shfl_xor(s, 2); s += __shfl_xor(s, 4); mx = fmaxf(mx, s); }
    mx = wave_max(mx);
    if (lane == 0) __hip_atomic_fetch_max(KN2 + bh, __builtin_bit_cast(unsigned, mx), __ATOMIC_RELAXED, __HIP_MEMORY_SCOPE_AGENT);
}
template <int MODE> __device__ __forceinline__ void attn_row(int b, int t, int hg, int lane, LAS float* scr, unsigned mask, const bf16* PROJ, const float* rel, const float* CUM, float* o) {
    constexpr int NH = MODE == 2 ? 1 : 4, MAXK = MODE == 2 ? 2048 : 1024;
    LAS float* qs = scr;
    LAS float* sb = scr + 256;
    LAS int* cb = (LAS int*)(scr + 256 + 4096);
    const size_t tok = (size_t)b * 2048 + t;
    const int qcol = MODE == 2 ? C_FQ + hg * 64 : C_NQ + hg * 256, kcol = (MODE == 0 ? C_KSLC : MODE == 1 ? C_KWIN : C_FK) + hg * 64, vcol = (MODE == 0 ? C_VSLC : MODE == 1 ? C_VWIN : C_FV) + hg * 64;
#pragma unroll
    for (int r = 0; r < NH; ++r) qs[r * 64 + lane] = bf2f(PROJ[tok * NPROJ + qcol + r * 64 + lane]);
    WSYNC();
    const float ct = MODE == 2 ? CUM[(size_t)(b * 16 + hg) * 2048 + t] : 0.f;
    const int nchunk = MODE == 0 ? 32 : (MODE == 1 ? 8 : (t >> 6) + 1);
    int nc = 0; float mx[NH];
#pragma unroll
    for (int r = 0; r < NH; ++r) mx[r] = -INFINITY;
#pragma unroll 1
    for (int ch = 0; ch < nchunk; ++ch) {
        if (MODE == 0 && !((mask >> ch) & 1u)) continue;
        const int p0 = MODE == 1 ? t - 511 + ch * 64 : ch * 64; const int pos = p0 + lane; const bool ok = pos >= 0 && pos <= t;
        float d[NH];
#pragma unroll
        for (int r = 0; r < NH; ++r) d[r] = 0.f;
        if (ok) { const v4u* kr = (const v4u*)(PROJ + (size_t)(b * 2048 + pos) * NPROJ + kcol);
#pragma unroll 2
            for (int i = 0; i < 8; ++i) { const v4u w = kr[i];
                const float k0 = bflo(w.x), k1 = bfhi(w.x), k2 = bflo(w.y), k3 = bfhi(w.y), k4 = bflo(w.z), k5 = bfhi(w.z), k6 = bflo(w.w), k7 = bfhi(w.w);
#pragma unroll
                for (int r = 0; r < NH; ++r) { const LAS float* q = qs + r * 64 + i * 8; d[r] += q[0] * k0 + q[1] * k1 + q[2] * k2 + q[3] * k3 + q[4] * k4 + q[5] * k5 + q[6] * k6 + q[7] * k7; } } }
#pragma unroll
        for (int r = 0; r < NH; ++r) { float bias;
            if (MODE == 2) bias = ok ? ct - CUM[(size_t)(b * 16 + hg) * 2048 + pos] : 0.f; else bias = rel[t5_bucket(t - pos) * 16 + hg * 4 + r] * LOG2E;
            const float s = ok ? d[r] + bias : -INFINITY; sb[r * MAXK + nc * 64 + lane] = s; mx[r] = fmaxf(mx[r], s); }
        if (lane == 0) cb[nc] = p0;
        ++nc;
    }
    WSYNC();
    const int nk = nc * 64; float inv[NH];
#pragma unroll
    for (int r = 0; r < NH; ++r) { const float m = wave_max(mx[r]); float sum = 0.f;
        for (int i = lane; i < nk; i += 64) { const float s = sb[r * MAXK + i]; const float e = (s == -INFINITY) ? 0.f : exp2f(s - m); sb[r * MAXK + i] = e; sum += e; }
        inv[r] = 1.f / fmaxf(wave_sum(sum), 1e-30f); }
    WSYNC();
#pragma unroll
    for (int r = 0; r < NH; ++r) o[r] = 0.f;
    for (int c = 0; c < nc; ++c) { const int p0 = cb[c];
#pragma unroll 4
        for (int j = 0; j < 64; ++j) { const int pos = p0 + j; if (pos < 0 || pos > t) continue;
            const float v = bf2f(PROJ[(size_t)(b * 2048 + pos) * NPROJ + vcol + lane]);
#pragma unroll
            for (int r = 0; r < NH; ++r) o[r] += sb[r * MAXK + c * 64 + j] * v; } }
#pragma unroll
    for (int r = 0; r < NH; ++r) o[r] *= inv[r];
    WSYNC();
}
__device__ __forceinline__ void nsa_item(int item, int lane, LAS float* scr, const bf16* PROJ, const bf16* KC, const bf16* VC, const float* rel, const float* GF, bf16* O, float* SSQ) {
    const int g = item & 3, bt = item >> 2, t = bt & 2047, b = bt >> 11; const size_t tok = (size_t)b * 2048 + t;
    LAS float* qs = scr; LAS float* ps = scr + 256; LAS float* pg = scr + 256 + 512; LAS float* sc = scr + 256 + 512 + 136;
#pragma unroll
    for (int r = 0; r < 4; ++r) qs[r * 64 + lane] = bf2f(PROJ[tok * NPROJ + C_NQ + (g * 4 + r) * 64 + lane]);
    WSYNC();
    const int nvalid = t >= 31 ? min(127, (t - 31) / 16 + 1) : 0;
    float s0[4], s1[4];
#pragma unroll
    for (int half = 0; half < 2; ++half) { const int c = lane + 64 * half; const v4u* kr = (const v4u*)(KC + ((size_t)(b * 128 + c) * 4 + g) * 64);
        float d0 = 0.f, d1 = 0.f, d2 = 0.f, d3 = 0.f;
#pragma unroll 1
        for (int i = 0; i < 8; ++i) { const v4u w = kr[i]; const float kk[8] = {bflo(w.x), bfhi(w.x), bflo(w.y), bfhi(w.y), bflo(w.z), bfhi(w.z), bflo(w.w), bfhi(w.w)};
#pragma unroll
            for (int j = 0; j < 8; ++j) { const int d = i * 8 + j; d0 += qs[d] * kk[j]; d1 += qs[64 + d] * kk[j]; d2 += qs[128 + d] * kk[j]; d3 += qs[192 + d] * kk[j]; } }
        const bool ok = c < nvalid; const int bk = t5_bucket(t - (16 * c + 31)); const float* rb = rel + bk * 16 + g * 4;
        const float v0 = ok ? d0 + rb[0] * LOG2E : -INFINITY, v1 = ok ? d1 + rb[1] * LOG2E : -INFINITY, v2 = ok ? d2 + rb[2] * LOG2E : -INFINITY, v3 = ok ? d3 + rb[3] * LOG2E : -INFINITY;
        if (half == 0) { s0[0] = v0; s0[1] = v1; s0[2] = v2; s0[3] = v3; } else { s1[0] = v0; s1[1] = v1; s1[2] = v2; s1[3] = v3; } }
    float pgl0 = 0.f, pgl1 = 0.f;
#pragma unroll
    for (int r = 0; r < 4; ++r) { const float m = wave_max(fmaxf(s0[r], s1[r]));
        const float e0 = (lane < nvalid) ? exp2f(s0[r] - m) : 0.f, e1 = (lane + 64 < nvalid) ? exp2f(s1[r] - m) : 0.f;
        const float sum = wave_sum(e0 + e1), inv = 1.f / fmaxf(sum, 1e-30f); const float p0 = e0 * inv, p1 = e1 * inv;
        ps[r * 128 + lane] = p0; ps[r * 128 + lane + 64] = p1; pgl0 += p0; pgl1 += p1; }
    pg[1 + lane] = pgl0; pg[65 + lane] = pgl1; if (lane == 0) pg[0] = 0.f;
    WSYNC();
    float oc[4] = {0.f, 0.f, 0.f, 0.f};
#pragma unroll 4
    for (int c = 0; c < nvalid; ++c) { const float v = bf2f(VC[((size_t)(b * 128 + c) * 4 + g) * 64 + lane]); oc[0] += ps[c] * v; oc[1] += ps[128 + c] * v; oc[2] += ps[256 + c] * v; oc[3] += ps[384 + c] * v; }
    const int cur = t >> 6, blk = lane & 31;
    const int c0 = 4 * blk;
    const float imp = pg[c0] + 2.f * (pg[c0 + 1] + pg[c0 + 2] + pg[c0 + 3]) + pg[c0 + 4];
    const bool valid = blk <= cur; const bool forced = (blk == 0) || (blk == cur) || (blk == cur - 1);
    const float score = valid ? imp + (forced ? 1e4f : 0.f) : -1e30f;
    if (lane < 32) sc[lane] = score;
    WSYNC();
    int rank = 0;
    for (int j = 0; j < 32; ++j) { const float o = sc[j]; rank += (o > score || (o == score && j < blk)) ? 1 : 0; }
    const bool sel = (lane < 32) && valid && rank < 16;
    const unsigned mask = (unsigned)__ballot(sel);
    WSYNC();
    float os[4], ow[4];
    attn_row<0>(b, t, g, lane, scr, mask, PROJ, rel, nullptr, os);
    attn_row<1>(b, t, g, lane, scr, 0u, PROJ, rel, nullptr, ow);
    float ss = 0.f;
#pragma unroll
    for (int r = 0; r < 4; ++r) { const float* gl = GF + tok * 64 + g * 12 + r * 3;
        const float v = sigmoidf_(gl[0]) * oc[r] + sigmoidf_(gl[1]) * os[r] + sigmoidf_(gl[2]) * ow[r];
        O[tok * 2048 + (g * 4 + r) * 64 + lane] = (bf16)f2bf(v); ss += v * v; }
    ss = wave_sum(ss); if (lane < 4) SSQ[tok * 32 + g * 4 + lane] = (lane == 0) ? ss : 0.f;
}
__device__ __forceinline__ void fox_item(int item, int lane, LAS float* scr, const bf16* PROJ, const float* CUM, bf16* O, float* SSQ) {
    const int h = item & 15, bt = item >> 4, t = bt & 2047, b = bt >> 11; const size_t tok = (size_t)b * 2048 + t;
    float o[1];
    attn_row<2>(b, t, h, lane, scr, 0u, PROJ, nullptr, CUM, o);
    O[tok * 2048 + 1024 + h * 64 + lane] = (bf16)f2bf(o[0]); const float ss = wave_sum(o[0] * o[0]); if (lane == 0) SSQ[tok * 32 + 16 + h] = ss;
}
__device__ __forceinline__ void normalize_item(size_t tok, int lane, const bf16* O, const float* SSQ, bf16* MIXED) {
    float a = 0.f, f = 0.f;
    for (int i = 0; i < 16; ++i) a += SSQ[tok * 32 + i];
    for (int i = 0; i < 16; ++i) f += SSQ[tok * 32 + 16 + i];
    const float ra = 1.f / sqrtf(a * (1.f / 1024.f) + NORM_EPS), rf = 1.f / sqrtf(f * (1.f / 1024.f) + NORM_EPS);
    const v4u* src = (const v4u*)(O + tok * 2048); v4u* dst = (v4u*)(MIXED + tok * 2048);
#pragma unroll
    for (int i = 0; i < 4; ++i) { const v4u w = src[i * 64 + lane]; const float r = (i < 2) ? ra : rf; v4u o;
        o.x = pk2(bflo(w.x) * r, bfhi(w.x) * r); o.y = pk2(bflo(w.y) * r, bfhi(w.y) * r); o.z = pk2(bflo(w.z) * r, bfhi(w.z) * r); o.w = pk2(bflo(w.w) * r, bfhi(w.w) * r); dst[i * 64 + lane] = o; }
}
__device__ __forceinline__ void router_token(size_t tok, int lane, LAS float* lg, const bf16* HB, const float* HSSQ, const float* ffn_w, const float* wg, const float* bg, const float* we, const float* be, int& e0, int& e1, float& w0, float& w1, float& rstd) {
    float ss = (lane < 32) ? HSSQ[tok * 32 + lane] : 0.f; ss = wave_sum(ss);
    rstd = 1.f / sqrtf(ss * (1.f / 2048.f) + NORM_EPS);
    float acc[36];
#pragma unroll
    for (int o = 0; o < 36; ++o) acc[o] = 0.f;
    for (int i = 0; i < 32; ++i) { const int k = i * 64 + lane; const float hn = bf2f(HB[tok * 2048 + k]) * rstd * ffn_w[k];
        const f32x4 g4 = *(const f32x4*)(wg + (size_t)k * 4);
        acc[0] += hn * g4[0]; acc[1] += hn * g4[1]; acc[2] += hn * g4[2]; acc[3] += hn * g4[3];
#pragma unroll
        for (int j = 0; j < 8; ++j) { const f32x4 e4 = *(const f32x4*)(we + (size_t)k * 32 + j * 4);
            acc[4 + j * 4 + 0] += hn * e4[0]; acc[4 + j * 4 + 1] += hn * e4[1]; acc[4 + j * 4 + 2] += hn * e4[2]; acc[4 + j * 4 + 3] += hn * e4[3]; } }
#pragma unroll
    for (int o = 0; o < 36; ++o) { const float v = wave_sum(acc[o]); if (lane == 0) lg[o] = v + (o < 4 ? bg[o] : be[o - 4]); }
    WSYNC();
    int gsel = 0; float gm = lg[0];
    for (int i = 1; i < 4; ++i) if (lg[i] > gm) { gm = lg[i]; gsel = i; }
    float den = 0.f; for (int i = 0; i < 4; ++i) den += expf(lg[i] - gm);
    const float pgs = 1.f / den;
    const LAS float* el = lg + 4 + gsel * 8;
    int i1 = 0; float v1 = el[0];
    for (int j = 1; j < 8; ++j) if (el[j] > v1) { v1 = el[j]; i1 = j; }
    int i2 = 0; float v2 = -INFINITY;
    for (int j = 0; j < 8; ++j) if (j != i1 && el[j] > v2) { v2 = el[j]; i2 = j; }
    const float ex = expf(v2 - v1), d2 = 1.f / (1.f + ex);
    e0 = gsel * 8 + i1; e1 = gsel * 8 + i2; w0 = d2 * pgs; w1 = ex * d2 * pgs;
    WSYNC();
}

__device__ __forceinline__ void router_mfma(int bx, int tid, int lane, int wave, LAS float* part, const bf16* HB, const bf16* WrT) {
    typedef float f32x16 __attribute__((ext_vector_type(16)));
    const int r32 = lane & 31, hi = lane >> 5;
    f32x16 acc[2][2];
#pragma unroll
    for (int i = 0; i < 2; ++i)
#pragma unroll
        for (int j = 0; j < 2; ++j)
#pragma unroll
            for (int r = 0; r < 16; ++r) acc[i][j][r] = 0.f;
    const bf16* a0 = HB + (size_t)(bx * 64 + r32) * 2048 + wave * 256 + hi * 8;
    const bf16* b0 = WrT + wave * 16384 + lane * 8;
#pragma unroll 4
    for (int s = 0; s < 16; ++s) {
        bf16x8 A[2], Bh[2], Bl[2];
#pragma unroll
        for (int i = 0; i < 2; ++i) { A[i] = *(const bf16x8*)(a0 + (size_t)i * 32 * 2048 + s * 16); Bh[i] = *(const bf16x8*)(b0 + s * 1024 + i * 512); Bl[i] = *(const bf16x8*)(b0 + 64 * 2048 + s * 1024 + i * 512); }
#pragma unroll
        for (int i = 0; i < 2; ++i)
#pragma unroll
            for (int j = 0; j < 2; ++j) { acc[i][j] = __builtin_amdgcn_mfma_f32_32x32x16_bf16(A[i], Bh[j], acc[i][j], 0, 0, 0); acc[i][j] = __builtin_amdgcn_mfma_f32_32x32x16_bf16(A[i], Bl[j], acc[i][j], 0, 0, 0); }
    }
    LAS float* pw = part + wave * 4096;
#pragma unroll
    for (int i = 0; i < 2; ++i)
#pragma unroll
        for (int j = 0; j < 2; ++j)
#pragma unroll
            for (int r = 0; r < 16; ++r) pw[(32 * i + (r & 3) + 8 * (r >> 2) + 4 * hi) * 64 + 32 * j + r32] = acc[i][j][r];
}
__device__ __forceinline__ float fp8f(unsigned w, int i) { return i == 0 ? __builtin_amdgcn_cvt_f32_fp8((int)w, 0) : i == 1 ? __builtin_amdgcn_cvt_f32_fp8((int)w, 1) : i == 2 ? __builtin_amdgcn_cvt_f32_fp8((int)w, 2) : __builtin_amdgcn_cvt_f32_fp8((int)w, 3); }
__device__ __forceinline__ void final_item(size_t tok, int lane, const bf16* HB, const unsigned char* YS, const float* fw, float* OUT) {
    float v[32]; float ss = 0.f;
    const v4u* h4 = (const v4u*)(HB + tok * 2048); const unsigned long long* y0 = (const unsigned long long*)(YS + tok * 2048); const unsigned long long* y1 = (const unsigned long long*)(YS + (size_t)16384 * 2048 + tok * 2048);
#pragma unroll
    for (int i = 0; i < 4; ++i) { const v4u a = h4[i * 64 + lane]; const unsigned long long p = y0[i * 64 + lane], q = y1[i * 64 + lane];
        const unsigned pl = (unsigned)p, ph = (unsigned)(p >> 32), ql = (unsigned)q, qh = (unsigned)(q >> 32);
        v[i * 8 + 0] = bflo(a.x) + fp8f(pl, 0) + fp8f(ql, 0); v[i * 8 + 1] = bfhi(a.x) + fp8f(pl, 1) + fp8f(ql, 1); v[i * 8 + 2] = bflo(a.y) + fp8f(pl, 2) + fp8f(ql, 2); v[i * 8 + 3] = bfhi(a.y) + fp8f(pl, 3) + fp8f(ql, 3);
        v[i * 8 + 4] = bflo(a.z) + fp8f(ph, 0) + fp8f(qh, 0); v[i * 8 + 5] = bfhi(a.z) + fp8f(ph, 1) + fp8f(qh, 1); v[i * 8 + 6] = bflo(a.w) + fp8f(ph, 2) + fp8f(qh, 2); v[i * 8 + 7] = bfhi(a.w) + fp8f(ph, 3) + fp8f(qh, 3); }
#pragma unroll
    for (int i = 0; i < 32; ++i) ss += v[i] * v[i];
    ss = wave_sum(ss); const float r = 1.f / sqrtf(ss * (1.f / 2048.f) + NORM_EPS);
#pragma unroll
    for (int i = 0; i < 4; ++i) { const int k = i * 512 + lane * 8; const f32x4 wa = *(const f32x4*)(fw + k), wb = *(const f32x4*)(fw + k + 4);
        f32x4 oa = {v[i * 8 + 0] * r * wa[0], v[i * 8 + 1] * r * wa[1], v[i * 8 + 2] * r * wa[2], v[i * 8 + 3] * r * wa[3]};
        f32x4 ob = {v[i * 8 + 4] * r * wb[0], v[i * 8 + 5] * r * wb[1], v[i * 8 + 6] * r * wb[2], v[i * 8 + 7] * r * wb[3]};
        *(f32x4*)(OUT + tok * 2048 + k) = oa; *(f32x4*)(OUT + tok * 2048 + k + 4) = ob; }
}

namespace att {
typedef float f32x16 __attribute__((ext_vector_type(16)));
typedef short s16x4 __attribute__((ext_vector_type(4)));
typedef short v4i16_t __attribute__((ext_vector_type(4)));
typedef float f32x2_t __attribute__((ext_vector_type(2))); typedef __bf16 bf16x2_t __attribute__((ext_vector_type(2)));
typedef unsigned u32x4w __attribute__((ext_vector_type(4)));
__device__ __forceinline__ int clamp127(int d) { return d < 0 ? 0 : (d > 127 ? 127 : d); }
constexpr int SLOTB = 8192;
constexpr int A_KR = 0, A_VR = 32768, A_WSF = 65536, A_OST = 67584, A_PG = 100352, A_SC = 133120, A_SELM = 141312, A_BTAB = 141568, A_GATE = 143616, A_QSLOT = 146688;
static_assert(A_QSLOT + 16 <= 8 * 18432, "attention LDS map");
constexpr int A_BTW = 8 * 18432 + 9216;
constexpr float THR = 8.f;
constexpr float FOX_CUT = 40.f;
#define SBAR() __builtin_amdgcn_sched_barrier(0)
#ifndef PIPE_SGB
#define PIPE_SGB() do { _Pragma("unroll") for (int i = 0; i < 8; ++i) { __builtin_amdgcn_sched_group_barrier(0x100, 2, 0); __builtin_amdgcn_sched_group_barrier(0x008, 1, 0); __builtin_amdgcn_sched_group_barrier(0x002, 10, 0); } } while (0)
#endif
#define WAIT_BAR0() asm volatile("s_waitcnt vmcnt(0) lgkmcnt(0)\n\ts_barrier" ::: "memory")
__device__ __forceinline__ int crow(int r, int hi) { return (r & 3) + 8 * (r >> 2) + 4 * hi; }
__device__ __forceinline__ void glds16(const void* gsrc, unsigned lds_dst) { unsigned keep;
    asm volatile("s_mov_b32 %0, m0\n\ts_mov_b32 m0, %2\n\ts_nop 0\n\tglobal_load_lds_dwordx4 %1, off\n\ts_mov_b32 m0, %0" : "=&s"(keep) : "v"(gsrc), "s"(lds_dst) : "memory"); }
__device__ __forceinline__ unsigned cvtpk_s(float lo, float hi) { f32x2_t v = {lo, hi}; bf16x2_t b = __builtin_convertvector(v, bf16x2_t); return __builtin_bit_cast(unsigned, b); }
__device__ __forceinline__ s16x4 vtr(const LAS char* p) { return __builtin_bit_cast(s16x4, __builtin_amdgcn_ds_read_tr16_b64_v4i16((LAS v4i16_t*)p)); }
__device__ __forceinline__ float swapmax(float m) { auto rr = __builtin_amdgcn_permlane32_swap(__float_as_uint(m), __float_as_uint(m), false, false); return fmaxf(__uint_as_float(rr[0]), __uint_as_float(rr[1])); }
__device__ __forceinline__ float swapsum(float m) { auto rr = __builtin_amdgcn_permlane32_swap(__float_as_uint(m), __float_as_uint(m), false, false); return __uint_as_float(rr[0]) + __uint_as_float(rr[1]); }

struct Ctx { int tid, lane, r32, hi, wid; LAS char* shm; unsigned lds0; };
struct FlashState { f32x16 o[2]; float mhat, l; bool started; };

__device__ __forceinline__ void dma_k(const Ctx& c, const bf16* Ktile, long pitch, int slot) {
    glds16(Ktile + (long)c.lane * pitch + c.wid * 8, (unsigned)__builtin_amdgcn_readfirstlane(c.lds0 + A_KR + slot * SLOTB + c.wid * 1024)); }
__device__ __forceinline__ void dma_v(const Ctx& c, const bf16* Vtile, long pitch, int slot) {
    glds16(Vtile + (long)(16 * (c.wid & 3) + (c.lane >> 2)) * pitch + (c.wid >> 2) * 32 + (c.lane & 3) * 8, (unsigned)__builtin_amdgcn_readfirstlane(c.lds0 + A_VR + slot * SLOTB + c.wid * 1024)); }

__device__ __forceinline__ void qkt(f32x16& p0, f32x16& p1, const Ctx& c, int slot, const bf16x8 (&qr)[4], float cinit) {
    const LAS char* kb = c.shm + A_KR + slot * SLOTB + c.hi * 1024 + c.r32 * 16;
#pragma unroll
    for (int r = 0; r < 16; ++r) { p0[r] = cinit; p1[r] = cinit; }
#pragma unroll
    for (int d0 = 0; d0 < 4; ++d0) {
        const bf16x8 b0 = *(const LAS bf16x8*)(kb + d0 * 2048), b1 = *(const LAS bf16x8*)(kb + d0 * 2048 + 512);
        p0 = __builtin_amdgcn_mfma_f32_32x32x16_bf16(b0, qr[d0], p0, 0, 0, 0); p1 = __builtin_amdgcn_mfma_f32_32x32x16_bf16(b1, qr[d0], p1, 0, 0, 0); }
}
__device__ __forceinline__ void pv(f32x16 (&o)[2], const Ctx& c, int slot, const f32x16& p0, const f32x16& p1) {
    u32x4w pw[4];
#pragma unroll
    for (int k = 0; k < 2; ++k) {
        pw[k] = (u32x4w){cvtpk_s(p0[8 * k + 0], p0[8 * k + 1]), cvtpk_s(p0[8 * k + 2], p0[8 * k + 3]), cvtpk_s(p0[8 * k + 4], p0[8 * k + 5]), cvtpk_s(p0[8 * k + 6], p0[8 * k + 7])};
        pw[2 + k] = (u32x4w){cvtpk_s(p1[8 * k + 0], p1[8 * k + 1]), cvtpk_s(p1[8 * k + 2], p1[8 * k + 3]), cvtpk_s(p1[8 * k + 4], p1[8 * k + 5]), cvtpk_s(p1[8 * k + 6], p1[8 * k + 7])}; }
    const LAS char* vp = c.shm + A_VR + slot * SLOTB + ((c.lane >> 4) & 1) * 32 + (c.lane & 3) * 8 + (4 * c.hi + ((c.lane & 15) >> 2)) * 64;
#pragma unroll
    for (int d0 = 0; d0 < 2; ++d0)
#pragma unroll
        for (int ks = 0; ks < 4; ++ks) { const s16x4 lo = vtr(vp + d0 * 4096 + ks * 1024), hi4 = vtr(vp + d0 * 4096 + ks * 1024 + 512);
            const bf16x8 vf = (bf16x8){lo[0], lo[1], lo[2], lo[3], hi4[0], hi4[1], hi4[2], hi4[3]};
            o[d0] = __builtin_amdgcn_mfma_f32_32x32x16_bf16(__builtin_bit_cast(bf16x8, pw[ks]), vf, o[d0], 0, 0, 0); }
}
__device__ __forceinline__ float max3f(float a, float b, float c) { float r; asm("v_max3_f32 %0, %1, %2, %3" : "=v"(r) : "v"(a), "v"(b), "v"(c)); return r; }
__device__ __forceinline__ float rowmax32(const f32x16& p0, const f32x16& p1) {
    float a = max3f(p0[0], p0[1], p1[0]), b = max3f(p0[2], p0[3], p1[1]); a = max3f(a, p1[2], p1[3]);
#pragma unroll
    for (int r = 4; r < 16; r += 4) { a = max3f(a, p0[r], p0[r + 1]); b = max3f(b, p0[r + 2], p0[r + 3]); a = max3f(a, p1[r], p1[r + 1]); b = max3f(b, p1[r + 2], p1[r + 3]); }
    return swapmax(max3f(a, b, b));
}
__device__ __forceinline__ void softmax_step(FlashState& s, f32x16& p0, f32x16& p1, const Ctx& c) {
    const float rm = rowmax32(p0, p1);
    const bool fin = rm > -INFINITY; const bool need = fin && (!s.started || rm > THR);
    if (__any(need)) {
        const float dl = need ? (s.started ? fmaxf(rm, 0.f) : rm) : 0.f; s.mhat += dl;
#pragma unroll
        for (int r = 0; r < 16; ++r) { p0[r] -= dl; p1[r] -= dl; }
        const float f = __builtin_amdgcn_exp2f(-dl); s.l *= f;
        LAS float* wsf = (LAS float*)(c.shm + A_WSF) + c.wid * 64;
        if (c.hi == 0) wsf[c.r32] = f;
        asm volatile("s_waitcnt lgkmcnt(0)" ::: "memory");
#pragma unroll
        for (int r = 0; r < 16; ++r) { const float fr = wsf[crow(r, c.hi)]; s.o[0][r] *= fr; s.o[1][r] *= fr; }
        asm volatile("s_waitcnt lgkmcnt(0)" ::: "memory");
    }
    s.started = s.started || fin;
    float sacc = 0.f;
#pragma unroll
    for (int r = 0; r < 16; ++r) { p0[r] = __builtin_amdgcn_exp2f(p0[r]); p1[r] = __builtin_amdgcn_exp2f(p1[r]); sacc += p0[r] + p1[r]; }
    s.l += sacc;
}
__device__ __forceinline__ float sm_decide(FlashState& s, f32x16& p0, f32x16& p1, bool& any) {
    const float rm = rowmax32(p0, p1);
    const bool fin = rm > -INFINITY; const bool need = fin && (!s.started || rm > THR);
    float f = 1.f; any = __any(need);
    if (any) {
        const float dl = need ? (s.started ? fmaxf(rm, 0.f) : rm) : 0.f; s.mhat += dl;
#pragma unroll
        for (int r = 0; r < 16; ++r) { p0[r] -= dl; p1[r] -= dl; }
        f = __builtin_amdgcn_exp2f(-dl); s.l *= f;
    }
    s.started = s.started || fin;
    return f;
}
__device__ __forceinline__ void sm_rescale_o(FlashState& s, float f, const Ctx& c) {
    LAS float* wsf = (LAS float*)(c.shm + A_WSF) + c.wid * 64;
    if (c.hi == 0) wsf[c.r32] = f;
    asm volatile("s_waitcnt lgkmcnt(0)" ::: "memory");
#pragma unroll
    for (int r = 0; r < 16; ++r) { const float fr = wsf[crow(r, c.hi)]; s.o[0][r] *= fr; s.o[1][r] *= fr; }
    asm volatile("s_waitcnt lgkmcnt(0)" ::: "memory");
}
__device__ __forceinline__ void sm_exp(FlashState& s, f32x16& p0, f32x16& p1) {
    float sacc = 0.f;
#pragma unroll
    for (int r = 0; r < 16; ++r) { p0[r] = __builtin_amdgcn_exp2f(p0[r]); p1[r] = __builtin_amdgcn_exp2f(p1[r]); sacc += p0[r] + p1[r]; }
    s.l += sacc;
}
__device__ __forceinline__ void sm_pack(const f32x16& p0, const f32x16& p1, u32x4w (&pw)[4]) {
#pragma unroll
    for (int k = 0; k < 2; ++k) {
        pw[k] = (u32x4w){cvtpk_s(p0[8 * k + 0], p0[8 * k + 1]), cvtpk_s(p0[8 * k + 2], p0[8 * k + 3]), cvtpk_s(p0[8 * k + 4], p0[8 * k + 5]), cvtpk_s(p0[8 * k + 6], p0[8 * k + 7])};
        pw[2 + k] = (u32x4w){cvtpk_s(p1[8 * k + 0], p1[8 * k + 1]), cvtpk_s(p1[8 * k + 2], p1[8 * k + 3]), cvtpk_s(p1[8 * k + 4], p1[8 * k + 5]), cvtpk_s(p1[8 * k + 6], p1[8 * k + 7])}; }
}
__device__ __forceinline__ void pv_packed(f32x16 (&o)[2], const Ctx& c, int slot, const u32x4w (&pw)[4]) {
    const LAS char* vp = c.shm + A_VR + slot * SLOTB + ((c.lane >> 4) & 1) * 32 + (c.lane & 3) * 8 + (4 * c.hi + ((c.lane & 15) >> 2)) * 64;
#pragma unroll
    for (int d0 = 0; d0 < 2; ++d0)
#pragma unroll
        for (int ks = 0; ks < 4; ++ks) { const s16x4 lo = vtr(vp + d0 * 4096 + ks * 1024), hi4 = vtr(vp + d0 * 4096 + ks * 1024 + 512);
            const bf16x8 vf = (bf16x8){lo[0], lo[1], lo[2], lo[3], hi4[0], hi4[1], hi4[2], hi4[3]};
            o[d0] = __builtin_amdgcn_mfma_f32_32x32x16_bf16(__builtin_bit_cast(bf16x8, pw[ks]), vf, o[d0], 0, 0, 0); }
}
__device__ __forceinline__ f32x16 splat(float v) { f32x16 x;
#pragma unroll
    for (int r = 0; r < 16; ++r) x[r] = v; return x; }

template <bool PIPE, class Next, class CInit, class Post, class Skip>
__device__ __forceinline__ int flash(FlashState& s, const Ctx& c, const bf16x8 (&qr)[4], const bf16* Kc, const bf16* Vc, long pitch, int first, Next next, CInit cinit, Post post, Skip skip,
                                     int pair0 = 0, bool pre = false, const bf16* tK = nullptr, const bf16* tV = nullptr, int tj0 = -1, int tj1 = -1) {
    if (first < 0) return pair0;
    int j0 = first, j1 = next(first), pair = pair0;
    if (!pre) { dma_k(c, Kc + (long)j0 * 64 * pitch, pitch, 2 * pair); dma_v(c, Vc + (long)j0 * 64 * pitch, pitch, 2 * pair);
        if (j1 >= 0) { dma_k(c, Kc + (long)j1 * 64 * pitch, pitch, 2 * pair + 1); dma_v(c, Vc + (long)j1 * 64 * pitch, pitch, 2 * pair + 1); } }
    while (j0 >= 0) {
        const int n0 = j1 >= 0 ? next(j1) : -1, n1 = n0 >= 0 ? next(n0) : -1;
        WAIT_BAR0();
        const int so = 2 * (pair ^ 1);
        if (n0 >= 0) { dma_k(c, Kc + (long)n0 * 64 * pitch, pitch, so); dma_v(c, Vc + (long)n0 * 64 * pitch, pitch, so);
            if (n1 >= 0) { dma_k(c, Kc + (long)n1 * 64 * pitch, pitch, so + 1); dma_v(c, Vc + (long)n1 * 64 * pitch, pitch, so + 1); } }
        else if (tj0 >= 0) { dma_k(c, tK + (long)tj0 * 64 * pitch, pitch, so); dma_v(c, tV + (long)tj0 * 64 * pitch, pitch, so);
            if (tj1 >= 0) { dma_k(c, tK + (long)tj1 * 64 * pitch, pitch, so + 1); dma_v(c, tV + (long)tj1 * 64 * pitch, pitch, so + 1); }
            tj0 = -1; }
        bool both = false;
        if constexpr (PIPE) both = j1 >= 0 && !skip(j0) && !skip(j1);
        if (both) {
            const int sl0 = 2 * pair, sl1 = 2 * pair + 1;
            f32x16 a0, a1, b0, b1; u32x4w pw[4]; bool any0, any1;
            qkt(a0, a1, c, sl0, qr, cinit(j0));
            asm volatile("s_nop 15\n\ts_nop 7" : "+v"(a0), "+v"(a1));
            post(j0, a0, a1);
            const float f0 = sm_decide(s, a0, a1, any0);
            if (any0) sm_rescale_o(s, f0, c);
            SBAR();
            qkt(b0, b1, c, sl1, qr, cinit(j1));
            sm_exp(s, a0, a1);
            PIPE_SGB();
            sm_pack(a0, a1, pw);
            asm volatile("s_nop 15\n\ts_nop 7" : "+v"(b0), "+v"(b1));
            post(j1, b0, b1);
            const float f1 = sm_decide(s, b0, b1, any1);
            SBAR();
            pv_packed(s.o, c, sl0, pw);
            sm_exp(s, b0, b1);
            PIPE_SGB();
            if (any1) sm_rescale_o(s, f1, c);
            sm_pack(b0, b1, pw);
            pv_packed(s.o, c, sl1, pw);
        } else
#pragma unroll
        for (int h = 0; h < 2; ++h) {
            const int j = h ? j1 : j0, slot = 2 * pair + h;
            if (j >= 0 && !skip(j)) {
                f32x16 p0, p1;
                qkt(p0, p1, c, slot, qr, cinit(j));
                asm volatile("s_nop 15\n\ts_nop 7" : "+v"(p0), "+v"(p1));
                post(j, p0, p1);
                softmax_step(s, p0, p1, c);
                pv(s.o, c, slot, p0, p1);
            }
        }
        pair ^= 1; j0 = n0; j1 = n1;
    }
    asm volatile("s_waitcnt lgkmcnt(0)\n\ts_barrier" ::: "memory");
    return pair;
}
__device__ __forceinline__ void load_q(bf16x8 (&qr)[4], const bf16* Qrow, int hi) {
#pragma unroll
    for (int d0 = 0; d0 < 4; ++d0) qr[d0] = *(const bf16x8*)(Qrow + d0 * 16 + hi * 8);
}
__device__ __forceinline__ void accum_branch(f32x16 (&ot)[2], const f32x16 (&o)[2], float fac, const Ctx& c) {
    LAS float* wsf = (LAS float*)(c.shm + A_WSF) + c.wid * 64;
    if (c.hi == 0) wsf[c.r32] = fac;
    asm volatile("s_waitcnt lgkmcnt(0)" ::: "memory");
#pragma unroll
    for (int r = 0; r < 16; ++r) { const float fr = wsf[crow(r, c.hi)]; ot[0][r] += o[0][r] * fr; ot[1][r] += o[1][r] * fr; }
    asm volatile("s_waitcnt lgkmcnt(0)" ::: "memory");
}
__device__ __forceinline__ void store_o(const f32x16 (&o)[2], const Ctx& c, bf16* Orow0, float* ssq0) {
    LAS bf16* stg = (LAS bf16*)(c.shm + A_OST) + c.wid * 2048;
#pragma unroll
    for (int r = 0; r < 16; ++r) { const int orow = crow(r, c.hi);
#pragma unroll
        for (int d0 = 0; d0 < 2; ++d0) stg[orow * 64 + d0 * 32 + c.r32] = (bf16)f2bf(o[d0][r]); }
    asm volatile("s_waitcnt lgkmcnt(0)" ::: "memory");
#pragma unroll
    for (int i = 0; i < 4; ++i) { const int row = i * 8 + (c.lane >> 3), ch = c.lane & 7; const v4u v = *(const LAS v4u*)(stg + row * 64 + ch * 8);
        *(v4u*)(Orow0 + (long)row * 2048 + ch * 8) = v;
        float ss = bflo(v.x) * bflo(v.x) + bfhi(v.x) * bfhi(v.x) + bflo(v.y) * bflo(v.y) + bfhi(v.y) * bfhi(v.y) + bflo(v.z) * bflo(v.z) + bfhi(v.z) * bfhi(v.z) + bflo(v.w) * bflo(v.w) + bfhi(v.w) * bfhi(v.w);
        ss += __shfl_xor(ss, 1); ss += __shfl_xor(ss, 2); ss += __shfl_xor(ss, 4);
        if (ch == 0) ssq0[(long)row * 32] = ss; }
    asm volatile("s_waitcnt lgkmcnt(0)" ::: "memory");
}

__device__ __forceinline__ void fox_unit(const Ctx& c, int b, int h, int qb, const bf16* PROJ, const float* CUM, const unsigned* KN2, bf16* O, float* SSQ, unsigned* qhead, unsigned& pend) {
    const int q0 = qb * 256, NT = 4 * (qb + 1); const long rowbase = (long)b * 2048;
    const bf16* Kb = PROJ + rowbase * NPROJ + C_FK + h * 64; const bf16* Vb = PROJ + rowbase * NPROJ + C_FV + h * 64;
    dma_k(c, Kb + (long)(NT - 1) * 64 * NPROJ, NPROJ, 0); dma_v(c, Vb + (long)(NT - 1) * 64 * NPROJ, NPROJ, 0);
    dma_k(c, Kb + (long)(NT - 2) * 64 * NPROJ, NPROJ, 1); dma_v(c, Vb + (long)(NT - 2) * 64 * NPROJ, NPROJ, 1);
    LAS float* cumL = (LAS float*)(c.shm + A_PG);
    const float* cu = CUM + (size_t)(b * 16 + h) * 2048;
    float cv[4];
#pragma unroll
    for (int k = 0; k < 4; ++k) cv[k] = cu[c.tid + 512 * k];
    bf16x8 qr[4]; load_q(qr, PROJ + (rowbase + q0 + c.wid * 32 + c.r32) * NPROJ + C_FQ + h * 64, c.hi);
    const int qrel = c.wid * 32 + c.r32; const float cq = cu[q0 + qrel];
    const float kn2 = __builtin_bit_cast(float, __hip_atomic_load(KN2 + b * 16 + h, __ATOMIC_RELAXED, __HIP_MEMORY_SCOPE_AGENT));
#pragma unroll
    for (int k = 0; k < 4; ++k) cumL[c.tid + 512 * k] = cv[k];
    FlashState s; s.o[0] = splat(0.f); s.o[1] = splat(0.f); s.mhat = 0.f; s.l = 0.f; s.started = false;
    const int wid = c.wid, hi = c.hi;
    float qn2 = 0.f;
#pragma unroll
    for (int d0 = 0; d0 < 4; ++d0)
#pragma unroll
        for (int j = 0; j < 8; ++j) { const float x = bf2f((unsigned short)qr[d0][j]); qn2 += x * x; }
    qn2 = swapsum(qn2);
    const float qkb = sqrtf(qn2 * kn2) * 1.0001f;
    auto cinit = [&](int) { return cq - s.mhat; };
    auto post = [&](int j, f32x16& p0, f32x16& p1) {
            const LAS f32x4* ck = (const LAS f32x4*)(cumL + 64 * j + 4 * hi);
#pragma unroll
            for (int k = 0; k < 4; ++k) { const f32x4 a = ck[2 * k];
#pragma unroll
                for (int i = 0; i < 4; ++i) p0[4 * k + i] -= a[i]; }
            SBAR();
#pragma unroll
            for (int k = 0; k < 4; ++k) { const f32x4 bq = ck[2 * k + 8];
#pragma unroll
                for (int i = 0; i < 4; ++i) p1[4 * k + i] -= bq[i]; }
            SBAR();
            const int jb = j - (NT - 4);
            if (jb >= 0) { const int kb = 64 * jb + 4 * hi;
#pragma unroll
                for (int r = 0; r < 16; ++r) { const int kv = kb + (r & 3) + 8 * (r >> 2); if (kv > qrel) p0[r] = -INFINITY; if (kv + 32 > qrel) p1[r] = -INFINITY; } }
        };
    auto skip = [&](int j) { const int jb = j - (NT - 4); return jb >= 0 && 64 * jb > 32 * wid + 31; };
    flash<false>(s, c, qr, Kb, Vb, (long)NPROJ, NT - 1, [&](int j) { return j > NT - 4 ? j - 1 : -1; }, cinit, post, skip, 0, true, Kb, Vb, NT > 4 ? NT - 5 : -1, NT - 6);
    if (NT > 4) {
        LAS float* wmx = (LAS float*)(c.shm + A_SC);
        const float ub = wave_max(qkb + cq - s.mhat);
        if (c.lane == 0) wmx[c.wid] = ub;
        __syncthreads();
        float A = wmx[0];
#pragma unroll
        for (int w = 1; w < 8; ++w) A = fmaxf(A, wmx[w]);
        A = __builtin_bit_cast(float, __builtin_amdgcn_readfirstlane(__builtin_bit_cast(int, A)));
        auto alive = [&](int j) { return j >= 0 && A - cumL[64 * j + 63] >= -FOX_CUT; };
        flash<false>(s, c, qr, Kb, Vb, (long)NPROJ, alive(NT - 5) ? NT - 5 : -1, [&](int j) { return alive(j - 1) ? j - 1 : -1; }, cinit, post, [](int) { return false; }, 0, true);
    }
    if (c.tid == 0) pend = __hip_atomic_fetch_add(qhead, 1u, __ATOMIC_RELAXED, __HIP_MEMORY_SCOPE_AGENT) + gridDim.x;
    const float lt = swapsum(s.l);
    f32x16 ot[2]; ot[0] = splat(0.f); ot[1] = splat(0.f);
    accum_branch(ot, s.o, 1.f / lt, c);
    store_o(ot, c, O + (rowbase + q0 + c.wid * 32) * 2048 + 1024 + h * 64, SSQ + (rowbase + q0 + c.wid * 32) * 32 + 16 + h);
    asm volatile("s_waitcnt lgkmcnt(0)\n\ts_barrier" ::: "memory");
}

__device__ __forceinline__ void nsa_unit(const Ctx& c, int b, int g, int qt, const bf16* PROJ, const bf16* KC, const bf16* VC, const float* rel, const float* GF, bf16* O, float* SSQ, unsigned* qhead, unsigned& pend) {
    const long rowbase = (long)b * 2048; const int t0 = 64 * qt;
    const int head = c.wid >> 1, a = 32 * (c.wid & 1) + c.r32;
    const int t = t0 + a, hi = c.hi;
    LAS float* pg = (LAS float*)(c.shm + A_PG); LAS float* sc = (LAS float*)(c.shm + A_SC); LAS unsigned* selm = (LAS unsigned*)(c.shm + A_SELM);
    LAS float* btab = (LAS float*)(c.shm + A_BTAB); LAS float* gate = (LAS float*)(c.shm + A_GATE);
    const bool two = qt >= 16;
    { const bf16* Kc = KC + ((size_t)b * 128 * 4 + g) * 64; const bf16* Vc = VC + ((size_t)b * 128 * 4 + g) * 64;
        dma_k(c, Kc, 256, 0); dma_v(c, Vc, 256, 0);
        if (two) { dma_k(c, Kc + 64 * 256, 256, 1); dma_v(c, Vc + 64 * 256, 256, 1); } }
    const bf16* Ks = PROJ + rowbase * NPROJ + C_KSLC + g * 64; const bf16* Vs = PROJ + rowbase * NPROJ + C_VSLC + g * 64;
    dma_k(c, Ks + (long)qt * 64 * NPROJ, NPROJ, 2); dma_v(c, Vs + (long)qt * 64 * NPROJ, NPROJ, 2);
    if (qt > 0) { dma_k(c, Ks + (long)(qt - 1) * 64 * NPROJ, NPROJ, 3); dma_v(c, Vs + (long)(qt - 1) * 64 * NPROJ, NPROJ, 3); }
    bf16x8 qr[4]; load_q(qr, PROJ + (rowbase + t) * NPROJ + C_NQ + (g * 4 + head) * 64, hi);
    { const int hh = c.tid >> 7, d = c.tid & 127; const int hq = g * 4 + hh; const float r31 = rel[31 * 16 + hq];
        const float rb = rel[t5_bucket(d) * 16 + hq];
        const int i1 = c.tid + 512, h0 = c.tid >> 8, h1 = i1 >> 8, d0 = (c.tid & 255) - 64, d1 = (i1 & 255) - 64;
        const float w0 = rel[t5_bucket(clamp127(d0)) * 16 + g * 4 + h0], w0r = rel[31 * 16 + g * 4 + h0], w1 = rel[t5_bucket(clamp127(d1)) * 16 + g * 4 + h1], w1r = rel[31 * 16 + g * 4 + h1];
        const int ga = c.tid, gb = c.tid < 256 ? c.tid + 512 : c.tid;
        const float gv0 = GF[(size_t)(rowbase + t0 + (ga % 192) / 3) * 64 + g * 12 + (ga / 192) * 3 + (ga % 192) % 3], gv1 = GF[(size_t)(rowbase + t0 + (gb % 192) / 3) * 64 + g * 12 + (gb / 192) * 3 + (gb % 192) % 3];
        btab[c.tid] = (rb - r31) * LOG2E;
        LAS float* bw = (LAS float*)(c.shm + A_BTW);
        bw[c.tid] = (d0 >= 0 && d0 < 127) ? (w0 - w0r) * LOG2E : 0.f; bw[i1] = (d1 >= 0 && d1 < 127) ? (w1 - w1r) * LOG2E : 0.f;
        gate[ga] = sigmoidf_(gv0); if (c.tid < 256) gate[gb] = sigmoidf_(gv1); }
    if (c.tid < 64) selm[c.tid] = 0u;
    f32x16 ot[2]; ot[0] = splat(0.f); ot[1] = splat(0.f);
    const LAS float* bt = btab + head * 128;
    __syncthreads();
    {
        WAIT_BAR0();
        f32x16 p0, p1, p2, p3;
        qkt(p0, p1, c, 0, qr, 0.f);
        if (two) qkt(p2, p3, c, 1, qr, 0.f); else { p2 = splat(-INFINITY); p3 = splat(-INFINITY); }
        const int cmax = t >= 31 ? (t - 31) >> 4 : -1;
        auto cmp_post = [&](f32x16& p, int cbase) {
#pragma unroll
            for (int q4 = 0; q4 < 4; ++q4) {
                float bv[4];
#pragma unroll
                for (int i = 0; i < 4; ++i) { const int c0 = crow(4 * q4 + i, hi) + cbase; bv[i] = bt[clamp127(t - 16 * c0 - 31)]; }
                asm volatile("" : "+v"(bv[0]), "+v"(bv[1]), "+v"(bv[2]), "+v"(bv[3]));
#pragma unroll
                for (int i = 0; i < 4; ++i) { const int r = 4 * q4 + i; const int c0 = crow(r, hi) + cbase; p[r] = (c0 <= cmax) ? p[r] + bv[i] : -INFINITY; }
            }
        };
        cmp_post(p0, 0); cmp_post(p1, 32);
        if (two) { cmp_post(p2, 64); cmp_post(p3, 96); }
        float rm = fmaxf(rowmax32(p0, p1), rowmax32(p2, p3)); if (!(rm > -INFINITY)) rm = 0.f;
        float sum = 0.f;
#pragma unroll
        for (int r = 0; r < 16; ++r) { p0[r] = __builtin_amdgcn_exp2f(p0[r] - rm); p1[r] = __builtin_amdgcn_exp2f(p1[r] - rm); p2[r] = __builtin_amdgcn_exp2f(p2[r] - rm); p3[r] = __builtin_amdgcn_exp2f(p3[r] - rm); sum += (p0[r] + p1[r]) + (p2[r] + p3[r]); }
        sum = swapsum(sum); const float inv = 1.f / fmaxf(sum, 1e-30f);
#pragma unroll
        for (int r = 0; r < 16; ++r) { p0[r] *= inv; p1[r] *= inv; p2[r] *= inv; p3[r] *= inv; }
        if (qt >= 16) {
#pragma unroll 1
            for (int hh = 0; hh < 4; ++hh) {
                if (head == hh) {
#pragma unroll
                    for (int r = 0; r < 16; ++r) { const int cc = crow(r, hi);
                        if (hh == 0) { pg[(cc) * 64 + a] = p0[r]; pg[(cc + 32) * 64 + a] = p1[r]; pg[(cc + 64) * 64 + a] = p2[r]; pg[(cc + 96) * 64 + a] = p3[r]; }
                        else { pg[(cc) * 64 + a] += p0[r]; pg[(cc + 32) * 64 + a] += p1[r]; pg[(cc + 64) * 64 + a] += p2[r]; pg[(cc + 96) * 64 + a] += p3[r]; } } }
                __syncthreads();
            }
        }
        { const float g0 = gate[(head * 64 + a) * 3 + 0];
#pragma unroll
            for (int r = 0; r < 16; ++r) { p0[r] *= g0; p1[r] *= g0; p2[r] *= g0; p3[r] *= g0; } }
        pv(ot, c, 0, p0, p1);
        if (two) pv(ot, c, 1, p2, p3);
        asm volatile("s_waitcnt lgkmcnt(0)\n\ts_barrier" ::: "memory");
    }
    unsigned mymask;
    if (qt >= 16) {
        const int tk = c.tid & 63, grp = c.tid >> 6; float sv[4];
#pragma unroll
        for (int i = 0; i < 4; ++i) { const int blk = 4 * grp + i, c0 = 4 * blk;
            const float imp = (c0 > 0 ? pg[(c0 - 1) * 64 + tk] : 0.f) + 2.f * (pg[c0 * 64 + tk] + pg[(c0 + 1) * 64 + tk] + pg[(c0 + 2) * 64 + tk]) + pg[(c0 + 3) * 64 + tk];
            const bool valid = blk <= qt, forced = (blk == 0) || (blk == qt) || (blk == qt - 1);
            sv[i] = valid ? imp + (forced ? 1e4f : 0.f) : -1e30f; sc[blk * 64 + tk] = sv[i]; }
        __syncthreads();
        int rk[4] = {0, 0, 0, 0};
#pragma unroll 8
        for (int j = 0; j < 32; ++j) { const float o = sc[j * 64 + tk];
#pragma unroll
            for (int i = 0; i < 4; ++i) rk[i] += (int)(o > sv[i]) + (int)((o == sv[i]) & (j < 4 * grp + i)); }
        unsigned bits = 0u;
#pragma unroll
        for (int i = 0; i < 4; ++i) if (rk[i] < 16 && 4 * grp + i <= qt) bits |= 1u << (4 * grp + i);
        if (bits) __hip_atomic_fetch_or(selm + tk, bits, __ATOMIC_RELAXED, __HIP_MEMORY_SCOPE_WORKGROUP);
        __syncthreads();
        mymask = selm[a];
    } else mymask = (qt == 31) ? 0xffffffffu : ((1u << (qt + 1)) - 1u);
    unsigned um = mymask;
    if (qt >= 16) { um = 0u; for (int i = 0; i < 64; ++i) um |= selm[i]; }
    um = (unsigned)__builtin_amdgcn_readfirstlane((int)um);
    const int awave = 32 * (c.wid & 1);
    const LAS float* bwin = (const LAS float*)(c.shm + A_BTW) + head * 256 + (a - 4 * hi + 5);
    auto near_post = [&](int delta, f32x16& p0, f32x16& p1) {
        const LAS float* tb = bwin + 64 * delta;
        const int lim2 = delta == 0 ? a - 4 * hi : 1000;
#pragma unroll
        for (int q4 = 0; q4 < 4; ++q4) {
            float b0[4], b1[4];
#pragma unroll
            for (int i = 0; i < 4; ++i) { b0[i] = tb[59 - 8 * q4 - i]; b1[i] = tb[27 - 8 * q4 - i]; }
            asm volatile("" : "+v"(b0[0]), "+v"(b0[1]), "+v"(b0[2]), "+v"(b0[3]), "+v"(b1[0]), "+v"(b1[1]), "+v"(b1[2]), "+v"(b1[3]));
#pragma unroll
            for (int i = 0; i < 4; ++i) { const int r = 4 * q4 + i, kv = 8 * q4 + i;
                p0[r] = (kv <= lim2) ? p0[r] + b0[i] : -INFINITY; p1[r] = (kv + 32 <= lim2) ? p1[r] + b1[i] : -INFINITY; }
        }
    };
    const bf16* Kw = PROJ + rowbase * NPROJ + C_KWIN + g * 64; const bf16* Vw = PROJ + rowbase * NPROJ + C_VWIN + g * 64;
    const int jlo = qt >= 8 ? qt - 8 : 0; int wpar;
    {
        FlashState s; s.o[0] = splat(0.f); s.o[1] = splat(0.f); s.mhat = 0.f; s.l = 0.f; s.started = false;
        wpar = flash<false>(s, c, qr, Ks, Vs, (long)NPROJ, qt,
            [&](int j) { const unsigned below = j > 0 ? (um & ((1u << j) - 1u)) : 0u; return below ? 31 - __builtin_clz(below) : -1; },
            [&](int j) { return ((mymask >> j) & 1u) ? -s.mhat : -INFINITY; },
            [&](int j, f32x16& p0, f32x16& p1) { const int delta = qt - j; if (delta < 3) near_post(delta, p0, p1); },
            [&](int j) { return qt - j == 0 && false; },
            1, true, Kw, Vw, qt, qt > jlo ? qt - 1 : -1);
        const float lt = swapsum(s.l);
        accum_branch(ot, s.o, gate[(head * 64 + a) * 3 + 1] / lt, c);
    }
    {
        FlashState s; s.o[0] = splat(0.f); s.o[1] = splat(0.f); s.mhat = 0.f; s.l = 0.f; s.started = false;
        flash<false>(s, c, qr, Kw, Vw, (long)NPROJ, qt,
            [&](int j) { return j > jlo ? j - 1 : -1; },
            [&](int) { return -s.mhat; },
            [&](int j, f32x16& p0, f32x16& p1) {
                const int delta = qt - j;
                if (delta < 3) near_post(delta, p0, p1);
                else if (delta == 8) {
#pragma unroll
                    for (int r = 0; r < 16; ++r) { const int kb = crow(r, hi); if (!(kb > a)) p0[r] = -INFINITY; if (!(kb + 32 > a)) p1[r] = -INFINITY; } }
            },
            [&](int j) { return qt - j == 8 && awave == 32 && false; }, wpar, true);
        if (c.tid == 0) pend = __hip_atomic_fetch_add(qhead, 1u, __ATOMIC_RELAXED, __HIP_MEMORY_SCOPE_AGENT) + gridDim.x;
        const float lt = swapsum(s.l);
        accum_branch(ot, s.o, gate[(head * 64 + a) * 3 + 2] / lt, c);
    }
    store_o(ot, c, O + (rowbase + t0 + awave) * 2048 + (g * 4 + head) * 64, SSQ + (rowbase + t0 + awave) * 32 + g * 4 + head);
    asm volatile("s_waitcnt lgkmcnt(0)\n\ts_barrier" ::: "memory");
}
#undef SBAR
#undef WAIT_BAR0
}

constexpr int NWAVES = 8;
constexpr int RING_BYTES = 131072;
constexpr int LDSCTL_OFF = 8 * WSCR, MISC_OFF = LDSCTL_OFF + 320;
constexpr int LDS_BYTES = 163840;
static_assert(LDSCTL_OFF >= RING_BYTES && MISC_OFF + 128 <= LDS_BYTES, "LDS map");
constexpr int CW_BAR = 4096;
constexpr int N_BAR_REGIONS = 12;
constexpr int CW_KN2 = 1024;
constexpr int CW_Q8 = 49152, CW_Q9 = 53248;
constexpr int CW_TMO2 = 57344;
constexpr int CW_RDY = 65536;
constexpr int CW_CQ = 58368, CW_DONE1 = 59392, CW_DONE3 = 60416;
constexpr int CW_NCNT = 81920;
constexpr int I_DLATE = 5632;
constexpr int CW_QUEUE = 2048;
static_assert((CW_BAR + N_BAR_REGIONS * XCD_BAR_WORDS) * 4 <= (int)CTL_ZERO_BYTES, "barrier words inside the memset region");

struct Args { const float* in[23]; float* out; unsigned char* ws; int ph_lo, ph_hi, li, pad; };

template <class ColOf, class RowOf, class ScaleOf>
__device__ __forceinline__ void tr_item(const float* W, size_t pitch, int k0, int n0, LAS float* scr, int lane, bf16* WT, int Kdst, const float* ks, ColOf colof, RowOf rowof, ScaleOf scaleof) {
    const int nl = lane & 31; const int sc = colof(n0 + nl);
#pragma unroll 8
    for (int i = 0; i < 32; ++i) { const int kk = 2 * i + (lane >> 5); scr[kk * 33 + nl] = W[(size_t)(k0 + kk) * pitch + sc]; }
    LDS_WAIT(); asm volatile("" ::: "memory");
    const int c = lane & 7; float kf[8];
#pragma unroll
    for (int j = 0; j < 8; ++j) kf[j] = ks ? ks[k0 + 8 * c + j] : 1.f;
#pragma unroll
    for (int j = 0; j < 4; ++j) { const int n = (lane >> 3) + 8 * j; const LAS float* s = scr + (8 * c) * 33 + n; const float cs = scaleof(n0 + n);
        v4u o; o.x = pk2(s[0 * 33] * kf[0] * cs, s[1 * 33] * kf[1] * cs); o.y = pk2(s[2 * 33] * kf[2] * cs, s[3 * 33] * kf[3] * cs);
        o.z = pk2(s[4 * 33] * kf[4] * cs, s[5 * 33] * kf[5] * cs); o.w = pk2(s[6 * 33] * kf[6] * cs, s[7 * 33] * kf[7] * cs);
        *(GAS v4u*)(WT + (size_t)rowof(n0 + n) * Kdst + k0 + 8 * c) = o; }
    LDS_WAIT(); asm volatile("" ::: "memory");
}
template <class DstOf>
__device__ __forceinline__ void tr_item_chunks(const float* W, size_t pitch, int k0, int n0, LAS float* scr, int lane, bf16* WT, DstOf dstof) {
    const int nl = lane & 31;
#pragma unroll 8
    for (int i = 0; i < 32; ++i) { const int kk = 2 * i + (lane >> 5); scr[kk * 33 + nl] = W[(size_t)(k0 + kk) * pitch + n0 + nl]; }
    LDS_WAIT(); asm volatile("" ::: "memory");
    const int c = lane & 7;
#pragma unroll
    for (int j = 0; j < 4; ++j) { const int n = (lane >> 3) + 8 * j; const LAS float* s = scr + (8 * c) * 33 + n;
        v4u o; o.x = pk2(s[0 * 33], s[1 * 33]); o.y = pk2(s[2 * 33], s[3 * 33]); o.z = pk2(s[4 * 33], s[5 * 33]); o.w = pk2(s[6 * 33], s[7 * 33]);
        *(GAS v4u*)(WT + dstof(n0 + n, k0 + 8 * c)) = o; }
    LDS_WAIT(); asm volatile("" ::: "memory");
}
__device__ __forceinline__ void tr8_load(f32x4 (&v)[8], const float* W, size_t pitch, int k0, int n0, int lane) {
    const int r8 = lane >> 3, c4 = (lane & 7) * 4;
#pragma unroll
    for (int i = 0; i < 8; ++i) v[i] = *(const GAS f32x4*)(W + (size_t)(k0 + 8 * i + r8) * pitch + n0 + c4);
}
template <class RowOf>
__device__ __forceinline__ void tr8_finish(const f32x4 (&v)[8], int k0, int n0, LAS float* scr, int lane, unsigned char* WT, int Kdst, const float* ks, RowOf rowof) {
    { const int r8 = lane >> 3, c4 = (lane & 7) * 4;
#pragma unroll
        for (int i = 0; i < 8; ++i) { LAS float* d = scr + (8 * i + r8) * 33 + c4; d[0] = v[i][0]; d[1] = v[i][1]; d[2] = v[i][2]; d[3] = v[i][3]; } }
    LDS_WAIT(); asm volatile("" ::: "memory");
    const int c = lane & 3; float kf[16];
#pragma unroll
    for (int j = 0; j < 16; ++j) kf[j] = (ks ? ks[k0 + 16 * c + j] : 1.f) * 64.f;
#pragma unroll
    for (int j = 0; j < 2; ++j) { const int n = (lane >> 2) + 16 * j; const LAS float* s = scr + (16 * c) * 33 + n;
        v4u o;
#define W8(i) __builtin_amdgcn_fmed3f(s[(i) * 33] * kf[i], -448.f, 448.f)
        o.x = pg8::pk_fp8x4(W8(0), W8(1), W8(2), W8(3)); o.y = pg8::pk_fp8x4(W8(4), W8(5), W8(6), W8(7));
        o.z = pg8::pk_fp8x4(W8(8), W8(9), W8(10), W8(11)); o.w = pg8::pk_fp8x4(W8(12), W8(13), W8(14), W8(15));
#undef W8
        *(GAS v4u*)(WT + (size_t)rowof(n0 + n) * Kdst + k0 + 16 * c) = o; }
    LDS_WAIT(); asm volatile("" ::: "memory");
}
template <class RowOf>
__device__ __forceinline__ void tr_item8(const float* W, size_t pitch, int k0, int n0, LAS float* scr, int lane, unsigned char* WT, int Kdst, const float* ks, RowOf rowof) {
    f32x4 v[8]; tr8_load(v, W, pitch, k0, n0, lane); tr8_finish(v, k0, n0, scr, lane, WT, Kdst, ks, rowof);
}
__device__ __forceinline__ void rms_row_load(f32x4 (&v)[8], const float* xrow, int lane) {
    const GAS f32x4* xr = (const GAS f32x4*)xrow + lane;
#pragma unroll
    for (int j = 0; j < 8; ++j) v[j] = xr[64 * j];
}
__device__ __forceinline__ void rms_row_finish(const f32x4 (&v)[8], const float* w, bf16* orow, int lane) {
    const GAS f32x4* wr = (const GAS f32x4*)w + lane; float s = 0.f;
#pragma unroll
    for (int j = 0; j < 8; ++j) s += (v[j].x * v[j].x + v[j].y * v[j].y) + (v[j].z * v[j].z + v[j].w * v[j].w);
    const float r = 1.f / sqrtf(wave_sum(s) * (1.f / 2048.f) + NORM_EPS);
    GAS unsigned long long* o8 = (GAS unsigned long long*)orow + lane;
#pragma unroll
    for (int j = 0; j < 8; ++j) { const f32x4 ww = wr[64 * j]; o8[64 * j] = (unsigned long long)pk2(v[j].x * r * ww.x, v[j].y * r * ww.y) | ((unsigned long long)pk2(v[j].z * r * ww.z, v[j].w * r * ww.w) << 32); }
}

constexpr int N_PHASES = 11;
#ifndef MK_N_LAUNCHES
#define MK_N_LAUNCHES 1
#endif

#ifndef CODE_PF_BYTES
#define CODE_PF_BYTES 139264
#endif
__device__ __forceinline__ void code_prefetch(unsigned long long pc0, int lane, unsigned lds_dummy) {
#if defined(__HIP_DEVICE_COMPILE__)
    const char* p = (const char*)(pc0 & ~127ull) + lane * 128;
    unsigned keep;
#pragma unroll 1
    for (int off = 0; off < CODE_PF_BYTES; off += 8192)
        asm volatile("s_mov_b32 %0, m0\n\ts_mov_b32 m0, %2\n\ts_nop 0\n\tglobal_load_lds_dword %1, off\n\ts_mov_b32 m0, %0" : "=&s"(keep) : "v"(p + off), "s"(lds_dummy) : "memory");
#endif
}
__global__ void __launch_bounds__(NWAVES * 64, 2) mk(Args args) {
    unsigned long long pc0 = 0;
#if defined(__HIP_DEVICE_COMPILE__)
    asm volatile("s_getpc_b64 %0" : "=s"(pc0));
#endif
    extern __shared__ __attribute__((aligned(16))) unsigned char lds[];
    LAS unsigned char* L = (LAS unsigned char*)lds;
    volatile LAS unsigned* MISC = (volatile LAS unsigned*)(L + MISC_OFF);
    const int tid = threadIdx.x, lane = tid & 63, wave = __builtin_amdgcn_readfirstlane(tid >> 6);
    const int G = gridDim.x; const int bx = blockIdx.x; const int vcu = (G % 8 == 0) ? (bx % 8) * (G / 8) + bx / 8 : bx;
    const int gw = vcu * NWAVES + wave, NGW = G * NWAVES;
    unsigned char* ws = args.ws;
    gu32* ctl = (gu32*)(ws + WS_CTL);
    for (int u = tid; u < (LDS_BYTES - LDSCTL_OFF) / 4; u += NWAVES * 64) ((LAS unsigned*)(L + LDSCTL_OFF))[u] = 0u;
    __syncthreads();
    XcdBarrier bar = xcd_barrier_post((unsigned*)(ctl + CW_BAR) + args.li * XCD_BAR_WORDS, MISC + 8);
    const int lo = args.ph_lo, hi = args.ph_hi;
#ifdef ONLY_PHASE
#define IN(k) ((k) == ONLY_PHASE && lo <= (k) && (k) < hi)
#else
#define IN(k) (lo <= (k) && (k) < hi)
#endif
#ifndef CODE_PF_ON
#define CODE_PF() do { } while (0)
#else
#define CODE_PF() do { if (wave == NWAVES - 1) code_prefetch(pc0, lane, (unsigned)__builtin_amdgcn_readfirstlane((unsigned)(unsigned long long)(L + LDSCTL_OFF + 15360))); } while (0)
#endif
    CODE_PF();
#define SEAM(k) do { if (IN(k) && IN((k) + 1)) { xcd_barrier(bar); CODE_PF(); } } while (0)
    bf16* WinT = (bf16*)(ws + WS_WIN_T); bf16* WoutT = (bf16*)(ws + WS_WOUT_T); bf16* WguT = (bf16*)(ws + WS_WGU_T); bf16* WdT = (bf16*)(ws + WS_WD_T);
    bf16* XN = (bf16*)(ws + WS_XN); bf16* PROJ = (bf16*)(ws + WS_PROJ); float* GF = (float*)(ws + WS_GF); bf16* HB = (bf16*)(ws + WS_HB);
    bf16* O = (bf16*)(ws + WS_XN); bf16* MIXED = (bf16*)(ws + WS_PROJ); bf16* XS = (bf16*)(ws + WS_PROJ); bf16* YS = (bf16*)(ws + WS_PROJ); bf16* HID = (bf16*)(ws + WS_XN);
    unsigned char* Wgu8 = ws + WS_WGU_T; unsigned char* Wd8 = ws + WS_WD_T; unsigned char* HB8 = ws + WS_WGU_T + 64 * MiB; unsigned char* HID8 = ws + WS_XN;
    bf16* WrT = (bf16*)(ws + WS_WRT); bf16* W1T = (bf16*)(ws + WS_W1T); float* B1 = (float*)(ws + WS_B1);
    bf16* KC = (bf16*)(ws + WS_KC); bf16* VC = (bf16*)(ws + WS_VC); float* CUM = (float*)(ws + WS_CUM);
    float* SSQ = (float*)(ws + WS_SSQ); float* HSSQ = (float*)(ws + WS_HSSQ);
    int* EID = (int*)(ws + WS_ROUTE); float* WT = (float*)(ws + WS_ROUTE + 131072); float* RSTD = (float*)(ws + WS_ROUTE + 262144); int* LRANK = (int*)(ws + WS_ROUTE + 393216);
    int* CNTW = (int*)(ws + WS_SORT + 2 * MiB);
    int* NTp = (int*)(ws + WS_SORT + 512); int* TEXP = (int*)(ws + WS_SORT + 1024);
    int* RDST = (int*)(ws + WS_SORT + 65536); float* RWT = (float*)(ws + WS_SORT + 262144); float* RSTDS = (float*)(ws + WS_SORT + 458752);
    LAS float* wscr = (LAS float*)(L + wave * WSCR);

    if (IN(0)) {
        LAS float* scr = wscr;
        const float* w_in = args.in[2]; const float* w_out = args.in[13]; const float* wgate = args.in[19]; const float* wup = args.in[20]; const float* wdown = args.in[21];
        const float* nsa_w = args.in[11]; const float* fox_w = args.in[12]; const float* ffn_w = args.in[14];
        constexpr int I_IN = 32 * 178, I_OUT = 32 * 64, I_GU = 32 * 32 * 16, I_D = 32 * 8 * 64;
        constexpr int NITEMS = I_IN + I_OUT + 2 * I_GU + I_D;
        for (int it = gw; it < NITEMS; it += NGW) {
            int r = it;
            if (r < 2 * I_GU) { const int up = r >= I_GU; if (up) r -= I_GU; const int e = r / 512, q = r % 512, kb = q / 16, nb = q % 16;
                const float* src = (up ? wup : wgate) + (size_t)e * 2048 * 512; const int rb = e * 1024 + (up ? 128 : 0);
                tr_item8(src, 512, 64 * kb, 32 * nb, scr, lane, Wgu8, 2048, ffn_w, [rb](int j) { return rb + (j >> 7) * 256 + (j & 127); });
                continue; } r -= 2 * I_GU;
            if (r < I_D) { if (G == 256 && r < I_DLATE) continue;
                const int e = r / 512, q = r % 512, kb = q / 64, nb = q % 64; const float* src = wdown + (size_t)e * 512 * 2048; const int rb = e * 2048;
                tr_item8(src, 2048, 64 * kb, 32 * nb, scr, lane, Wd8, 512, nullptr, [rb](int j) { return rb + j; });
                continue; } r -= I_D;
            if (r < I_OUT) { const int kb = r / 64, nb = r % 64; const float* ks = (kb < 16) ? nsa_w : fox_w - 1024;
                tr_item(w_out, 2048, 64 * kb, 32 * nb, scr, lane, WoutT, 2048, ks, [](int j) { return j; }, [](int j) { return j; }, [](int) { return 1.f; });
                continue; } r -= I_OUT;
            { const int kb = r / 178, nb = r % 178;
                tr_item(w_in, 5696, 64 * kb, 32 * nb, scr, lane, WinT, 2048, nullptr,
                        [](int j) { return j < 2560 ? j : (j < 5632 ? j + 48 : (j < 5680 ? j - 5632 + 2560 : j)); }, [](int j) { return j; },
                        [](int j) { return (j < 1024 || (j >= 2560 && j < 3584)) ? C2 : 1.f; }); }
        }
        for (int i = gw * 64 + lane; i < 192 * 256; i += NGW * 64) ((GAS v4u*)(WinT + (size_t)5696 * 2048))[i] = (v4u){0u, 0u, 0u, 0u};
        for (int it = gw; it < 2 * 128; it += NGW) { const int kvv = it >> 7, q = it & 127, kb = q >> 2, nb = q & 3; const float* src = kvv ? args.in[7] : args.in[5];
            tr_item_chunks(src, 128, 64 * kb, 32 * nb, scr, lane, W1T, [kvv](int n, int k) { return (size_t)(kvv * 8 + (k >> 8)) * 32768 + ((k >> 4) & 15) * 2048 + (n >> 5) * 512 + ((k >> 3) & 1) * 256 + (n & 31) * 8; }); }
        for (int it = gw; it < 2 * 128; it += NGW) { const int kvv = it >> 7, j = it & 127; const float* w1 = kvv ? args.in[7] : args.in[5]; const float* pe = kvv ? args.in[4] : args.in[3];
            float s = 0.f; for (int i = lane; i < 2048; i += 64) s += pe[i] * w1[(size_t)i * 128 + j];
            s = wave_sum(s); if (lane == 0) B1[it] = s; }
        for (int i = gw * 64 + lane; i < 64 * 2048; i += NGW * 64) { const int o = i >> 11, k = i & 2047;
            const float v = (o < 4 ? args.in[15][(size_t)k * 4 + o] : (o < 36 ? args.in[17][(size_t)k * 32 + (o - 4)] : 0.f)) * ffn_w[k];
            const int f = (((k >> 8) * 16 + ((k >> 4) & 15)) * 2 + (o >> 5)) * 512 + ((k >> 3) & 1) * 256 + (o & 31) * 8 + (k & 7);
            const unsigned short h = (unsigned short)f2bf(v); WrT[f] = h; WrT[64 * 2048 + f] = (unsigned short)f2bf(v - bf2f(h)); }
        for (int m = gw; m < NTOK; m += NGW) { f32x4 v[8]; rms_row_load(v, args.in[0] + (size_t)m * DM, lane); rms_row_finish(v, args.in[1], XN + (size_t)m * DM, lane); }
    }
    SEAM(0);
    if (IN(1)) {
        pg8::Gemm g{XN, WinT, NTOK, NPROJ_PAD, DM, DM}; pg8::StaticOrder S; S.init(NTOK, NPROJ_PAD, G, bx);
        pg8::EpiProj E{PROJ, GF};
        pg8::gemm_phase<pg8::EpiProj, pg8::StaticOrder, true, true>(L, g, S, E);
        if (G == 256 && bx >= 192) { const float* wdown = args.in[21];
            for (int r = (bx - 192) * NWAVES + wave; r < I_DLATE; r += 64 * NWAVES) { const int e = r / 512, q = r % 512, kb = q / 64, nb = q % 64; const float* src = wdown + (size_t)e * 512 * 2048; const int rb = e * 2048;
                tr_item8(src, 2048, 64 * kb, 32 * nb, wscr, lane, Wd8, 512, nullptr, [rb](int j) { return rb + j; }); } }
    }
    SEAM(1);
    if (IN(2)) {
#ifndef P2SKIP
#define P2SKIP 0
#endif
        if (!((P2SKIP & 1) && args.li == 1)) if (bx < 128) cumsum_wg(bx, wave, lane, GF, args.in[10], CUM, (LAS float*)(L + LDSCTL_OFF + 4096));
        if (!((P2SKIP & 2) && args.li == 1)) knorm_item(bx * 8 + wave, lane, PROJ, (unsigned*)(ctl + CW_KN2));
        if (!((P2SKIP & 4) && args.li == 1)) {
#ifdef COMPRESS_NAIVE
        for (int it = gw; it < 8 * 128 * 4 * 2; it += NGW) compress_item(it, lane, wscr, PROJ, args.in[3], args.in[4], args.in[5], args.in[6], args.in[7], args.in[8], KC, VC);
#else
        if (bx < 254) compress_mfma(bx, tid, lane, wave, (LAS float*)L, (LAS float*)(L + RING_BYTES), PROJ, W1T, B1, args.in[6], args.in[8], KC, VC);
        else if (tid < 256) { bf16* z = (bx == 254 ? KC : VC) + ((size_t)((tid >> 5) * 128 + 127) * 4) * 64 + (tid & 31) * 8; *(v4u*)z = (v4u){0u, 0u, 0u, 0u}; }
#endif
        }
    }
    SEAM(2);
    if (IN(3)) {
#ifdef ATTN_NAIVE
        for (int it = gw; it < NTOK * 4; it += NGW) nsa_item(it, lane, wscr, PROJ, KC, VC, args.in[9], GF, O, SSQ);
        for (int it = gw; it < NTOK * 16; it += NGW) fox_item(it, lane, wscr, PROJ, CUM, O, SSQ);
#else
        LAS int* qslot = (LAS int*)(L + att::A_QSLOT);
        unsigned* qhead = (unsigned*)(ctl + CW_QUEUE + 64 * args.li);
        int u = bx; unsigned pend = 0u;
        for (;; ) {
            if (u >= 2048) break;
            const int k = 7 - (u >> 8), off = u & 255;
            int tid_ = tid; asm volatile("" : "+v"(tid_));
            const att::Ctx c{tid_, tid_ & 63, tid_ & 31, (tid_ >> 5) & 1, wave, (LAS char*)L, (unsigned)(unsigned long)L};
#ifndef PROBE_ATT
#define PROBE_ATT 0
#endif
            bool claimed = true;
#ifndef DBG_NO_FOX
            if (off < 128) { if (!(PROBE_ATT == 2 && args.li == 1)) att::fox_unit(c, off >> 4, off & 15, k, PROJ, CUM, (const unsigned*)(ctl + CW_KN2), O, SSQ, qhead, pend); else claimed = false; }
#else
            if (off < 128) { claimed = false; }
#endif
#ifndef DBG_NO_NSA
            else if (!(PROBE_ATT == 1 && args.li == 1)) { const int o2 = off - 128; att::nsa_unit(c, (o2 & 31) >> 2, o2 & 3, 4 * k + 3 - (o2 >> 5), PROJ, KC, VC, args.in[9], GF, O, SSQ, qhead, pend); }
            else claimed = false;
#else
            else claimed = false;
#endif
            if (!claimed && tid == 0) pend = __hip_atomic_fetch_add(qhead, 1u, __ATOMIC_RELAXED, __HIP_MEMORY_SCOPE_AGENT) + (unsigned)G;
            if (tid == 0) *qslot = (int)pend;
            __syncthreads();
            u = __builtin_amdgcn_readfirstlane(*qslot);
        }
#endif
    }
    SEAM(3);
#ifdef NORM_PASS
    if (IN(4)) { for (int m = gw; m < NTOK; m += NGW) normalize_item((size_t)m, lane, O, SSQ, MIXED); }
#endif
#ifdef NORM_PASS
    SEAM(4);
#endif
    if (IN(5)) {
        pg8::Gemm g{O, WoutT, NTOK, DM, DM / 2, DM}; pg8::StaticOrder2 S; S.S.init(NTOK, DM, G, bx); S.khalf = DM / 2;
        LAS float* RT = (LAS float*)(L + RING_BYTES);
        pg8::Unit u0, u1; const bool h0 = S.S.next(0, u0), h1 = S.S.next(1, u1);
        { const pg8::Unit& ut = (tid < 256) ? u0 : u1; const bool hv = (tid < 256) ? h0 : h1;
            if (hv) { const float* sp = SSQ + ((size_t)ut.pm * 256 + (tid & 255)) * 32; float sa = 0.f, sf = 0.f;
#pragma unroll
                for (int i = 0; i < 4; ++i) { const f32x4 a4 = *(const f32x4*)(sp + 4 * i), f4 = *(const f32x4*)(sp + 16 + 4 * i); sa += (a4[0] + a4[1]) + (a4[2] + a4[3]); sf += (f4[0] + f4[1]) + (f4[2] + f4[3]); }
                const float ra = 1.f / sqrtf(sa * (1.f / 1024.f) + NORM_EPS), rf = 1.f / sqrtf(sf * (1.f / 1024.f) + NORM_EPS);
                RT[tid * 2] = ra / rf; RT[tid * 2 + 1] = rf; } }
        __syncthreads();
        pg8::EpiOut E{args.in[0], HB, HSSQ, SSQ, HB8, RT, u0.pm, u0.pn};
        pg8::gemm_phase<pg8::EpiOut, pg8::StaticOrder2, true, true>(L, g, S, E);
    }
    SEAM(5);
    const int TPW = NTOK / G;
    LAS int* elist = (LAS int*)(L + LDSCTL_OFF + 4096);
    if (IN(6)) {
#ifdef P6REP
#pragma unroll 1
      for (int rep6 = 0; rep6 < (args.li == 1 ? 2 : 1); ++rep6) { const int bx6 = rep6 ? ((bx + 128) & 255) : bx;
#else
      { const int bx6 = bx;
#endif
#ifdef P6WARM
        if (args.li == 1) { for (int i = tid; i < 256 * 1024 / 16; i += 512) { v4u v = ((const v4u*)(HB + (size_t)bx6 * 64 * 2048))[i]; asm volatile("" :: "v"(v.x)); }
            for (int i = tid; i < 512 * 1024 / 16; i += 512) { v4u v = ((const v4u*)WrT)[i]; asm volatile("" :: "v"(v.x)); }
            __syncthreads(); }
#endif
        LAS float* part = (LAS float*)L;
        const float bias_r = tid < 4 ? args.in[16][tid] : (tid < 36 ? args.in[18][tid - 4] : 0.f);
        const f32x4 hs4 = *(const f32x4*)(HSSQ + (size_t)bx6 * TPW * 32 + tid * 4);
#ifndef P6SKIP
#define P6SKIP 0
#endif
        if (!((P6SKIP & 1) && args.li == 1)) router_mfma(bx6, tid, lane, wave, part, HB, WrT);
        __syncthreads();
        if (!((P6SKIP & 2) && args.li == 1)) {
        LAS float* lgt = (LAS float*)(L + RING_BYTES);
        LAS float* ssl = lgt + TPW * 36;
        LAS float* bsl = ssl + TPW; if (tid < 36) bsl[tid] = bias_r;
        { float ss = (hs4[0] + hs4[1]) + (hs4[2] + hs4[3]); ss += __shfl_xor(ss, 1); ss += __shfl_xor(ss, 2); ss += __shfl_xor(ss, 4); if ((tid & 7) == 0) ssl[tid >> 3] = ss; }
        for (int i = tid; i < TPW * 36; i += NWAVES * 64) { const int tk = i / 36, o = i % 36; float s = 0.f;
#pragma unroll
            for (int w = 0; w < 8; ++w) s += part[w * 4096 + tk * 64 + o];
            lgt[i] = s; }
        __syncthreads();
        if (tid < TPW) { const size_t tok = (size_t)bx6 * TPW + tid; const LAS float* lg = lgt + tid * 36;
            const float ss = ssl[tid];
            const float rstd = 1.f / sqrtf(ss * (1.f / 2048.f) + NORM_EPS);
            const LAS float* bg = bsl; const LAS float* be = bsl + 4;
            float gl[4]; int gsel = 0;
#pragma unroll
            for (int i = 0; i < 4; ++i) gl[i] = lg[i] * rstd + bg[i];
            float gm = gl[0];
#pragma unroll
            for (int i = 1; i < 4; ++i) if (gl[i] > gm) { gm = gl[i]; gsel = i; }
            float den = 0.f;
#pragma unroll
            for (int i = 0; i < 4; ++i) den += expf(gl[i] - gm);
            const float pgs = 1.f / den;
            int i1 = 0, i2 = 0; float v1 = -INFINITY, v2 = -INFINITY;
            for (int j = 0; j < 8; ++j) { const float v = lg[4 + gsel * 8 + j] * rstd + be[gsel * 8 + j];
                if (v > v1) { v2 = v1; i2 = i1; v1 = v; i1 = j; } else if (v > v2) { v2 = v; i2 = j; } }
            const float ex = expf(v2 - v1), d2 = 1.f / (1.f + ex);
            const int e0 = gsel * 8 + i1, e1 = gsel * 8 + i2;
            EID[tok * 2] = e0; EID[tok * 2 + 1] = e1; WT[tok * 2] = d2 * pgs; WT[tok * 2 + 1] = ex * d2 * pgs; RSTD[tok] = rstd; elist[tid * 2] = e0; elist[tid * 2 + 1] = e1; }
        __syncthreads();
        LAS int* cntl = elist + 2 * TPW; int e = 0, rk = 0;
        if (tid < 2 * TPW) { e = elist[tid]; int cnt = 0;
#ifdef P6ROLL
#pragma unroll 1
#endif
            for (int ee = 0; ee < 32; ++ee) { const unsigned long long m = __ballot(e == ee); if (e == ee) rk = __popcll(m & ((1ull << lane) - 1ull)); if (lane == ee) cnt = __popcll(m); }
            if (lane < 32) cntl[wave * 32 + lane] = cnt; }
        __syncthreads();
        if (tid < 2 * TPW) LRANK[(size_t)bx6 * 2 * TPW + tid] = rk + (wave ? cntl[e] : 0);
        if (tid < 32) CNTW[bx6 * 32 + tid] = cntl[tid] + cntl[32 + tid];
        __syncthreads();
        }
      }
    }
    SEAM(6);
    if (IN(7)) {
        LAS int* cw = (LAS int*)L;
        LAS int* tot = (LAS int*)(L + 65536); LAS int* mine = tot + 32; LAS int* base = tot + 64; LAS int* rowof = tot + 128;
        int e7 = 0, lr7 = 0; float wt7 = 0.f, rs7 = 0.f;
        { int cv[16];
#pragma unroll
            for (int k = 0; k < 16; ++k) cv[k] = CNTW[tid + 512 * k];
            if (tid < 2 * TPW) { const int entry = bx * 2 * TPW + tid; e7 = EID[entry]; lr7 = LRANK[entry]; wt7 = WT[entry]; rs7 = RSTD[entry >> 1]; }
#pragma unroll
            for (int k = 0; k < 16; ++k) cw[tid + 512 * k] = cv[k]; }
        __syncthreads();
        if (tid < 32) { int t = 0, m = 0; for (int w = 0; w < G; ++w) { const int c = cw[w * 32 + tid]; t += c; m += (w < bx) ? c : 0; } tot[tid] = t; mine[tid] = m; }
        __syncthreads();
        if (tid == 0) { int acc = 0; for (int e = 0; e < 32; ++e) { base[e] = acc; acc += (tot[e] + 255) & ~255; } base[32] = acc; }
        __syncthreads();
        if (bx == 0) { if (tid == 0) NTp[0] = base[32] >> 8; if (tid < 32) for (int tl = base[tid] >> 8; tl < (base[tid + 1] >> 8); ++tl) TEXP[tl] = tid; }
        if (tid < 2 * TPW) { const int entry = bx * 2 * TPW + tid; const int row = base[e7] + mine[e7] + lr7;
            RDST[row] = entry; RWT[row] = wt7; RSTDS[row] = rs7; }
        if (bx < 32) { const int e = bx; for (int row = base[e] + tot[e] + tid; row < base[e + 1]; row += NWAVES * 64) { RDST[row] = -1; RWT[row] = 0.f; RSTDS[row] = 0.f; } }
        __syncthreads();
    }
    SEAM(7);
    LAS int* qsl = (LAS int*)(L + LDSCTL_OFF + 8192);
    unsigned* RDY = (unsigned*)(ctl + CW_RDY); unsigned* TMO2 = (unsigned*)(ctl + CW_TMO2);
    if (IN(8)) {
        const int nt = ld_i32(NTp);
        pg8::Gemm g{(const bf16*)HB8, (const bf16*)Wgu8, MAXROWS, 1024, DM / 2, DM / 2}; pg8::QueueOrder S{nt, 4, TEXP, RDST, (unsigned*)(ctl + CW_Q8 + 64 * args.li), qsl, nullptr, 0u, RDY, TMO2};
        pg8::EpiGateUp E{HID8, RSTDS};
        pg8::gemm_phase_g<pg8::EpiGateUp, pg8::QueueOrder, true, true, true>(L, g, S, E);
    }
    if (IN(9)) {
        const int nt = ld_i32(NTp);
        pg8::Gemm g{(const bf16*)HID8, (const bf16*)Wd8, MAXROWS, 2048, EFF / 2, EFF / 2}; pg8::QueueOrder S{nt, 8, TEXP, RDST, (unsigned*)(ctl + CW_Q9 + 64 * args.li), qsl + 4, RDY, 32u, nullptr, TMO2};
        pg8::EpiDown E{(unsigned char*)YS, RDST, RWT};
        pg8::gemm_phase<pg8::EpiDown, pg8::QueueOrder, true, true, true>(L, g, S, E);
    }
    SEAM(9);
    if (IN(10)) { for (int m = gw; m < NTOK; m += NGW) final_item((size_t)m, lane, HB, (const unsigned char*)YS, args.in[22], args.out); }
#undef IN
#undef SEAM
}

extern "C" void kernel_launch(void* const* d_in, const int* in_sizes, int n_in, void* d_out, int out_size, void* d_ws, size_t ws_size, hipStream_t stream) {
    static int grid = 0;
    if (grid == 0) {
        if (n_in != 23 || in_sizes[0] != NTOK * DM || out_size != NTOK * DM || ws_size < WS_END) { fprintf(stderr, "kernel_launch: unexpected shapes (n_in %d, in0 %d, out %d, ws %zu < %zu)\n", n_in, n_in > 0 ? in_sizes[0] : -1, out_size, ws_size, (size_t)WS_END); grid = -1; return; }
        int dev = 0, cus = 0;
        if (hipGetDevice(&dev) != hipSuccess || hipDeviceGetAttribute(&cus, hipDeviceAttributeMultiprocessorCount, dev) != hipSuccess) { grid = -1; return; }
        if (hipFuncSetAttribute((const void*)mk, hipFuncAttributeMaxDynamicSharedMemorySize, LDS_BYTES) != hipSuccess) { fprintf(stderr, "kernel_launch: hipFuncSetAttribute failed\n"); grid = -1; return; }
        int per_cu = 0;
        if (hipOccupancyMaxActiveBlocksPerMultiprocessor(&per_cu, (const void*)mk, NWAVES * 64, LDS_BYTES) != hipSuccess || per_cu < 1) fprintf(stderr, "kernel_launch: occupancy query says %d\n", per_cu);
        (void)hipGetLastError();
        if (cus != 256) { fprintf(stderr, "kernel_launch: built for a 256-CU device, found %d CUs; nothing launched\n", cus); grid = -1; return; }
        grid = cus;
    }
    if (grid < 0) return;
    unsigned char* ws = (unsigned char*)d_ws;
    (void)hipMemsetAsync(ws + WS_CTL, 0, CTL_ZERO_BYTES, stream);
    Args a{};
    for (int i = 0; i < 23; ++i) a.in[i] = (const float*)d_in[i];
    a.out = (float*)d_out; a.ws = ws;
#ifdef PROBE_PREFIX
    a.ph_lo = 0; a.ph_hi = N_PHASES; a.li = 0; hipLaunchKernelGGL(mk, dim3(grid), dim3(NWAVES * 64), LDS_BYTES, stream, a);
    a.ph_lo = 0; a.ph_hi = PROBE_PREFIX; a.li = 1; hipLaunchKernelGGL(mk, dim3(grid), dim3(NWAVES * 64), LDS_BYTES, stream, a);
#elif defined(PROBE_PHASE)
#ifndef PROBE_END
#define PROBE_END (PROBE_PHASE + 1)
#endif
    { const int cuts[4] = {0, PROBE_END, PROBE_END, N_PHASES}; const int los[3] = {0, PROBE_PHASE, PROBE_END};
      for (int i = 0; i < 3; ++i) { a.ph_lo = los[i]; a.ph_hi = cuts[i + 1] == PROBE_END && i == 0 ? PROBE_END : (i == 1 ? PROBE_END : N_PHASES); a.li = i; if (a.ph_lo < a.ph_hi) hipLaunchKernelGGL(mk, dim3(grid), dim3(NWAVES * 64), LDS_BYTES, stream, a); } }
#else
    if (MK_N_LAUNCHES == 1) { a.ph_lo = 0; a.ph_hi = N_PHASES; a.li = 0; hipLaunchKernelGGL(mk, dim3(grid), dim3(NWAVES * 64), LDS_BYTES, stream, a); }
    else for (int p = 0; p < N_PHASES; ++p) { a.ph_lo = p; a.ph_hi = p + 1; a.li = p; hipLaunchKernelGGL(mk, dim3(grid), dim3(NWAVES * 64), LDS_BYTES, stream, a); }
#endif
}
```

```cpp
#include <hip/hip_runtime.h>
#include <cstdio>
#include <cstdint>

constexpr int BATCH = 8, SEQ = 2048, DM = 2048, NTOK = BATCH * SEQ;
constexpr int NPROJ = 5632, NPROJ_PAD = 5888;
constexpr int C_NQ = 0, C_KCMP = 1024, C_VCMP = 1280, C_KSLC = 1536, C_VSLC = 1792, C_KWIN = 2048, C_VWIN = 2304, C_FQ = 2560, C_FK = 3584, C_FV = 4608;
constexpr int NEXP = 32, EFF = 512;
constexpr int MAXROWS = 40960;
constexpr float NORM_EPS = 1e-6f;
constexpr float LOG2E = 1.4426950408889634f;
constexpr float C2 = 0.125f * LOG2E;

constexpr size_t MiB = 1u << 20;
constexpr size_t WS_CTL = 0, CTL_ZERO_BYTES = 1 * MiB;
constexpr size_t WS_WIN_T = 1 * MiB;
constexpr size_t WS_WOUT_T = 24 * MiB;
constexpr size_t WS_WGU_T = 32 * MiB;
constexpr size_t WS_WD_T = 160 * MiB;
constexpr size_t WS_W1T = 224 * MiB;
constexpr size_t WS_KC = 225 * MiB;
constexpr size_t WS_VC = WS_KC + 512 * 1024;
constexpr size_t WS_CUM = 226 * MiB;
constexpr size_t WS_GF = 227 * MiB;
constexpr size_t WS_SSQ = 231 * MiB;
constexpr size_t WS_HSSQ = 233 * MiB;
constexpr size_t WS_B1 = 235 * MiB;
constexpr size_t WS_WRT = 235 * MiB + 512 * 1024;
constexpr size_t WS_ROUTE = 236 * MiB;
constexpr size_t WS_SORT = 237 * MiB;
constexpr size_t WS_XN = 244 * MiB;
constexpr size_t WS_PROJ = 308 * MiB;
constexpr size_t WS_HB = 484 * MiB;
constexpr size_t WS_END = 548 * MiB;
namespace pg8 {
#define PG8_LAS __attribute__((address_space(3)))
typedef unsigned short bf16_t;
typedef short bf16x8 __attribute__((ext_vector_type(8)));
typedef float f32x4 __attribute__((ext_vector_type(4)));
typedef unsigned u32x4 __attribute__((ext_vector_type(4)));
constexpr int BM = 256, BK = 64, HALF = 128, HTB = HALF * BK * 2  , STAGE_BYTES = 8 * HTB, NXCD = 8, WGM = 8;

__host__ __device__ __forceinline__ int lds_byte(int r, int c) { const int st = (r >> 4) * 2 + (c >> 5), rr = r & 15, cc = c & 31, ob = rr * 64 + cc * 2; return st * 1024 + (ob ^ (((ob >> 9) & 1) << 5)); }
__host__ __device__ __forceinline__ void stage_rc(int b, int& R, int& C) { const int st = b / 1024, sb = b % 1024, swz = sb ^ (((sb >> 9) & 1) << 5); R = (st >> 1) * 16 + swz / 64; C = (st & 1) * 32 + (swz % 64) / 2; }
__host__ __device__ __forceinline__ int perm32(int rho) { const int n = rho >> 4, i = rho & 15; return 8 * (i >> 2) + 4 * n + (i & 3); }

typedef int v8i32 __attribute__((ext_vector_type(8)));
__device__ __forceinline__ v8i32 cat8(bf16x8 lo, bf16x8 hi) { typedef int v4i __attribute__((ext_vector_type(4))); const v4i a = __builtin_bit_cast(v4i, lo), b = __builtin_bit_cast(v4i, hi); return (v8i32){a[0], a[1], a[2], a[3], b[0], b[1], b[2], b[3]}; }
typedef int v4i32 __attribute__((ext_vector_type(4)));
template <bool FP8> struct FragT;
template <> struct FragT<false> {
    struct type { bf16x8 k0, k1; };
    static __device__ __forceinline__ void ld(type& f, const PG8_LAS unsigned char* p) { f.k0 = *(const PG8_LAS bf16x8*)p; f.k1 = *(const PG8_LAS bf16x8*)(p + 1024); }
    static __device__ __forceinline__ void mma(f32x4& acc, const type& b, const type& a) { acc = __builtin_amdgcn_mfma_f32_16x16x32_bf16(b.k0, a.k0, acc, 0, 0, 0); acc = __builtin_amdgcn_mfma_f32_16x16x32_bf16(b.k1, a.k1, acc, 0, 0, 0); }
};
template <> struct FragT<true> {
    typedef v8i32 type;
    static __device__ __forceinline__ void ld(type& f, const PG8_LAS unsigned char* p) { f.lo = *(const PG8_LAS v4i32*)p; f.hi = *(const PG8_LAS v4i32*)(p + 1024); }
    static __device__ __forceinline__ void mma(f32x4& acc, const type& b, const type& a) {
#if defined(__HIP_DEVICE_COMPILE__)
        int sc = 0x7F7F7F7F;
        asm volatile("v_mfma_scale_f32_16x16x128_f8f6f4 %0, %1, %2, %0, %3, %3 op_sel_hi:[0,0,0]" : "+v"(acc) : "v"(b), "v"(a), "v"(sc));
#endif
    }
};
struct Unit { int pm, pn, bn, koff, kh; };
struct Gemm { const bf16_t* A; const bf16_t* Bt; int M, N, K, ld; };

struct StaticOrder {
    int nM, nN, nwg, G, c;
    __host__ __device__ void init(int M, int N, int G_, int c_) { nM = M / BM; nN = N / BM; nwg = nM * nN; G = G_; c = c_; }
    __host__ __device__ bool next(int i, Unit& u) const {
        const long L = (long)i * G + c; if (L >= nwg) return false;
        int wgid = (int)L; { const int q = nwg / NXCD, r = nwg % NXCD, xcd = wgid % NXCD, off = wgid / NXCD; wgid = (xcd < r ? xcd * (q + 1) : r * (q + 1) + (xcd - r) * q) + off; }
        const int nig = WGM * nN, gid = wgid / nig, fm = gid * WGM, gsz = (nM - fm) < WGM ? (nM - fm) : WGM;
        u.pm = fm + ((wgid % nig) % gsz); u.pn = (wgid % nig) / gsz; u.bn = u.pn; u.koff = 0; u.kh = 1; return true;
    }
    __device__ __forceinline__ void a_ready(const Unit&) const {}
    __device__ __forceinline__ void claim() const {}
    __device__ __forceinline__ void done(const Unit&) const {}
};

struct StaticOrder2 {
    StaticOrder S; int khalf;
    __host__ __device__ bool next(int i, Unit& u) const { if (!S.next(i >> 1, u)) return false; u.kh = i & 1; u.koff = (i & 1) * khalf; return true; }
    __device__ __forceinline__ void a_ready(const Unit&) const {}
    __device__ __forceinline__ void claim() const {}
    __device__ __forceinline__ void done(const Unit&) const {}
};

__device__ __forceinline__ unsigned cvt_pk_bf16(float lo, float hi) { unsigned r; asm volatile("v_cvt_pk_bf16_f32 %0, %1, %2" : "=v"(r) : "v"(lo), "v"(hi)); return r; }
typedef float f32x2 __attribute__((ext_vector_type(2)));

__device__ __forceinline__ unsigned pk_fp8x4(float a, float b, float c, float d) { unsigned w = 0u; w = (unsigned)__builtin_amdgcn_cvt_pk_fp8_f32(a, b, (int)w, false); w = (unsigned)__builtin_amdgcn_cvt_pk_fp8_f32(c, d, (int)w, true); return w; }
struct EpiProj {
    static constexpr bool PERM = true, AFTER_DRAIN = false, MID = false;
    bf16_t* P; float* GF;
    __device__ __forceinline__ void operator()(const f32x4 (&acc)[2][2][4][2], const Unit& u, int wr, int wc, int fr, int fq) const {
        const int row0 = u.pm * BM + wr * 64 + fr;
        if (u.pn < 22) {
            const int col0 = u.pn * BM + wc * 32 + 8 * fq;
#pragma unroll
            for (int ai = 0; ai < 2; ++ai)
#pragma unroll
                for (int m = 0; m < 4; ++m) { bf16_t* rowp = P + (size_t)(row0 + ai * HALF + m * 16) * 5632 + col0;
#pragma unroll
                    for (int bj = 0; bj < 2; ++bj) { const f32x4 v0 = acc[ai][bj][m][0], v1 = acc[ai][bj][m][1];
                        u32x4 w; w.x = cvt_pk_bf16(v0[0], v0[1]); w.y = cvt_pk_bf16(v0[2], v0[3]); w.z = cvt_pk_bf16(v1[0], v1[1]); w.w = cvt_pk_bf16(v1[2], v1[3]);
                        *(u32x4*)(rowp + bj * HALF) = w; } }
        } else {
            const int col0 = wc * 32 + 8 * fq;
            if (col0 < 64) {
#pragma unroll
                for (int ai = 0; ai < 2; ++ai)
#pragma unroll
                    for (int m = 0; m < 4; ++m) { float* rowp = GF + (size_t)(row0 + ai * HALF + m * 16) * 64 + col0;
                        *(f32x4*)(rowp) = acc[ai][0][m][0]; *(f32x4*)(rowp + 4) = acc[ai][0][m][1]; }
            }
        }
    }
};
struct EpiOut {
    static constexpr bool PERM = true, AFTER_DRAIN = false, MID = true;
    const float* X; bf16_t* HB; float* HSSQ; const float* SSQ; unsigned char* HB8;
    const PG8_LAS float* RT; int pm0, pn0;
    __device__ __forceinline__ const PG8_LAS float* rt_of(const Unit& u, int wr, int fr) const { return RT + ((u.pm == pm0 && u.pn == pn0) ? 0 : 512) + (wr * 64 + fr) * 2; }
    __device__ __forceinline__ void mid(f32x4 (&acc)[2][2][4][2], const Unit& u, int wr, int wc, int fr, int fq) const {
        const PG8_LAS float* rt = rt_of(u, wr, fr);
#pragma unroll
        for (int ai = 0; ai < 2; ++ai)
#pragma unroll
            for (int m = 0; m < 4; ++m) { const float q = rt[(ai * HALF + m * 16) * 2];
#pragma unroll
                for (int bj = 0; bj < 2; ++bj)
#pragma unroll
                    for (int n = 0; n < 2; ++n) acc[ai][bj][m][n] *= q; }
    }
    __device__ __forceinline__ void operator()(const f32x4 (&acc)[2][2][4][2], const Unit& u, int wr, int wc, int fr, int fq) const {
        const int row0 = u.pm * BM + wr * 64 + fr, col0 = u.pn * BM + wc * 32 + 8 * fq;
        const PG8_LAS float* rt = rt_of(u, wr, fr);
        f32x4 xa[2][2], xb[2][2];
        { const float* xr = X + (size_t)row0 * 2048 + col0;
#pragma unroll
            for (int bj = 0; bj < 2; ++bj) { xa[bj][0] = *(const f32x4*)(xr + bj * HALF); xa[bj][1] = *(const f32x4*)(xr + bj * HALF + 4); } }
#pragma unroll
        for (int ai = 0; ai < 2; ++ai)
#pragma unroll
            for (int m = 0; m < 4; ++m) { const int row = row0 + ai * HALF + m * 16; const float rs = rt[(ai * HALF + m * 16) * 2 + 1];
                if (!(ai == 1 && m == 3)) { const int rn = row0 + (m == 3 ? HALF : ai * HALF + (m + 1) * 16); const float* xr = X + (size_t)rn * 2048 + col0;
#pragma unroll
                    for (int bj = 0; bj < 2; ++bj) { xb[bj][0] = *(const f32x4*)(xr + bj * HALF); xb[bj][1] = *(const f32x4*)(xr + bj * HALF + 4); } }
                bf16_t* hr = HB + (size_t)row * 2048 + col0; float ss = 0.f;
#pragma unroll
                for (int bj = 0; bj < 2; ++bj) { const f32x4 v0 = acc[ai][bj][m][0] * rs + xa[bj][0], v1 = acc[ai][bj][m][1] * rs + xa[bj][1];
                    ss += (v0[0] * v0[0] + v0[1] * v0[1]) + (v0[2] * v0[2] + v0[3] * v0[3]) + (v1[0] * v1[0] + v1[1] * v1[1]) + (v1[2] * v1[2] + v1[3] * v1[3]);
                    u32x4 w; w.x = cvt_pk_bf16(v0[0], v0[1]); w.y = cvt_pk_bf16(v0[2], v0[3]); w.z = cvt_pk_bf16(v1[0], v1[1]); w.w = cvt_pk_bf16(v1[2], v1[3]);
                    *(u32x4*)(hr + bj * HALF) = w;
                    *(unsigned long long*)(HB8 + (size_t)row * 2048 + col0 + bj * HALF) = (unsigned long long)pk_fp8x4(v0[0], v0[1], v0[2], v0[3]) | ((unsigned long long)pk_fp8x4(v1[0], v1[1], v1[2], v1[3]) << 32); }
                ss += __shfl_xor(ss, 16); ss += __shfl_xor(ss, 32);
                if (fq == 0) HSSQ[(size_t)row * 32 + u.pn * 4 + wc] = ss;
#pragma unroll
                for (int bj = 0; bj < 2; ++bj) { xa[bj][0] = xb[bj][0]; xa[bj][1] = xb[bj][1]; }
                __builtin_amdgcn_sched_barrier(0); }
    }
};
struct EpiGateUp {
    static constexpr bool PERM = true, AFTER_DRAIN = false, MID = false;
    unsigned char* HID; const float* rstd_s;
    static constexpr float WSC = 1.f / 64.f, HSC = 16.f;
    __device__ __forceinline__ void operator()(const f32x4 (&acc)[2][2][4][2], const Unit& u, int wr, int wc, int fr, int fq) const {
        const int row0 = u.pm * BM + wr * 64 + fr, col0 = u.pn * 128 + wc * 32 + 8 * fq;
        const __amdgpu_buffer_rsrc_t rsrc = __builtin_amdgcn_make_buffer_rsrc((void*)HID, 0, 40960 * 512, 0x00020000);
        float rsv[2][4];
#pragma unroll
        for (int ai = 0; ai < 2; ++ai)
#pragma unroll
            for (int m = 0; m < 4; ++m) rsv[ai][m] = rstd_s[row0 + ai * HALF + m * 16];
#pragma unroll
        for (int ai = 0; ai < 2; ++ai)
#pragma unroll
            for (int m = 0; m < 4; ++m) { const int row = row0 + ai * HALF + m * 16; const float rs = rsv[ai][m];
                float o[8];
#pragma unroll
                for (int n = 0; n < 2; ++n)
#pragma unroll
                    for (int j = 0; j < 4; ++j) { const float g = acc[ai][0][m][n][j] * rs * WSC, up = acc[ai][1][m][n][j] * rs * WSC;
                        const float sg = __builtin_amdgcn_rcpf(1.f + __builtin_amdgcn_exp2f(-g * 1.4426950408889634f)); o[n * 4 + j] = __builtin_amdgcn_fmed3f(g * sg * up, -28.f, 28.f); }
                typedef unsigned u32x2 __attribute__((ext_vector_type(2)));
                const u32x2 w = {pk_fp8x4(o[0] * HSC, o[1] * HSC, o[2] * HSC, o[3] * HSC), pk_fp8x4(o[4] * HSC, o[5] * HSC, o[6] * HSC, o[7] * HSC)};
                __builtin_amdgcn_raw_buffer_store_b64(w, rsrc, (int)((size_t)row * 512 + col0), 0, 16);
                __builtin_amdgcn_sched_barrier(0); }
    }
};
struct EpiDown {
    static constexpr bool PERM = true, AFTER_DRAIN = false, MID = false;
    unsigned char* YS; const int* rdst; const float* rwt;
    __device__ __forceinline__ void operator()(const f32x4 (&acc)[2][2][4][2], const Unit& u, int wr, int wc, int fr, int fq) const {
        const int row0 = u.pm * BM + wr * 64 + fr, col0 = u.pn * BM + wc * 32 + 8 * fq;
        int dv[2][4]; float wv[2][4];
#pragma unroll
        for (int ai = 0; ai < 2; ++ai)
#pragma unroll
            for (int m = 0; m < 4; ++m) { dv[ai][m] = rdst[row0 + ai * HALF + m * 16]; wv[ai][m] = rwt[row0 + ai * HALF + m * 16]; }
#pragma unroll
        for (int ai = 0; ai < 2; ++ai)
#pragma unroll
            for (int m = 0; m < 4; ++m) { const int d = dv[ai][m]; const float wt = wv[ai][m] * (1.f / 1024.f);
                if (d >= 0) { unsigned char* yr = YS + ((size_t)(d & 1) * 16384 + (size_t)(d >> 1)) * 2048 + col0;
#pragma unroll
                    for (int bj = 0; bj < 2; ++bj) { const f32x4 v0 = acc[ai][bj][m][0] * wt, v1 = acc[ai][bj][m][1] * wt;
                        *(unsigned long long*)(yr + bj * HALF) = (unsigned long long)pk_fp8x4(v0[0], v0[1], v0[2], v0[3]) | ((unsigned long long)pk_fp8x4(v1[0], v1[1], v1[2], v1[3]) << 32); } }
                __builtin_amdgcn_sched_barrier(0); }
    }
};
struct GroupedOrder {
    int ntiles, nN, G, c; const int* tile_expert; const int* rdst;
    __device__ __forceinline__ int arow(int pm, int h, int R) const { const int d = rdst[pm * BM + h * HALF + R]; return d < 0 ? 0 : (d >> 1); }
    __device__ __forceinline__ bool next(int i, Unit& u) const {
        const int L = i * G + c; if (L >= ntiles * nN) return false;
        u.pm = L / nN; u.pn = L % nN; u.koff = 0; u.kh = 1; u.bn = __hip_atomic_load(tile_expert + u.pm, __ATOMIC_RELAXED, __HIP_MEMORY_SCOPE_AGENT) * nN + u.pn; return true;
    }
    __device__ __forceinline__ void a_ready(const Unit&) const {}
    __device__ __forceinline__ void claim() const {}
    __device__ __forceinline__ void done(const Unit&) const {}
};

struct QueueOrder {
    int ntiles, nN; const int* tile_expert; const int* rdst;
    unsigned* head; PG8_LAS int* slot;
    const unsigned* ready; unsigned need; unsigned* publish; unsigned* tmo;
    mutable unsigned pend = 0u;
    __device__ __forceinline__ void claim() const { if (threadIdx.x == 0) { unsigned z = 0u; asm volatile("" : "+v"(z)); pend = __hip_atomic_fetch_add(head + z, 1u, __ATOMIC_RELAXED, __HIP_MEMORY_SCOPE_AGENT); } }
    __device__ __forceinline__ int arow(int pm, int h, int R) const { const int d = rdst[pm * BM + h * HALF + R]; return d < 0 ? 0 : (d >> 1); }
    __device__ __forceinline__ bool next(int i, Unit& u) const {
        if (threadIdx.x == 0) slot[i & 1] = i == 0 ? (int)blockIdx.x : (int)(pend + gridDim.x);
        asm volatile("s_waitcnt lgkmcnt(0)\n\ts_barrier" ::: "memory");
        const int L = __builtin_amdgcn_readfirstlane(slot[i & 1]);
        const int pm = L / nN;
        const int te = __hip_atomic_load(tile_expert + (pm < MAXROWS / 256 ? pm : 0), __ATOMIC_RELAXED, __HIP_MEMORY_SCOPE_AGENT);
        if (L >= ntiles * nN) return false;
        u.pm = pm; u.pn = L % nN; u.koff = 0; u.kh = 1; u.bn = te * nN + u.pn; return true;
    }
    __device__ __forceinline__ void a_ready(const Unit& u) const {
        if (need == 0u) return;
        if (threadIdx.x < 64) {
            unsigned polls = 0;
            while ((unsigned)__builtin_amdgcn_readfirstlane(__hip_atomic_load(ready + 64 * u.pm, __ATOMIC_RELAXED, __HIP_MEMORY_SCOPE_AGENT)) < need) {
                __builtin_amdgcn_s_sleep(2);
                if ((++polls & 255u) == 0u) { if (__builtin_amdgcn_readfirstlane(__hip_atomic_load(tmo, __ATOMIC_RELAXED, __HIP_MEMORY_SCOPE_AGENT)) != 0u) break;
                    if (polls > (1u << 20)) { if (threadIdx.x == 0) __hip_atomic_store(tmo, 1u, __ATOMIC_RELAXED, __HIP_MEMORY_SCOPE_AGENT); break; } } }
            __builtin_amdgcn_fence(__ATOMIC_ACQUIRE, "agent");
            asm volatile("s_waitcnt vmcnt(0)" ::: "memory");
        }
        asm volatile("" ::: "memory"); __builtin_amdgcn_s_barrier(); asm volatile("" ::: "memory");
    }
    __device__ __forceinline__ void done(const Unit& u) const {
        if (publish == nullptr) return;
        asm volatile("s_waitcnt vmcnt(0)" ::: "memory");
        if ((threadIdx.x & 63) == 0) (void)__hip_atomic_fetch_add(publish + 64 * u.pm, 1u, __ATOMIC_RELAXED, __HIP_MEMORY_SCOPE_AGENT);
    }
};
template <class Epi, class Sched, bool ALIGN_EPI = false, bool SP2 = false, bool FP8 = false>
__device__ __forceinline__ void gemm_phase(PG8_LAS unsigned char* lds, const Gemm g, const Sched& S, const Epi& E) {
    const int tid = threadIdx.x, wid = __builtin_amdgcn_readfirstlane(tid >> 6), lane = tid & 63, wr = wid >> 2, wc = wid & 3, fr = lane & 15, fq = lane >> 4;
    const int K = g.ld, nt = g.K / BK;
    unsigned voffA[2], voffB[2];
#pragma unroll
    for (int i = 0; i < 2; ++i) { int R, C; stage_rc(tid * 16 + i * 8192, R, C); const int Rb = Epi::PERM ? ((R & ~31) + perm32(R & 31)) : R;
        voffA[i] = (unsigned)(R * K + C) * 2u; voffB[i] = (unsigned)(Rb * K + C) * 2u; }
    const size_t kstep = (size_t)(BK * 2);
    const size_t hstep = (size_t)HALF * K * 2;
    const size_t tstep = 2 * hstep;
    const unsigned ldsw = (unsigned)wid * 1024u;
    const int aoff = lds_byte(wr * 64 + fr, fq * 8), boff = lds_byte(wc * 32 + fr, fq * 8);
#define PG8_SA(b, h) (((b) * 2 + (h)) * HTB)
#define PG8_SB(b, h) ((4 + (b) * 2 + (h)) * HTB)
#define PG8_STAGE(bufoff, gbase, voff) do { _Pragma("unroll") for (int _i = 0; _i < 2; ++_i) \
        __builtin_amdgcn_global_load_lds((const unsigned*)((const char*)(gbase) + (voff)[_i]), (PG8_LAS unsigned*)(lds + (bufoff) + ldsw + _i * 8192), 16, 0, 0); } while (0)
#define PG8_LDA(dst, b, h) do { _Pragma("unroll") for (int m = 0; m < 4; ++m) { FragT<FP8>::ld(dst[m], lds + PG8_SA(b, h) + aoff + m * 2048); } } while (0)
#define PG8_LDB(dst, b, h) do { _Pragma("unroll") for (int n = 0; n < 2; ++n) { FragT<FP8>::ld(dst[n], lds + PG8_SB(b, h) + boff + n * 2048); } } while (0)
#define PG8_MMA(ai, bj, At, Bt) do { __builtin_amdgcn_s_setprio(1); _Pragma("unroll") for (int m = 0; m < 4; ++m) _Pragma("unroll") for (int n = 0; n < 2; ++n) { \
        FragT<FP8>::mma(acc[ai][bj][m][n], Bt[n], At[m]); } \
        __builtin_amdgcn_s_setprio(0); } while (0)
#define PG8_WAIT_V(n) asm volatile("s_waitcnt vmcnt(" #n ")" ::: "memory")
#define PG8_WAIT_L(n) asm volatile("s_waitcnt lgkmcnt(" #n ")" ::: "memory")
#define PG8_BAR __builtin_amdgcn_s_barrier()
#define PG8_SCHED __builtin_amdgcn_sched_barrier(0)
    Unit cur, nxt; int ui = 0;
    if (!S.next(0, cur)) return;
    S.claim();
    f32x4 acc[2][2][4][2];
#pragma unroll
    for (int a = 0; a < 2; ++a)
#pragma unroll
        for (int b = 0; b < 2; ++b)
#pragma unroll
            for (int m = 0; m < 4; ++m)
#pragma unroll
                for (int n = 0; n < 2; ++n) acc[a][b][m][n] = (f32x4){0.f, 0.f, 0.f, 0.f};
    typename FragT<FP8>::type At[4], B0[2], B1[2];
    const char* cA = (const char*)g.A + (size_t)cur.pm * tstep + (size_t)cur.koff * 2; const char* cB = (const char*)g.Bt + (size_t)cur.bn * tstep + (size_t)cur.koff * 2;
    S.a_ready(cur);
    if constexpr (SP2) {
        PG8_STAGE(PG8_SB(0, 0), cB, voffB); PG8_STAGE(PG8_SB(0, 1), cB + hstep, voffB); PG8_STAGE(PG8_SA(0, 0), cA, voffA); PG8_STAGE(PG8_SA(0, 1), cA + hstep, voffA);
        if (wr == 1) PG8_BAR;
        PG8_WAIT_V(2); PG8_BAR;
        PG8_STAGE(PG8_SB(1, 0), cB + kstep, voffB); PG8_STAGE(PG8_SA(1, 0), cA + kstep, voffA); PG8_STAGE(PG8_SB(1, 1), cB + hstep + kstep, voffB);
        PG8_WAIT_V(6); PG8_BAR;
    } else {
        PG8_STAGE(PG8_SB(0, 0), cB, voffB); PG8_STAGE(PG8_SA(0, 0), cA, voffA); PG8_STAGE(PG8_SB(0, 1), cB + hstep, voffB); PG8_STAGE(PG8_SA(0, 1), cA + hstep, voffA);
        if (wr == 1) PG8_BAR;
        PG8_WAIT_V(4); PG8_BAR;
        PG8_STAGE(PG8_SB(1, 0), cB + kstep, voffB); PG8_STAGE(PG8_SA(1, 0), cA + kstep, voffA); PG8_STAGE(PG8_SB(1, 1), cB + hstep + kstep, voffB);
        PG8_WAIT_V(6); PG8_BAR;
    }
    for (;;) {
        const bool has_next = S.next(ui + 1, nxt);
        const char* nA = has_next ? (const char*)g.A + (size_t)nxt.pm * tstep + (size_t)nxt.koff * 2 : cA; const char* nB = has_next ? (const char*)g.Bt + (size_t)nxt.bn * tstep + (size_t)nxt.koff * 2 : cB;
#pragma unroll 1
        for (int t = 0; t < nt; t += 2) {
            const bool last = (t == nt - 2);
            const char* a1 = cA + (size_t)(t + 1) * kstep;
            const char* a2 = last ? nA : cA + (size_t)(t + 2) * kstep; const char* b2 = last ? nB : cB + (size_t)(t + 2) * kstep;
            const char* a3 = a2 + kstep; const char* b3 = b2 + kstep;
            if (last && has_next) S.a_ready(nxt);
            if constexpr (SP2) {
            PG8_LDB(B0, 0, 0); PG8_LDB(B1, 0, 1); PG8_SCHED; PG8_LDA(At, 0, 0); PG8_STAGE(PG8_SA(1, 1), a1 + hstep, voffA);
            PG8_WAIT_V(8); PG8_WAIT_L(0); PG8_BAR; PG8_MMA(0, 0, At, B0); PG8_MMA(0, 1, At, B1); PG8_BAR; PG8_SCHED;
            PG8_LDA(At, 0, 1); PG8_STAGE(PG8_SB(0, 0), b2, voffB); PG8_STAGE(PG8_SB(0, 1), b2 + hstep, voffB); PG8_STAGE(PG8_SA(0, 0), a2, voffA);
            PG8_WAIT_V(8); PG8_WAIT_L(0); PG8_BAR; PG8_MMA(1, 0, At, B0); PG8_MMA(1, 1, At, B1); PG8_BAR; PG8_SCHED;
            PG8_LDB(B0, 1, 0); PG8_LDB(B1, 1, 1); PG8_SCHED; PG8_LDA(At, 1, 0); PG8_STAGE(PG8_SA(0, 1), a2 + hstep, voffA);
            PG8_WAIT_V(8); PG8_WAIT_L(0); PG8_BAR; PG8_MMA(0, 0, At, B0); PG8_MMA(0, 1, At, B1); PG8_BAR; PG8_SCHED;
            PG8_LDA(At, 1, 1); PG8_STAGE(PG8_SB(1, 0), b3, voffB); PG8_STAGE(PG8_SB(1, 1), b3 + hstep, voffB); PG8_STAGE(PG8_SA(1, 0), a3, voffA);
            PG8_WAIT_V(8); PG8_WAIT_L(0); PG8_BAR; PG8_MMA(1, 0, At, B0); PG8_MMA(1, 1, At, B1); PG8_BAR; PG8_SCHED;
            } else {
            PG8_LDB(B0, 0, 0); PG8_SCHED; PG8_LDA(At, 0, 0); PG8_STAGE(PG8_SA(1, 1), a1 + hstep, voffA);
            PG8_WAIT_L(8); PG8_BAR; PG8_WAIT_L(0); PG8_MMA(0, 0, At, B0); PG8_BAR; PG8_SCHED;
            PG8_LDB(B1, 0, 1); PG8_STAGE(PG8_SB(0, 0), b2, voffB);
            PG8_BAR; PG8_WAIT_L(0); PG8_MMA(0, 1, At, B1); PG8_BAR;
            PG8_LDA(At, 0, 1); PG8_STAGE(PG8_SA(0, 0), a2, voffA);
            PG8_BAR; PG8_WAIT_L(0); PG8_MMA(1, 0, At, B0); PG8_BAR; PG8_SCHED;
            PG8_STAGE(PG8_SB(0, 1), b2 + hstep, voffB);
            PG8_WAIT_V(6); PG8_BAR; PG8_MMA(1, 1, At, B1); PG8_BAR;
            PG8_LDB(B0, 1, 0); PG8_SCHED; PG8_LDA(At, 1, 0); PG8_STAGE(PG8_SA(0, 1), a2 + hstep, voffA);
            PG8_WAIT_L(8); PG8_BAR; PG8_WAIT_L(0); PG8_MMA(0, 0, At, B0); PG8_BAR; PG8_SCHED;
            PG8_LDB(B1, 1, 1); PG8_STAGE(PG8_SB(1, 0), b3, voffB);
            PG8_BAR; PG8_WAIT_L(0); PG8_MMA(0, 1, At, B1); PG8_BAR;
            PG8_LDA(At, 1, 1); PG8_STAGE(PG8_SA(1, 0), a3, voffA);
            PG8_BAR; PG8_WAIT_L(0); PG8_MMA(1, 0, At, B0); PG8_BAR; PG8_SCHED;
            PG8_STAGE(PG8_SB(1, 1), b3 + hstep, voffB);
            PG8_WAIT_V(6); PG8_BAR; PG8_MMA(1, 1, At, B1); PG8_BAR;
            }
        }
        if (has_next) S.claim();
        if constexpr (FP8) asm volatile("s_nop 15\n\ts_nop 7" ::: "memory");
        bool keep = false;
        if constexpr (Epi::MID) keep = (cur.kh == 0);
        if constexpr (ALIGN_EPI) { if (wr == 0 && !keep) PG8_BAR; }
        if constexpr (Epi::MID) { if (keep) E.mid(acc, cur, wr, wc, fr, fq); }
        if constexpr (!Epi::AFTER_DRAIN) { if (!keep) { E(acc, cur, wr, wc, fr, fq); S.done(cur); } }
        if (!has_next) break;
        if (!keep) {
#pragma unroll
        for (int a = 0; a < 2; ++a)
#pragma unroll
            for (int b = 0; b < 2; ++b)
#pragma unroll
                for (int m = 0; m < 4; ++m)
#pragma unroll
                    for (int n = 0; n < 2; ++n) acc[a][b][m][n] = (f32x4){0.f, 0.f, 0.f, 0.f}; }
        cur = nxt; cA = nA; cB = nB; ++ui;
        if constexpr (ALIGN_EPI) { if (wr == 1 && !keep) PG8_BAR; }
    }
    PG8_WAIT_V(0);
    if constexpr (!ALIGN_EPI) { if (wr == 0) PG8_BAR; }
    PG8_BAR;
    if constexpr (Epi::AFTER_DRAIN) { E.fused(acc, cur, wr, wc, fr, fq, lds, wid, lane); S.done(cur); }
#undef PG8_SA
#undef PG8_SB
#undef PG8_STAGE
#undef PG8_LDA
#undef PG8_LDB
#undef PG8_MMA
#undef PG8_WAIT_V
#undef PG8_WAIT_L
#undef PG8_BAR
#undef PG8_SCHED
}
template <class Epi, class Sched, bool ALIGN_EPI = false, bool SP2 = false, bool FP8 = false>
__device__ __forceinline__ void gemm_phase_g(PG8_LAS unsigned char* lds, const Gemm g, const Sched& S, const Epi& E) {
    const int tid = threadIdx.x, wid = __builtin_amdgcn_readfirstlane(tid >> 6), lane = tid & 63, wr = wid >> 2, wc = wid & 3, fr = lane & 15, fq = lane >> 4;
    const int K = g.ld, nt = g.K / BK;
    unsigned voffA[2], voffB[2];
#pragma unroll
    for (int i = 0; i < 2; ++i) { int R, C; stage_rc(tid * 16 + i * 8192, R, C); const int Rb = Epi::PERM ? ((R & ~31) + perm32(R & 31)) : R;
        voffA[i] = (unsigned)(R * K + C) * 2u; voffB[i] = (unsigned)(Rb * K + C) * 2u; }
    unsigned vAc[2][2], vAn[2][2];
#define PG8_AOFF(dst, u) do { _Pragma("unroll") for (int _h = 0; _h < 2; ++_h) _Pragma("unroll") for (int _i = 0; _i < 2; ++_i) { int R, C; stage_rc(tid * 16 + _i * 8192, R, C); \
        dst[_h][_i] = (unsigned)(S.arow((u).pm, _h, R) * K + C) * 2u; } } while (0)
    const size_t kstep = (size_t)(BK * 2);
    const size_t hstep = (size_t)HALF * K * 2;
    const size_t tstep = 2 * hstep;
    const unsigned ldsw = (unsigned)wid * 1024u;
    const int aoff = lds_byte(wr * 64 + fr, fq * 8), boff = lds_byte(wc * 32 + fr, fq * 8);
#define PG8_SA(b, h) (((b) * 2 + (h)) * HTB)
#define PG8_SB(b, h) ((4 + (b) * 2 + (h)) * HTB)
#define PG8_STAGE(bufoff, gbase, voff) do { _Pragma("unroll") for (int _i = 0; _i < 2; ++_i) \
        __builtin_amdgcn_global_load_lds((const unsigned*)((const char*)(gbase) + (voff)[_i]), (PG8_LAS unsigned*)(lds + (bufoff) + ldsw + _i * 8192), 16, 0, 0); } while (0)
#define PG8_LDA(dst, b, h) do { _Pragma("unroll") for (int m = 0; m < 4; ++m) { FragT<FP8>::ld(dst[m], lds + PG8_SA(b, h) + aoff + m * 2048); } } while (0)
#define PG8_LDB(dst, b, h) do { _Pragma("unroll") for (int n = 0; n < 2; ++n) { FragT<FP8>::ld(dst[n], lds + PG8_SB(b, h) + boff + n * 2048); } } while (0)
#define PG8_MMA(ai, bj, At, Bt) do { __builtin_amdgcn_s_setprio(1); _Pragma("unroll") for (int m = 0; m < 4; ++m) _Pragma("unroll") for (int n = 0; n < 2; ++n) { \
        FragT<FP8>::mma(acc[ai][bj][m][n], Bt[n], At[m]); } \
        __builtin_amdgcn_s_setprio(0); } while (0)
#define PG8_WAIT_V(n) asm volatile("s_waitcnt vmcnt(" #n ")" ::: "memory")
#define PG8_WAIT_L(n) asm volatile("s_waitcnt lgkmcnt(" #n ")" ::: "memory")
#define PG8_BAR __builtin_amdgcn_s_barrier()
#define PG8_SCHED __builtin_amdgcn_sched_barrier(0)
    Unit cur, nxt; int ui = 0;
    if (!S.next(0, cur)) return;
    S.claim();
    f32x4 acc[2][2][4][2];
#pragma unroll
    for (int a = 0; a < 2; ++a)
#pragma unroll
        for (int b = 0; b < 2; ++b)
#pragma unroll
            for (int m = 0; m < 4; ++m)
#pragma unroll
                for (int n = 0; n < 2; ++n) acc[a][b][m][n] = (f32x4){0.f, 0.f, 0.f, 0.f};
    typename FragT<FP8>::type At[4], B0[2], B1[2];
    PG8_AOFF(vAc, cur);
    const char* cA = (const char*)g.A; const char* cB = (const char*)g.Bt + (size_t)cur.bn * tstep;
    S.a_ready(cur);
    if constexpr (SP2) {
        PG8_STAGE(PG8_SB(0, 0), cB, voffB); PG8_STAGE(PG8_SB(0, 1), cB + hstep, voffB); PG8_STAGE(PG8_SA(0, 0), cA, vAc[0]); PG8_STAGE(PG8_SA(0, 1), cA, vAc[1]);
        if (wr == 1) PG8_BAR;
        PG8_WAIT_V(2); PG8_BAR;
        PG8_STAGE(PG8_SB(1, 0), cB + kstep, voffB); PG8_STAGE(PG8_SA(1, 0), cA + kstep, vAc[0]); PG8_STAGE(PG8_SB(1, 1), cB + hstep + kstep, voffB);
        PG8_WAIT_V(6); PG8_BAR;
    } else {
        PG8_STAGE(PG8_SB(0, 0), cB, voffB); PG8_STAGE(PG8_SA(0, 0), cA, vAc[0]); PG8_STAGE(PG8_SB(0, 1), cB + hstep, voffB); PG8_STAGE(PG8_SA(0, 1), cA, vAc[1]);
        if (wr == 1) PG8_BAR;
        PG8_WAIT_V(4); PG8_BAR;
        PG8_STAGE(PG8_SB(1, 0), cB + kstep, voffB); PG8_STAGE(PG8_SA(1, 0), cA + kstep, vAc[0]); PG8_STAGE(PG8_SB(1, 1), cB + hstep + kstep, voffB);
        PG8_WAIT_V(6); PG8_BAR;
    }
    for (;;) {
        const bool has_next = S.next(ui + 1, nxt);
        if (has_next) PG8_AOFF(vAn, nxt); else { _Pragma("unroll") for (int _h = 0; _h < 2; ++_h) _Pragma("unroll") for (int _i = 0; _i < 2; ++_i) vAn[_h][_i] = vAc[_h][_i]; }
        const char* nA = cA; const char* nB = has_next ? (const char*)g.Bt + (size_t)nxt.bn * tstep : cB;
#pragma unroll 1
        for (int t = 0; t < nt; t += 2) {
            const bool last = (t == nt - 2);
            const char* a1 = cA + (size_t)(t + 1) * kstep;
            const char* a2 = last ? nA : cA + (size_t)(t + 2) * kstep; const char* b2 = last ? nB : cB + (size_t)(t + 2) * kstep;
            const char* a3 = a2 + kstep; const char* b3 = b2 + kstep;
            unsigned vs0[2], vs1[2]; vs0[0] = last ? vAn[0][0] : vAc[0][0]; vs0[1] = last ? vAn[0][1] : vAc[0][1]; vs1[0] = last ? vAn[1][0] : vAc[1][0]; vs1[1] = last ? vAn[1][1] : vAc[1][1];
            if (last && has_next) S.a_ready(nxt);
            if constexpr (SP2) {
            PG8_LDB(B0, 0, 0); PG8_LDB(B1, 0, 1); PG8_SCHED; PG8_LDA(At, 0, 0); PG8_STAGE(PG8_SA(1, 1), a1, vAc[1]);
            PG8_WAIT_V(8); PG8_WAIT_L(0); PG8_BAR; PG8_MMA(0, 0, At, B0); PG8_MMA(0, 1, At, B1); PG8_BAR; PG8_SCHED;
            PG8_LDA(At, 0, 1); PG8_STAGE(PG8_SB(0, 0), b2, voffB); PG8_STAGE(PG8_SB(0, 1), b2 + hstep, voffB); PG8_STAGE(PG8_SA(0, 0), a2, vs0);
            PG8_WAIT_V(8); PG8_WAIT_L(0); PG8_BAR; PG8_MMA(1, 0, At, B0); PG8_MMA(1, 1, At, B1); PG8_BAR; PG8_SCHED;
            PG8_LDB(B0, 1, 0); PG8_LDB(B1, 1, 1); PG8_SCHED; PG8_LDA(At, 1, 0); PG8_STAGE(PG8_SA(0, 1), a2, vs1);
            PG8_WAIT_V(8); PG8_WAIT_L(0); PG8_BAR; PG8_MMA(0, 0, At, B0); PG8_MMA(0, 1, At, B1); PG8_BAR; PG8_SCHED;
            PG8_LDA(At, 1, 1); PG8_STAGE(PG8_SB(1, 0), b3, voffB); PG8_STAGE(PG8_SB(1, 1), b3 + hstep, voffB); PG8_STAGE(PG8_SA(1, 0), a3, vs0);
            PG8_WAIT_V(8); PG8_WAIT_L(0); PG8_BAR; PG8_MMA(1, 0, At, B0); PG8_MMA(1, 1, At, B1); PG8_BAR; PG8_SCHED;
            } else {
            PG8_LDB(B0, 0, 0); PG8_SCHED; PG8_LDA(At, 0, 0); PG8_STAGE(PG8_SA(1, 1), a1, vAc[1]);
            PG8_WAIT_L(8); PG8_BAR; PG8_WAIT_L(0); PG8_MMA(0, 0, At, B0); PG8_BAR; PG8_SCHED;
            PG8_LDB(B1, 0, 1); PG8_STAGE(PG8_SB(0, 0), b2, voffB);
            PG8_BAR; PG8_WAIT_L(0); PG8_MMA(0, 1, At, B1); PG8_BAR;
            PG8_LDA(At, 0, 1); PG8_STAGE(PG8_SA(0, 0), a2, vs0);
            PG8_BAR; PG8_WAIT_L(0); PG8_MMA(1, 0, At, B0); PG8_BAR; PG8_SCHED;
            PG8_STAGE(PG8_SB(0, 1), b2 + hstep, voffB);
            PG8_WAIT_V(6); PG8_BAR; PG8_MMA(1, 1, At, B1); PG8_BAR;
            PG8_LDB(B0, 1, 0); PG8_SCHED; PG8_LDA(At, 1, 0); PG8_STAGE(PG8_SA(0, 1), a2, vs1);
            PG8_WAIT_L(8); PG8_BAR; PG8_WAIT_L(0); PG8_MMA(0, 0, At, B0); PG8_BAR; PG8_SCHED;
            PG8_LDB(B1, 1, 1); PG8_STAGE(PG8_SB(1, 0), b3, voffB);
            PG8_BAR; PG8_WAIT_L(0); PG8_MMA(0, 1, At, B1); PG8_BAR;
            PG8_LDA(At, 1, 1); PG8_STAGE(PG8_SA(1, 0), a3, vs0);
            PG8_BAR; PG8_WAIT_L(0); PG8_MMA(1, 0, At, B0); PG8_BAR; PG8_SCHED;
            PG8_STAGE(PG8_SB(1, 1), b3 + hstep, voffB);
            PG8_WAIT_V(6); PG8_BAR; PG8_MMA(1, 1, At, B1); PG8_BAR;
            }
        }
        if constexpr (ALIGN_EPI) { if (wr == 0) PG8_BAR; }
        if (has_next) S.claim();
        if constexpr (FP8) asm volatile("s_nop 15\n\ts_nop 7" ::: "memory");
        if constexpr (!Epi::AFTER_DRAIN) { E(acc, cur, wr, wc, fr, fq); S.done(cur); }
        if (!has_next) break;
#pragma unroll
        for (int a = 0; a < 2; ++a)
#pragma unroll
            for (int b = 0; b < 2; ++b)
#pragma unroll
                for (int m = 0; m < 4; ++m)
#pragma unroll
                    for (int n = 0; n < 2; ++n) acc[a][b][m][n] = (f32x4){0.f, 0.f, 0.f, 0.f};
        cur = nxt; cA = nA; cB = nB; ++ui;
        _Pragma("unroll") for (int _h = 0; _h < 2; ++_h) _Pragma("unroll") for (int _i = 0; _i < 2; ++_i) vAc[_h][_i] = vAn[_h][_i];
        if constexpr (ALIGN_EPI) { if (wr == 1) PG8_BAR; }
    }
    PG8_WAIT_V(0);
    if constexpr (!ALIGN_EPI) { if (wr == 0) PG8_BAR; }
    PG8_BAR;
    if constexpr (Epi::AFTER_DRAIN) { E.fused(acc, cur, wr, wc, fr, fq, lds, wid, lane); S.done(cur); }
#undef PG8_AOFF
#undef PG8_SA
#undef PG8_SB
#undef PG8_STAGE
#undef PG8_LDA
#undef PG8_LDB
#undef PG8_MMA
#undef PG8_WAIT_V
#undef PG8_WAIT_L
#undef PG8_BAR
#undef PG8_SCHED
}
}

#define GAS __attribute__((address_space(1)))
#define LAS __attribute__((address_space(3)))
typedef unsigned short bf16;
typedef unsigned v4u __attribute__((ext_vector_type(4)));
typedef float f32x4 __attribute__((ext_vector_type(4)));
typedef short bf16x8 __attribute__((ext_vector_type(8)));
typedef GAS unsigned gu32;
#define RLX_AGENT __ATOMIC_RELAXED, __HIP_MEMORY_SCOPE_AGENT
#define LDS_WAIT() asm volatile("s_waitcnt lgkmcnt(0)" ::: "memory")
#define VM_WAIT() asm volatile("s_waitcnt vmcnt(0)" ::: "memory")
__device__ __forceinline__ unsigned f2bf(float f) { unsigned u = __builtin_bit_cast(unsigned, f); return (u + 0x7fffu + ((u >> 16) & 1u)) >> 16; }
__device__ __forceinline__ unsigned pk2(float lo, float hi) { return f2bf(lo) | (f2bf(hi) << 16); }
__device__ __forceinline__ float bf2f(unsigned short b) { return __builtin_bit_cast(float, (unsigned)b << 16); }
__device__ __forceinline__ float bflo(unsigned w) { return __builtin_bit_cast(float, w << 16); }
__device__ __forceinline__ float bfhi(unsigned w) { return __builtin_bit_cast(float, w & 0xffff0000u); }
__device__ __forceinline__ int ld_i32(const int* p) { return __hip_atomic_load(p, __ATOMIC_RELAXED, __HIP_MEMORY_SCOPE_AGENT); }
__device__ __forceinline__ float wave_sum(float v) {
#pragma unroll
    for (int o = 1; o < 64; o <<= 1) v += __shfl_xor(v, o);
    return v;
}
__device__ __forceinline__ float wave_max(float v) {
#pragma unroll
    for (int o = 1; o < 64; o <<= 1) v = fmaxf(v, __shfl_xor(v, o));
    return v;
}
__device__ const unsigned char T5B[128] = {0,1,2,3,4,5,6,7,8,9,10,11,12,13,14,15,16,16,16,17,17,18,18,18,19,19,19,20,20,20,20,21,21,21,21,22,22,22,22,22,23,23,23,23,23,23,24,24,24,24,24,24,25,25,25,25,25,25,25,26,26,26,26,26,26,26,26,27,27,27,27,27,27,27,27,27,27,28,28,28,28,28,28,28,28,28,28,29,29,29,29,29,29,29,29,29,29,29,29,30,30,30,30,30,30,30,30,30,30,30,30,30,30,31,31,31,31,31,31,31,31,31,31,31,31,31,31,31};
__device__ __forceinline__ int t5_bucket(int dist) { return dist >= 128 ? 31 : (int)T5B[dist < 0 ? 0 : dist]; }
#define XB_TMO      128
#define XB_XCNT(j)  (256  + 64 * (j))
#define XB_XSUB(j)  (1280 + 64 * (j))
#define XB_XGEN(j)  (2304 + 64 * (j))
#define XB_TOP      3328
#define XB_TOPGEN   3392
#define XCD_BAR_WORDS 3456
#define XB_SPIN_CAP (1u << 18)

__device__ __forceinline__ unsigned xb_ld(unsigned* p)              { return __hip_atomic_load(p, __ATOMIC_RELAXED, __HIP_MEMORY_SCOPE_AGENT); }
__device__ __forceinline__ unsigned xb_add(unsigned* p, unsigned v) { return __hip_atomic_fetch_add(p, v, __ATOMIC_RELAXED, __HIP_MEMORY_SCOPE_AGENT); }
__device__ __forceinline__ unsigned xb_xcc_id() { return (unsigned)__builtin_amdgcn_s_getreg((3 << 11) | 20) & 0xFu; }
#define XB_SPIN(cond, bar) do { unsigned _sp = 0; while (cond) { __builtin_amdgcn_s_sleep(1); \
    if ((++_sp & 255u) == 0u) { if (xb_ld(&(bar)[XB_TMO])) break; if (_sp > XB_SPIN_CAP) { atomicAdd(&(bar)[XB_TMO], 1u); break; } } } } while (0)

struct XcdBarrier {
    unsigned* bar; unsigned x;
    volatile LAS unsigned* st;
};

__device__ __forceinline__ XcdBarrier xcd_barrier_post(unsigned* bar, volatile LAS unsigned* st) {
    XcdBarrier b; b.bar = bar; b.x = xb_xcc_id(); b.st = st;
    if (threadIdx.x == 0) (void)xb_add(&bar[XB_XCNT(b.x)], 1u);
    return b;
}
__device__ __forceinline__ void xcd_barrier_complete(unsigned* bar, unsigned x, unsigned& nloc, unsigned& nx) {
    const unsigned G = gridDim.x * gridDim.y * gridDim.z;
    unsigned sum, cnt, mine, sp = 0u;
    for (;;) {
        sum = 0u; cnt = 0u; mine = 0u;
#pragma unroll
        for (unsigned j = 0; j < 16; ++j) { const unsigned c = xb_ld(&bar[XB_XCNT(j)]); sum += c; cnt += (c > 0u) ? 1u : 0u; mine = (j == x) ? c : mine; }
        if (sum == G) break;
        __builtin_amdgcn_s_sleep(1);
        if ((++sp & 255u) == 0u) { if (xb_ld(&bar[XB_TMO])) break; if (sp > XB_SPIN_CAP) { atomicAdd(&bar[XB_TMO], 1u); break; } }
    }
    nloc = mine > 0u ? mine : 1u; nx = cnt > 0u ? cnt : 1u;
}

__device__ __forceinline__ void xcd_barrier(const XcdBarrier& b) {
    asm volatile("s_waitcnt vmcnt(0)" ::: "memory");
    __syncthreads();
    if (threadIdx.x == 0) {
        unsigned* bar = b.bar;
        __builtin_amdgcn_s_waitcnt(0);
        unsigned nloc = b.st[0], nx = b.st[1];
        if (nloc == 0u) { xcd_barrier_complete(bar, b.x, nloc, nx); b.st[0] = nloc; b.st[1] = nx; }
        const unsigned old = xb_add(&bar[XB_XSUB(b.x)], 1u);
        const unsigned gen = old / nloc;
        if (old + 1u == (gen + 1u) * nloc) {
            __builtin_amdgcn_fence(__ATOMIC_RELEASE, "agent");
            asm volatile("s_waitcnt vmcnt(0)" ::: "memory");
            const unsigned og = xb_add(&bar[XB_TOP], 1u);
            const unsigned tg = og / nx;
            if (og + 1u == (tg + 1u) * nx) xb_add(&bar[XB_TOPGEN], 1u);
            else XB_SPIN(xb_ld(&bar[XB_TOPGEN]) == tg, bar);
            __builtin_amdgcn_fence(__ATOMIC_ACQUIRE, "agent");
            xb_add(&bar[XB_XGEN(b.x)], 1u);
            asm volatile("s_waitcnt vmcnt(0)" ::: "memory");
        } else {
            XB_SPIN(xb_ld(&bar[XB_XGEN(b.x)]) == gen, bar);
            __builtin_amdgcn_fence(__ATOMIC_ACQUIRE, "agent");
            asm volatile("s_waitcnt vmcnt(0)" ::: "memory");
        }
    }
    __syncthreads();
}

#define WSYNC() asm volatile("s_waitcnt lgkmcnt(0)" ::: "memory")
constexpr int WSCR = 18432;
__device__ __forceinline__ float log_sigmoid(float x) { return fminf(x, 0.f) - log1pf(expf(-fabsf(x))); }
__device__ __forceinline__ float sigmoidf_(float x) { return 1.f / (1.f + expf(-x)); }

__device__ __forceinline__ void compress_item(int item, int lane, LAS float* scr, const bf16* PROJ, const float* pe_k, const float* pe_v, const float* w1k, const float* w2k, const float* w1v, const float* w2v, bf16* KC, bf16* VC) {
    const int kv = item & 1, g = (item >> 1) & 3, bc = item >> 3, c = bc & 127, b = bc >> 7;
    bf16* dst = (kv ? VC : KC) + ((size_t)(b * 128 + c) * 4 + g) * 64;
    if (c == 127) { dst[lane] = 0; return; }
    const float* pe = kv ? pe_v : pe_k; const float* w1 = kv ? w1v : w1k; const float* w2 = kv ? w2v : w2k;
    const int colbase = (kv ? C_VCMP : C_KCMP) + g * 64;
    LAS float* xin = scr; LAS float* hid = scr + 2048;
    for (int l = 0; l < 32; ++l) xin[l * 64 + lane] = bf2f(PROJ[(size_t)(b * 2048 + 16 * c + l) * NPROJ + colbase + lane]) + pe[l * 64 + lane];
    WSYNC();
    float s0 = 0.f, s1 = 0.f;
#pragma unroll 8
    for (int i = 0; i < 2048; ++i) { const float x = xin[i]; s0 += x * w1[(size_t)i * 128 + lane]; s1 += x * w1[(size_t)i * 128 + 64 + lane]; }
    hid[lane] = s0 / (1.f + expf(-s0)); hid[64 + lane] = s1 / (1.f + expf(-s1));
    WSYNC();
    float o = 0.f;
#pragma unroll 8
    for (int j = 0; j < 128; ++j) o += hid[j] * w2[j * 64 + lane];
    dst[lane] = (bf16)f2bf(o);
    WSYNC();
}

__device__ __forceinline__ void compress_mfma(int wg, int tid, int lane, int wave, LAS float* part, LAS float* hid, const bf16* PROJ, const bf16* W1T, const float* B1, const float* w2k, const float* w2v, bf16* KC, bf16* VC) {
    typedef float f32x16 __attribute__((ext_vector_type(16)));
    const int kv = wg / 127, blk = wg % 127; const int r32 = lane & 31, hi = lane >> 5;
    const int colbase = kv ? C_VCMP : C_KCMP;
    f32x4 w2r[4];
    { const f32x4* w2g = (const f32x4*)(kv ? w2v : w2k) + tid * 4;
#pragma unroll
        for (int i = 0; i < 4; ++i) w2r[i] = w2g[i]; }
    { const int rho = blk * 32 + r32; const int g = rho & 3, bc = rho >> 2, c = bc % 127, b = bc / 127;
        const bf16* arow = PROJ + (size_t)(b * 2048 + 16 * c + 4 * wave) * NPROJ + colbase + g * 64 + hi * 8;
        const bf16* brow = W1T + (size_t)(kv * 8 + wave) * 32768 + lane * 8;
        f32x16 acc[4];
#pragma unroll
        for (int j = 0; j < 4; ++j)
#pragma unroll
            for (int r = 0; r < 16; ++r) acc[j][r] = 0.f;
#pragma unroll 8
        for (int s = 0; s < 16; ++s) {
            const bf16x8 A = *(const bf16x8*)(arow + (size_t)(s >> 2) * NPROJ + (s & 3) * 16);
            bf16x8 B[4];
#pragma unroll
            for (int j = 0; j < 4; ++j) B[j] = *(const bf16x8*)(brow + s * 2048 + j * 512);
#pragma unroll
            for (int j = 0; j < 4; ++j) acc[j] = __builtin_amdgcn_mfma_f32_32x32x16_bf16(A, B[j], acc[j], 0, 0, 0);
        }
        LAS float* pw = part + wave * 4096;
#pragma unroll
        for (int j = 0; j < 4; ++j)
#pragma unroll
            for (int r = 0; r < 16; ++r) pw[((r & 3) + 8 * (r >> 2) + 4 * hi) * 128 + 32 * j + r32] = acc[j][r];
    }
    __syncthreads();
    for (int i = tid; i < 4096; i += 512) { float s = B1[kv * 128 + (i & 127)];
#pragma unroll
        for (int w = 0; w < 8; ++w) s += part[w * 4096 + i];
        hid[i] = s / (1.f + __expf(-s)); }
    __syncthreads();
    { LAS f32x4* w2l = (LAS f32x4*)part + tid * 4;
#pragma unroll
        for (int i = 0; i < 4; ++i) w2l[i] = w2r[i]; }
    __syncthreads();
    { const int row = tid >> 4, d4 = (tid & 15) * 4; f32x4 o = {0.f, 0.f, 0.f, 0.f};
#pragma unroll 8
        for (int j = 0; j < 128; ++j) { const float hv = hid[row * 128 + j]; const f32x4 w = *(const LAS f32x4*)(part + j * 64 + d4); o += w * hv; }
        const int rho = blk * 32 + row; const int g = rho & 3, bc = rho >> 2, c = bc % 127, b = bc / 127;
        bf16* dst = (kv ? VC : KC) + ((size_t)(b * 128 + c) * 4 + g) * 64 + d4;
        *(unsigned long long*)dst = (unsigned long long)pk2(o[0], o[1]) | ((unsigned long long)pk2(o[2], o[3]) << 32); }
    __syncthreads();
}
__device__ __forceinline__ float log_sigmoid_fast(float x) { return fminf(x, 0.f) - __logf(1.f + __expf(-fabsf(x))); }
__device__ __forceinline__ void cumsum_wg(int bh, int wave, int lane, const float* GF, const float* fb, float* CUM, LAS float* tot) {
    const int b = bh >> 4, h = bh & 15; const float bias = fb[h]; const int t0 = wave * 256 + lane * 4;
    float v[4];
#pragma unroll
    for (int i = 0; i < 4; ++i) v[i] = GF[(size_t)(b * 2048 + t0 + i) * 64 + 48 + h];
    float s = 0.f;
#pragma unroll
    for (int i = 0; i < 4; ++i) { s += log_sigmoid_fast(v[i] + bias); v[i] = s; }
    float incl = s;
#pragma unroll
    for (int o = 1; o < 64; o <<= 1) { const float u = __shfl_up(incl, o); if (lane >= o) incl += u; }
    if (lane == 63) tot[wave] = incl;
    __syncthreads();
    float ex = incl - s;
    for (int w = 0; w < wave; ++w) ex += tot[w];
    *(f32x4*)(CUM + (size_t)bh * 2048 + t0) = (f32x4){(ex + v[0]) * LOG2E, (ex + v[1]) * LOG2E, (ex + v[2]) * LOG2E, (ex + v[3]) * LOG2E};
}
__device__ __forceinline__ void knorm_item(int item, int lane, const bf16* PROJ, unsigned* KN2) {
    const int bh = item >> 4, ch = item & 15, b = bh >> 4, h = bh & 15; float mx = 0.f;
    const bf16* base = PROJ + (size_t)(b * 2048 + ch * 128 + (lane >> 3)) * NPROJ + C_FK + h * 64 + (lane & 7) * 8;
#pragma unroll 8
    for (int i = 0; i < 16; ++i) { const v4u w = *(const v4u*)(base + (size_t)i * 8 * NPROJ);
        float s = bflo(w.x) * bflo(w.x) + bfhi(w.x) * bfhi(w.x) + bflo(w.y) * bflo(w.y) + bfhi(w.y) * bfhi(w.y) + bflo(w.z) * bflo(w.z) + bfhi(w.z) * bfhi(w.z) + bflo(w.w) * bflo(w.w) + bfhi(w.w) * bfhi(w.w);
        s += __shfl_xor(s, 1); s += __shfl_xor(s, 2); s += __shfl_xor(s, 4); mx = fmaxf(mx, s); }
    mx = wave_max(mx);
    if (lane == 0) __hip_atomic_fetch_max(KN2 + bh, __builtin_bit_cast(unsigned, mx), __ATOMIC_RELAXED, __HIP_MEMORY_SCOPE_AGENT);
}
template <int MODE> __device__ __forceinline__ void attn_row(int b, int t, int hg, int lane, LAS float* scr, unsigned mask, const bf16* PROJ, const float* rel, const float* CUM, float* o) {
    constexpr int NH = MODE == 2 ? 1 : 4, MAXK = MODE == 2 ? 2048 : 1024;
    LAS float* qs = scr;
    LAS float* sb = scr + 256;
    LAS int* cb = (LAS int*)(scr + 256 + 4096);
    const size_t tok = (size_t)b * 2048 + t;
    const int qcol = MODE == 2 ? C_FQ + hg * 64 : C_NQ + hg * 256, kcol = (MODE == 0 ? C_KSLC : MODE == 1 ? C_KWIN : C_FK) + hg * 64, vcol = (MODE == 0 ? C_VSLC : MODE == 1 ? C_VWIN : C_FV) + hg * 64;
#pragma unroll
    for (int r = 0; r < NH; ++r) qs[r * 64 + lane] = bf2f(PROJ[tok * NPROJ + qcol + r * 64 + lane]);
    WSYNC();
    const float ct = MODE == 2 ? CUM[(size_t)(b * 16 + hg) * 2048 + t] : 0.f;
    const int nchunk = MODE == 0 ? 32 : (MODE == 1 ? 8 : (t >> 6) + 1);
    int nc = 0; float mx[NH];
#pragma unroll
    for (int r = 0; r < NH; ++r) mx[r] = -INFINITY;
#pragma unroll 1
    for (int ch = 0; ch < nchunk; ++ch) {
        if (MODE == 0 && !((mask >> ch) & 1u)) continue;
        const int p0 = MODE == 1 ? t - 511 + ch * 64 : ch * 64; const int pos = p0 + lane; const bool ok = pos >= 0 && pos <= t;
        float d[NH];
#pragma unroll
        for (int r = 0; r < NH; ++r) d[r] = 0.f;
        if (ok) { const v4u* kr = (const v4u*)(PROJ + (size_t)(b * 2048 + pos) * NPROJ + kcol);
#pragma unroll 2
            for (int i = 0; i < 8; ++i) { const v4u w = kr[i];
                const float k0 = bflo(w.x), k1 = bfhi(w.x), k2 = bflo(w.y), k3 = bfhi(w.y), k4 = bflo(w.z), k5 = bfhi(w.z), k6 = bflo(w.w), k7 = bfhi(w.w);
#pragma unroll
                for (int r = 0; r < NH; ++r) { const LAS float* q = qs + r * 64 + i * 8; d[r] += q[0] * k0 + q[1] * k1 + q[2] * k2 + q[3] * k3 + q[4] * k4 + q[5] * k5 + q[6] * k6 + q[7] * k7; } } }
#pragma unroll
        for (int r = 0; r < NH; ++r) { float bias;
            if (MODE == 2) bias = ok ? ct - CUM[(size_t)(b * 16 + hg) * 2048 + pos] : 0.f; else bias = rel[t5_bucket(t - pos) * 16 + hg * 4 + r] * LOG2E;
            const float s = ok ? d[r] + bias : -INFINITY; sb[r * MAXK + nc * 64 + lane] = s; mx[r] = fmaxf(mx[r], s); }
        if (lane == 0) cb[nc] = p0;
        ++nc;
    }
    WSYNC();
    const int nk = nc * 64; float inv[NH];
#pragma unroll
    for (int r = 0; r < NH; ++r) { const float m = wave_max(mx[r]); float sum = 0.f;
        for (int i = lane; i < nk; i += 64) { const float s = sb[r * MAXK + i]; const float e = (s == -INFINITY) ? 0.f : exp2f(s - m); sb[r * MAXK + i] = e; sum += e; }
        inv[r] = 1.f / fmaxf(wave_sum(sum), 1e-30f); }
    WSYNC();
#pragma unroll
    for (int r = 0; r < NH; ++r) o[r] = 0.f;
    for (int c = 0; c < nc; ++c) { const int p0 = cb[c];
#pragma unroll 4
        for (int j = 0; j < 64; ++j) { const int pos = p0 + j; if (pos < 0 || pos > t) continue;
            const float v = bf2f(PROJ[(size_t)(b * 2048 + pos) * NPROJ + vcol + lane]);
#pragma unroll
            for (int r = 0; r < NH; ++r) o[r] += sb[r * MAXK + c * 64 + j] * v; } }
#pragma unroll
    for (int r = 0; r < NH; ++r) o[r] *= inv[r];
    WSYNC();
}
__device__ __forceinline__ void nsa_item(int item, int lane, LAS float* scr, const bf16* PROJ, const bf16* KC, const bf16* VC, const float* rel, const float* GF, bf16* O, float* SSQ) {
    const int g = item & 3, bt = item >> 2, t = bt & 2047, b = bt >> 11; const size_t tok = (size_t)b * 2048 + t;
    LAS float* qs = scr; LAS float* ps = scr + 256; LAS float* pg = scr + 256 + 512; LAS float* sc = scr + 256 + 512 + 136;
#pragma unroll
    for (int r = 0; r < 4; ++r) qs[r * 64 + lane] = bf2f(PROJ[tok * NPROJ + C_NQ + (g * 4 + r) * 64 + lane]);
    WSYNC();
    const int nvalid = t >= 31 ? min(127, (t - 31) / 16 + 1) : 0;
    float s0[4], s1[4];
#pragma unroll
    for (int half = 0; half < 2; ++half) { const int c = lane + 64 * half; const v4u* kr = (const v4u*)(KC + ((size_t)(b * 128 + c) * 4 + g) * 64);
        float d0 = 0.f, d1 = 0.f, d2 = 0.f, d3 = 0.f;
#pragma unroll 1
        for (int i = 0; i < 8; ++i) { const v4u w = kr[i]; const float kk[8] = {bflo(w.x), bfhi(w.x), bflo(w.y), bfhi(w.y), bflo(w.z), bfhi(w.z), bflo(w.w), bfhi(w.w)};
#pragma unroll
            for (int j = 0; j < 8; ++j) { const int d = i * 8 + j; d0 += qs[d] * kk[j]; d1 += qs[64 + d] * kk[j]; d2 += qs[128 + d] * kk[j]; d3 += qs[192 + d] * kk[j]; } }
        const bool ok = c < nvalid; const int bk = t5_bucket(t - (16 * c + 31)); const float* rb = rel + bk * 16 + g * 4;
        const float v0 = ok ? d0 + rb[0] * LOG2E : -INFINITY, v1 = ok ? d1 + rb[1] * LOG2E : -INFINITY, v2 = ok ? d2 + rb[2] * LOG2E : -INFINITY, v3 = ok ? d3 + rb[3] * LOG2E : -INFINITY;
        if (half == 0) { s0[0] = v0; s0[1] = v1; s0[2] = v2; s0[3] = v3; } else { s1[0] = v0; s1[1] = v1; s1[2] = v2; s1[3] = v3; } }
    float pgl0 = 0.f, pgl1 = 0.f;
#pragma unroll
    for (int r = 0; r < 4; ++r) { const float m = wave_max(fmaxf(s0[r], s1[r]));
        const float e0 = (lane < nvalid) ? exp2f(s0[r] - m) : 0.f, e1 = (lane + 64 < nvalid) ? exp2f(s1[r] - m) : 0.f;
        const float sum = wave_sum(e0 + e1), inv = 1.f / fmaxf(sum, 1e-30f); const float p0 = e0 * inv, p1 = e1 * inv;
        ps[r * 128 + lane] = p0; ps[r * 128 + lane + 64] = p1; pgl0 += p0; pgl1 += p1; }
    pg[1 + lane] = pgl0; pg[65 + lane] = pgl1; if (lane == 0) pg[0] = 0.f;
    WSYNC();
    float oc[4] = {0.f, 0.f, 0.f, 0.f};
#pragma unroll 4
    for (int c = 0; c < nvalid; ++c) { const float v = bf2f(VC[((size_t)(b * 128 + c) * 4 + g) * 64 + lane]); oc[0] += ps[c] * v; oc[1] += ps[128 + c] * v; oc[2] += ps[256 + c] * v; oc[3] += ps[384 + c] * v; }
    const int cur = t >> 6, blk = lane & 31;
    const int c0 = 4 * blk;
    const float imp = pg[c0] + 2.f * (pg[c0 + 1] + pg[c0 + 2] + pg[c0 + 3]) + pg[c0 + 4];
    const bool valid = blk <= cur; const bool forced = (blk == 0) || (blk == cur) || (blk == cur - 1);
    const float score = valid ? imp + (forced ? 1e4f : 0.f) : -1e30f;
    if (lane < 32) sc[lane] = score;
    WSYNC();
    int rank = 0;
    for (int j = 0; j < 32; ++j) { const float o = sc[j]; rank += (o > score || (o == score && j < blk)) ? 1 : 0; }
    const bool sel = (lane < 32) && valid && rank < 16;
    const unsigned mask = (unsigned)__ballot(sel);
    WSYNC();
    float os[4], ow[4];
    attn_row<0>(b, t, g, lane, scr, mask, PROJ, rel, nullptr, os);
    attn_row<1>(b, t, g, lane, scr, 0u, PROJ, rel, nullptr, ow);
    float ss = 0.f;
#pragma unroll
    for (int r = 0; r < 4; ++r) { const float* gl = GF + tok * 64 + g * 12 + r * 3;
        const float v = sigmoidf_(gl[0]) * oc[r] + sigmoidf_(gl[1]) * os[r] + sigmoidf_(gl[2]) * ow[r];
        O[tok * 2048 + (g * 4 + r) * 64 + lane] = (bf16)f2bf(v); ss += v * v; }
    ss = wave_sum(ss); if (lane < 4) SSQ[tok * 32 + g * 4 + lane] = (lane == 0) ? ss : 0.f;
}
__device__ __forceinline__ void fox_item(int item, int lane, LAS float* scr, const bf16* PROJ, const float* CUM, bf16* O, float* SSQ) {
    const int h = item & 15, bt = item >> 4, t = bt & 2047, b = bt >> 11; const size_t tok = (size_t)b * 2048 + t;
    float o[1];
    attn_row<2>(b, t, h, lane, scr, 0u, PROJ, nullptr, CUM, o);
    O[tok * 2048 + 1024 + h * 64 + lane] = (bf16)f2bf(o[0]); const float ss = wave_sum(o[0] * o[0]); if (lane == 0) SSQ[tok * 32 + 16 + h] = ss;
}
__device__ __forceinline__ void normalize_item(size_t tok, int lane, const bf16* O, const float* SSQ, bf16* MIXED) {
    float a = 0.f, f = 0.f;
    for (int i = 0; i < 16; ++i) a += SSQ[tok * 32 + i];
    for (int i = 0; i < 16; ++i) f += SSQ[tok * 32 + 16 + i];
    const float ra = 1.f / sqrtf(a * (1.f / 1024.f) + NORM_EPS), rf = 1.f / sqrtf(f * (1.f / 1024.f) + NORM_EPS);
    const v4u* src = (const v4u*)(O + tok * 2048); v4u* dst = (v4u*)(MIXED + tok * 2048);
#pragma unroll
    for (int i = 0; i < 4; ++i) { const v4u w = src[i * 64 + lane]; const float r = (i < 2) ? ra : rf; v4u o;
        o.x = pk2(bflo(w.x) * r, bfhi(w.x) * r); o.y = pk2(bflo(w.y) * r, bfhi(w.y) * r); o.z = pk2(bflo(w.z) * r, bfhi(w.z) * r); o.w = pk2(bflo(w.w) * r, bfhi(w.w) * r); dst[i * 64 + lane] = o; }
}
__device__ __forceinline__ void router_token(size_t tok, int lane, LAS float* lg, const bf16* HB, const float* HSSQ, const float* ffn_w, const float* wg, const float* bg, const float* we, const float* be, int& e0, int& e1, float& w0, float& w1, float& rstd) {
    float ss = (lane < 32) ? HSSQ[tok * 32 + lane] : 0.f; ss = wave_sum(ss);
    rstd = 1.f / sqrtf(ss * (1.f / 2048.f) + NORM_EPS);
    float acc[36];
#pragma unroll
    for (int o = 0; o < 36; ++o) acc[o] = 0.f;
    for (int i = 0; i < 32; ++i) { const int k = i * 64 + lane; const float hn = bf2f(HB[tok * 2048 + k]) * rstd * ffn_w[k];
        const f32x4 g4 = *(const f32x4*)(wg + (size_t)k * 4);
        acc[0] += hn * g4[0]; acc[1] += hn * g4[1]; acc[2] += hn * g4[2]; acc[3] += hn * g4[3];
#pragma unroll
        for (int j = 0; j < 8; ++j) { const f32x4 e4 = *(const f32x4*)(we + (size_t)k * 32 + j * 4);
            acc[4 + j * 4 + 0] += hn * e4[0]; acc[4 + j * 4 + 1] += hn * e4[1]; acc[4 + j * 4 + 2] += hn * e4[2]; acc[4 + j * 4 + 3] += hn * e4[3]; } }
#pragma unroll
    for (int o = 0; o < 36; ++o) { const float v = wave_sum(acc[o]); if (lane == 0) lg[o] = v + (o < 4 ? bg[o] : be[o - 4]); }
    WSYNC();
    int gsel = 0; float gm = lg[0];
    for (int i = 1; i < 4; ++i) if (lg[i] > gm) { gm = lg[i]; gsel = i; }
    float den = 0.f; for (int i = 0; i < 4; ++i) den += expf(lg[i] - gm);
    const float pgs = 1.f / den;
    const LAS float* el = lg + 4 + gsel * 8;
    int i1 = 0; float v1 = el[0];
    for (int j = 1; j < 8; ++j) if (el[j] > v1) { v1 = el[j]; i1 = j; }
    int i2 = 0; float v2 = -INFINITY;
    for (int j = 0; j < 8; ++j) if (j != i1 && el[j] > v2) { v2 = el[j]; i2 = j; }
    const float ex = expf(v2 - v1), d2 = 1.f / (1.f + ex);
    e0 = gsel * 8 + i1; e1 = gsel * 8 + i2; w0 = d2 * pgs; w1 = ex * d2 * pgs;
    WSYNC();
}

__device__ __forceinline__ void router_mfma(int bx, int tid, int lane, int wave, LAS float* part, const bf16* HB, const bf16* WrT) {
    typedef float f32x16 __attribute__((ext_vector_type(16)));
    const int r32 = lane & 31, hi = lane >> 5;
    f32x16 acc[2][2];
#pragma unroll
    for (int i = 0; i < 2; ++i)
#pragma unroll
        for (int j = 0; j < 2; ++j)
#pragma unroll
            for (int r = 0; r < 16; ++r) acc[i][j][r] = 0.f;
    const bf16* a0 = HB + (size_t)(bx * 64 + r32) * 2048 + wave * 256 + hi * 8;
    const bf16* b0 = WrT + wave * 16384 + lane * 8;
#pragma unroll 4
    for (int s = 0; s < 16; ++s) {
        bf16x8 A[2], Bh[2], Bl[2];
#pragma unroll
        for (int i = 0; i < 2; ++i) { A[i] = *(const bf16x8*)(a0 + (size_t)i * 32 * 2048 + s * 16); Bh[i] = *(const bf16x8*)(b0 + s * 1024 + i * 512); Bl[i] = *(const bf16x8*)(b0 + 64 * 2048 + s * 1024 + i * 512); }
#pragma unroll
        for (int i = 0; i < 2; ++i)
#pragma unroll
            for (int j = 0; j < 2; ++j) { acc[i][j] = __builtin_amdgcn_mfma_f32_32x32x16_bf16(A[i], Bh[j], acc[i][j], 0, 0, 0); acc[i][j] = __builtin_amdgcn_mfma_f32_32x32x16_bf16(A[i], Bl[j], acc[i][j], 0, 0, 0); }
    }
    LAS float* pw = part + wave * 4096;
#pragma unroll
    for (int i = 0; i < 2; ++i)
#pragma unroll
        for (int j = 0; j < 2; ++j)
#pragma unroll
            for (int r = 0; r < 16; ++r) pw[(32 * i + (r & 3) + 8 * (r >> 2) + 4 * hi) * 64 + 32 * j + r32] = acc[i][j][r];
}
__device__ __forceinline__ float fp8f(unsigned w, int i) { return i == 0 ? __builtin_amdgcn_cvt_f32_fp8((int)w, 0) : i == 1 ? __builtin_amdgcn_cvt_f32_fp8((int)w, 1) : i == 2 ? __builtin_amdgcn_cvt_f32_fp8((int)w, 2) : __builtin_amdgcn_cvt_f32_fp8((int)w, 3); }
__device__ __forceinline__ void final_item(size_t tok, int lane, const bf16* HB, const unsigned char* YS, const float* fw, float* OUT) {
    float v[32]; float ss = 0.f;
    const v4u* h4 = (const v4u*)(HB + tok * 2048); const unsigned long long* y0 = (const unsigned long long*)(YS + tok * 2048); const unsigned long long* y1 = (const unsigned long long*)(YS + (size_t)16384 * 2048 + tok * 2048);
#pragma unroll
    for (int i = 0; i < 4; ++i) { const v4u a = h4[i * 64 + lane]; const unsigned long long p = y0[i * 64 + lane], q = y1[i * 64 + lane];
        const unsigned pl = (unsigned)p, ph = (unsigned)(p >> 32), ql = (unsigned)q, qh = (unsigned)(q >> 32);
        v[i * 8 + 0] = bflo(a.x) + fp8f(pl, 0) + fp8f(ql, 0); v[i * 8 + 1] = bfhi(a.x) + fp8f(pl, 1) + fp8f(ql, 1); v[i * 8 + 2] = bflo(a.y) + fp8f(pl, 2) + fp8f(ql, 2); v[i * 8 + 3] = bfhi(a.y) + fp8f(pl, 3) + fp8f(ql, 3);
        v[i * 8 + 4] = bflo(a.z) + fp8f(ph, 0) + fp8f(qh, 0); v[i * 8 + 5] = bfhi(a.z) + fp8f(ph, 1) + fp8f(qh, 1); v[i * 8 + 6] = bflo(a.w) + fp8f(ph, 2) + fp8f(qh, 2); v[i * 8 + 7] = bfhi(a.w) + fp8f(ph, 3) + fp8f(qh, 3); }
#pragma unroll
    for (int i = 0; i < 32; ++i) ss += v[i] * v[i];
    ss = wave_sum(ss); const float r = 1.f / sqrtf(ss * (1.f / 2048.f) + NORM_EPS);
#pragma unroll
    for (int i = 0; i < 4; ++i) { const int k = i * 512 + lane * 8; const f32x4 wa = *(const f32x4*)(fw + k), wb = *(const f32x4*)(fw + k + 4);
        f32x4 oa = {v[i * 8 + 0] * r * wa[0], v[i * 8 + 1] * r * wa[1], v[i * 8 + 2] * r * wa[2], v[i * 8 + 3] * r * wa[3]};
        f32x4 ob = {v[i * 8 + 4] * r * wb[0], v[i * 8 + 5] * r * wb[1], v[i * 8 + 6] * r * wb[2], v[i * 8 + 7] * r * wb[3]};
        *(f32x4*)(OUT + tok * 2048 + k) = oa; *(f32x4*)(OUT + tok * 2048 + k + 4) = ob; }
}

namespace att {
typedef float f32x16 __attribute__((ext_vector_type(16)));
typedef short s16x4 __attribute__((ext_vector_type(4)));
typedef short v4i16_t __attribute__((ext_vector_type(4)));
typedef float f32x2_t __attribute__((ext_vector_type(2))); typedef __bf16 bf16x2_t __attribute__((ext_vector_type(2)));
typedef unsigned u32x4w __attribute__((ext_vector_type(4)));
__device__ __forceinline__ int clamp127(int d) { return d < 0 ? 0 : (d > 127 ? 127 : d); }
constexpr int SLOTB = 8192;
constexpr int A_KR = 0, A_VR = 32768, A_WSF = 65536, A_OST = 67584, A_PG = 100352, A_SC = 133120, A_SELM = 141312, A_BTAB = 141568, A_GATE = 143616, A_QSLOT = 146688;
static_assert(A_QSLOT + 16 <= 8 * 18432, "attention LDS map");
constexpr int A_BTW = 8 * 18432 + 9216;
constexpr float THR = 8.f;
constexpr float FOX_CUT = 40.f;
#define SBAR() __builtin_amdgcn_sched_barrier(0)
#ifndef PIPE_SGB
#define PIPE_SGB() do { _Pragma("unroll") for (int i = 0; i < 8; ++i) { __builtin_amdgcn_sched_group_barrier(0x100, 2, 0); __builtin_amdgcn_sched_group_barrier(0x008, 1, 0); __builtin_amdgcn_sched_group_barrier(0x002, 10, 0); } } while (0)
#endif
#define WAIT_BAR0() asm volatile("s_waitcnt vmcnt(0) lgkmcnt(0)\n\ts_barrier" ::: "memory")
__device__ __forceinline__ int crow(int r, int hi) { return (r & 3) + 8 * (r >> 2) + 4 * hi; }
__device__ __forceinline__ void glds16(const void* gsrc, unsigned lds_dst) { unsigned keep;
    asm volatile("s_mov_b32 %0, m0\n\ts_mov_b32 m0, %2\n\ts_nop 0\n\tglobal_load_lds_dwordx4 %1, off\n\ts_mov_b32 m0, %0" : "=&s"(keep) : "v"(gsrc), "s"(lds_dst) : "memory"); }
__device__ __forceinline__ unsigned cvtpk_s(float lo, float hi) { f32x2_t v = {lo, hi}; bf16x2_t b = __builtin_convertvector(v, bf16x2_t); return __builtin_bit_cast(unsigned, b); }
__device__ __forceinline__ s16x4 vtr(const LAS char* p) { return __builtin_bit_cast(s16x4, __builtin_amdgcn_ds_read_tr16_b64_v4i16((LAS v4i16_t*)p)); }
__device__ __forceinline__ float swapmax(float m) { auto rr = __builtin_amdgcn_permlane32_swap(__float_as_uint(m), __float_as_uint(m), false, false); return fmaxf(__uint_as_float(rr[0]), __uint_as_float(rr[1])); }
__device__ __forceinline__ float swapsum(float m) { auto rr = __builtin_amdgcn_permlane32_swap(__float_as_uint(m), __float_as_uint(m), false, false); return __uint_as_float(rr[0]) + __uint_as_float(rr[1]); }

struct Ctx { int tid, lane, r32, hi, wid; LAS char* shm; unsigned lds0; };
struct FlashState { f32x16 o[2]; float mhat, l; bool started; };

__device__ __forceinline__ void dma_k(const Ctx& c, const bf16* Ktile, long pitch, int slot) {
    glds16(Ktile + (long)c.lane * pitch + c.wid * 8, (unsigned)__builtin_amdgcn_readfirstlane(c.lds0 + A_KR + slot * SLOTB + c.wid * 1024)); }
__device__ __forceinline__ void dma_v(const Ctx& c, const bf16* Vtile, long pitch, int slot) {
    glds16(Vtile + (long)(16 * (c.wid & 3) + (c.lane >> 2)) * pitch + (c.wid >> 2) * 32 + (c.lane & 3) * 8, (unsigned)__builtin_amdgcn_readfirstlane(c.lds0 + A_VR + slot * SLOTB + c.wid * 1024)); }

__device__ __forceinline__ void qkt(f32x16& p0, f32x16& p1, const Ctx& c, int slot, const bf16x8 (&qr)[4], float cinit) {
    const LAS char* kb = c.shm + A_KR + slot * SLOTB + c.hi * 1024 + c.r32 * 16;
#pragma unroll
    for (int r = 0; r < 16; ++r) { p0[r] = cinit; p1[r] = cinit; }
#pragma unroll
    for (int d0 = 0; d0 < 4; ++d0) {
        const bf16x8 b0 = *(const LAS bf16x8*)(kb + d0 * 2048), b1 = *(const LAS bf16x8*)(kb + d0 * 2048 + 512);
        p0 = __builtin_amdgcn_mfma_f32_32x32x16_bf16(b0, qr[d0], p0, 0, 0, 0); p1 = __builtin_amdgcn_mfma_f32_32x32x16_bf16(b1, qr[d0], p1, 0, 0, 0); }
}
__device__ __forceinline__ void pv(f32x16 (&o)[2], const Ctx& c, int slot, const f32x16& p0, const f32x16& p1) {
    u32x4w pw[4];
#pragma unroll
    for (int k = 0; k < 2; ++k) {
        pw[k] = (u32x4w){cvtpk_s(p0[8 * k + 0], p0[8 * k + 1]), cvtpk_s(p0[8 * k + 2], p0[8 * k + 3]), cvtpk_s(p0[8 * k + 4], p0[8 * k + 5]), cvtpk_s(p0[8 * k + 6], p0[8 * k + 7])};
        pw[2 + k] = (u32x4w){cvtpk_s(p1[8 * k + 0], p1[8 * k + 1]), cvtpk_s(p1[8 * k + 2], p1[8 * k + 3]), cvtpk_s(p1[8 * k + 4], p1[8 * k + 5]), cvtpk_s(p1[8 * k + 6], p1[8 * k + 7])}; }
    const LAS char* vp = c.shm + A_VR + slot * SLOTB + ((c.lane >> 4) & 1) * 32 + (c.lane & 3) * 8 + (4 * c.hi + ((c.lane & 15) >> 2)) * 64;
#pragma unroll
    for (int d0 = 0; d0 < 2; ++d0)
#pragma unroll
        for (int ks = 0; ks < 4; ++ks) { const s16x4 lo = vtr(vp + d0 * 4096 + ks * 1024), hi4 = vtr(vp + d0 * 4096 + ks * 1024 + 512);
            const bf16x8 vf = (bf16x8){lo[0], lo[1], lo[2], lo[3], hi4[0], hi4[1], hi4[2], hi4[3]};
            o[d0] = __builtin_amdgcn_mfma_f32_32x32x16_bf16(__builtin_bit_cast(bf16x8, pw[ks]), vf, o[d0], 0, 0, 0); }
}
__device__ __forceinline__ float max3f(float a, float b, float c) { float r; asm("v_max3_f32 %0, %1, %2, %3" : "=v"(r) : "v"(a), "v"(b), "v"(c)); return r; }
__device__ __forceinline__ float rowmax32(const f32x16& p0, const f32x16& p1) {
    float a = max3f(p0[0], p0[1], p1[0]), b = max3f(p0[2], p0[3], p1[1]); a = max3f(a, p1[2], p1[3]);
#pragma unroll
    for (int r = 4; r < 16; r += 4) { a = max3f(a, p0[r], p0[r + 1]); b = max3f(b, p0[r + 2], p0[r + 3]); a = max3f(a, p1[r], p1[r + 1]); b = max3f(b, p1[r + 2], p1[r + 3]); }
    return swapmax(max3f(a, b, b));
}
__device__ __forceinline__ void softmax_step(FlashState& s, f32x16& p0, f32x16& p1, const Ctx& c) {
    const float rm = rowmax32(p0, p1);
    const bool fin = rm > -INFINITY; const bool need = fin && (!s.started || rm > THR);
    if (__any(need)) {
        const float dl = need ? (s.started ? fmaxf(rm, 0.f) : rm) : 0.f; s.mhat += dl;
#pragma unroll
        for (int r = 0; r < 16; ++r) { p0[r] -= dl; p1[r] -= dl; }
        const float f = __builtin_amdgcn_exp2f(-dl); s.l *= f;
        LAS float* wsf = (LAS float*)(c.shm + A_WSF) + c.wid * 64;
        if (c.hi == 0) wsf[c.r32] = f;
        asm volatile("s_waitcnt lgkmcnt(0)" ::: "memory");
#pragma unroll
        for (int r = 0; r < 16; ++r) { const float fr = wsf[crow(r, c.hi)]; s.o[0][r] *= fr; s.o[1][r] *= fr; }
        asm volatile("s_waitcnt lgkmcnt(0)" ::: "memory");
    }
    s.started = s.started || fin;
    float sacc = 0.f;
#pragma unroll
    for (int r = 0; r < 16; ++r) { p0[r] = __builtin_amdgcn_exp2f(p0[r]); p1[r] = __builtin_amdgcn_exp2f(p1[r]); sacc += p0[r] + p1[r]; }
    s.l += sacc;
}
__device__ __forceinline__ float sm_decide(FlashState& s, f32x16& p0, f32x16& p1, bool& any) {
    const float rm = rowmax32(p0, p1);
    const bool fin = rm > -INFINITY; const bool need = fin && (!s.started || rm > THR);
    float f = 1.f; any = __any(need);
    if (any) {
        const float dl = need ? (s.started ? fmaxf(rm, 0.f) : rm) : 0.f; s.mhat += dl;
#pragma unroll
        for (int r = 0; r < 16; ++r) { p0[r] -= dl; p1[r] -= dl; }
        f = __builtin_amdgcn_exp2f(-dl); s.l *= f;
    }
    s.started = s.started || fin;
    return f;
}
__device__ __forceinline__ void sm_rescale_o(FlashState& s, float f, const Ctx& c) {
    LAS float* wsf = (LAS float*)(c.shm + A_WSF) + c.wid * 64;
    if (c.hi == 0) wsf[c.r32] = f;
    asm volatile("s_waitcnt lgkmcnt(0)" ::: "memory");
#pragma unroll
    for (int r = 0; r < 16; ++r) { const float fr = wsf[crow(r, c.hi)]; s.o[0][r] *= fr; s.o[1][r] *= fr; }
    asm volatile("s_waitcnt lgkmcnt(0)" ::: "memory");
}
__device__ __forceinline__ void sm_exp(FlashState& s, f32x16& p0, f32x16& p1) {
    float sacc = 0.f;
#pragma unroll
    for (int r = 0; r < 16; ++r) { p0[r] = __builtin_amdgcn_exp2f(p0[r]); p1[r] = __builtin_amdgcn_exp2f(p1[r]); sacc += p0[r] + p1[r]; }
    s.l += sacc;
}
__device__ __forceinline__ void sm_pack(const f32x16& p0, const f32x16& p1, u32x4w (&pw)[4]) {
#pragma unroll
    for (int k = 0; k < 2; ++k) {
        pw[k] = (u32x4w){cvtpk_s(p0[8 * k + 0], p0[8 * k + 1]), cvtpk_s(p0[8 * k + 2], p0[8 * k + 3]), cvtpk_s(p0[8 * k + 4], p0[8 * k + 5]), cvtpk_s(p0[8 * k + 6], p0[8 * k + 7])};
        pw[2 + k] = (u32x4w){cvtpk_s(p1[8 * k + 0], p1[8 * k + 1]), cvtpk_s(p1[8 * k + 2], p1[8 * k + 3]), cvtpk_s(p1[8 * k + 4], p1[8 * k + 5]), cvtpk_s(p1[8 * k + 6], p1[8 * k + 7])}; }
}
__device__ __forceinline__ void pv_packed(f32x16 (&o)[2], const Ctx& c, int slot, const u32x4w (&pw)[4]) {
    const LAS char* vp = c.shm + A_VR + slot * SLOTB + ((c.lane >> 4) & 1) * 32 + (c.lane & 3) * 8 + (4 * c.hi + ((c.lane & 15) >> 2)) * 64;
#pragma unroll
    for (int d0 = 0; d0 < 2; ++d0)
#pragma unroll
        for (int ks = 0; ks < 4; ++ks) { const s16x4 lo = vtr(vp + d0 * 4096 + ks * 1024), hi4 = vtr(vp + d0 * 4096 + ks * 1024 + 512);
            const bf16x8 vf = (bf16x8){lo[0], lo[1], lo[2], lo[3], hi4[0], hi4[1], hi4[2], hi4[3]};
            o[d0] = __builtin_amdgcn_mfma_f32_32x32x16_bf16(__builtin_bit_cast(bf16x8, pw[ks]), vf, o[d0], 0, 0, 0); }
}
__device__ __forceinline__ f32x16 splat(float v) { f32x16 x;
#pragma unroll
    for (int r = 0; r < 16; ++r) x[r] = v; return x; }

template <bool PIPE, class Next, class CInit, class Post, class Skip>
__device__ __forceinline__ int flash(FlashState& s, const Ctx& c, const bf16x8 (&qr)[4], const bf16* Kc, const bf16* Vc, long pitch, int first, Next next, CInit cinit, Post post, Skip skip,
                                     int pair0 = 0, bool pre = false, const bf16* tK = nullptr, const bf16* tV = nullptr, int tj0 = -1, int tj1 = -1) {
    if (first < 0) return pair0;
    int j0 = first, j1 = next(first), pair = pair0;
    if (!pre) { dma_k(c, Kc + (long)j0 * 64 * pitch, pitch, 2 * pair); dma_v(c, Vc + (long)j0 * 64 * pitch, pitch, 2 * pair);
        if (j1 >= 0) { dma_k(c, Kc + (long)j1 * 64 * pitch, pitch, 2 * pair + 1); dma_v(c, Vc + (long)j1 * 64 * pitch, pitch, 2 * pair + 1); } }
    while (j0 >= 0) {
        const int n0 = j1 >= 0 ? next(j1) : -1, n1 = n0 >= 0 ? next(n0) : -1;
        WAIT_BAR0();
        const int so = 2 * (pair ^ 1);
        if (n0 >= 0) { dma_k(c, Kc + (long)n0 * 64 * pitch, pitch, so); dma_v(c, Vc + (long)n0 * 64 * pitch, pitch, so);
            if (n1 >= 0) { dma_k(c, Kc + (long)n1 * 64 * pitch, pitch, so + 1); dma_v(c, Vc + (long)n1 * 64 * pitch, pitch, so + 1); } }
        else if (tj0 >= 0) { dma_k(c, tK + (long)tj0 * 64 * pitch, pitch, so); dma_v(c, tV + (long)tj0 * 64 * pitch, pitch, so);
            if (tj1 >= 0) { dma_k(c, tK + (long)tj1 * 64 * pitch, pitch, so + 1); dma_v(c, tV + (long)tj1 * 64 * pitch, pitch, so + 1); }
            tj0 = -1; }
        bool both = false;
        if constexpr (PIPE) both = j1 >= 0 && !skip(j0) && !skip(j1);
        if (both) {
            const int sl0 = 2 * pair, sl1 = 2 * pair + 1;
            f32x16 a0, a1, b0, b1; u32x4w pw[4]; bool any0, any1;
            qkt(a0, a1, c, sl0, qr, cinit(j0));
            asm volatile("s_nop 15\n\ts_nop 7" : "+v"(a0), "+v"(a1));
            post(j0, a0, a1);
            const float f0 = sm_decide(s, a0, a1, any0);
            if (any0) sm_rescale_o(s, f0, c);
            SBAR();
            qkt(b0, b1, c, sl1, qr, cinit(j1));
            sm_exp(s, a0, a1);
            PIPE_SGB();
            sm_pack(a0, a1, pw);
            asm volatile("s_nop 15\n\ts_nop 7" : "+v"(b0), "+v"(b1));
            post(j1, b0, b1);
            const float f1 = sm_decide(s, b0, b1, any1);
            SBAR();
            pv_packed(s.o, c, sl0, pw);
            sm_exp(s, b0, b1);
            PIPE_SGB();
            if (any1) sm_rescale_o(s, f1, c);
            sm_pack(b0, b1, pw);
            pv_packed(s.o, c, sl1, pw);
        } else
#pragma unroll
        for (int h = 0; h < 2; ++h) {
            const int j = h ? j1 : j0, slot = 2 * pair + h;
            if (j >= 0 && !skip(j)) {
                f32x16 p0, p1;
                qkt(p0, p1, c, slot, qr, cinit(j));
                asm volatile("s_nop 15\n\ts_nop 7" : "+v"(p0), "+v"(p1));
                post(j, p0, p1);
                softmax_step(s, p0, p1, c);
                pv(s.o, c, slot, p0, p1);
            }
        }
        pair ^= 1; j0 = n0; j1 = n1;
    }
    asm volatile("s_waitcnt lgkmcnt(0)\n\ts_barrier" ::: "memory");
    return pair;
}
__device__ __forceinline__ void load_q(bf16x8 (&qr)[4], const bf16* Qrow, int hi) {
#pragma unroll
    for (int d0 = 0; d0 < 4; ++d0) qr[d0] = *(const bf16x8*)(Qrow + d0 * 16 + hi * 8);
}
__device__ __forceinline__ void accum_branch(f32x16 (&ot)[2], const f32x16 (&o)[2], float fac, const Ctx& c) {
    LAS float* wsf = (LAS float*)(c.shm + A_WSF) + c.wid * 64;
    if (c.hi == 0) wsf[c.r32] = fac;
    asm volatile("s_waitcnt lgkmcnt(0)" ::: "memory");
#pragma unroll
    for (int r = 0; r < 16; ++r) { const float fr = wsf[crow(r, c.hi)]; ot[0][r] += o[0][r] * fr; ot[1][r] += o[1][r] * fr; }
    asm volatile("s_waitcnt lgkmcnt(0)" ::: "memory");
}
__device__ __forceinline__ void store_o(const f32x16 (&o)[2], const Ctx& c, bf16* Orow0, float* ssq0) {
    LAS bf16* stg = (LAS bf16*)(c.shm + A_OST) + c.wid * 2048;
#pragma unroll
    for (int r = 0; r < 16; ++r) { const int orow = crow(r, c.hi);
#pragma unroll
        for (int d0 = 0; d0 < 2; ++d0) stg[orow * 64 + d0 * 32 + c.r32] = (bf16)f2bf(o[d0][r]); }
    asm volatile("s_waitcnt lgkmcnt(0)" ::: "memory");
#pragma unroll
    for (int i = 0; i < 4; ++i) { const int row = i * 8 + (c.lane >> 3), ch = c.lane & 7; const v4u v = *(const LAS v4u*)(stg + row * 64 + ch * 8);
        *(v4u*)(Orow0 + (long)row * 2048 + ch * 8) = v;
        float ss = bflo(v.x) * bflo(v.x) + bfhi(v.x) * bfhi(v.x) + bflo(v.y) * bflo(v.y) + bfhi(v.y) * bfhi(v.y) + bflo(v.z) * bflo(v.z) + bfhi(v.z) * bfhi(v.z) + bflo(v.w) * bflo(v.w) + bfhi(v.w) * bfhi(v.w);
        ss += __shfl_xor(ss, 1); ss += __shfl_xor(ss, 2); ss += __shfl_xor(ss, 4);
        if (ch == 0) ssq0[(long)row * 32] = ss; }
    asm volatile("s_waitcnt lgkmcnt(0)" ::: "memory");
}

__device__ __forceinline__ void fox_unit(const Ctx& c, int b, int h, int qb, const bf16* PROJ, const float* CUM, const unsigned* KN2, bf16* O, float* SSQ, unsigned* qhead, unsigned& pend) {
    const int q0 = qb * 256, NT = 4 * (qb + 1); const long rowbase = (long)b * 2048;
    const bf16* Kb = PROJ + rowbase * NPROJ + C_FK + h * 64; const bf16* Vb = PROJ + rowbase * NPROJ + C_FV + h * 64;
    dma_k(c, Kb + (long)(NT - 1) * 64 * NPROJ, NPROJ, 0); dma_v(c, Vb + (long)(NT - 1) * 64 * NPROJ, NPROJ, 0);
    dma_k(c, Kb + (long)(NT - 2) * 64 * NPROJ, NPROJ, 1); dma_v(c, Vb + (long)(NT - 2) * 64 * NPROJ, NPROJ, 1);
    LAS float* cumL = (LAS float*)(c.shm + A_PG);
    const float* cu = CUM + (size_t)(b * 16 + h) * 2048;
    float cv[4];
#pragma unroll
    for (int k = 0; k < 4; ++k) cv[k] = cu[c.tid + 512 * k];
    bf16x8 qr[4]; load_q(qr, PROJ + (rowbase + q0 + c.wid * 32 + c.r32) * NPROJ + C_FQ + h * 64, c.hi);
    const int qrel = c.wid * 32 + c.r32; const float cq = cu[q0 + qrel];
    const float kn2 = __builtin_bit_cast(float, __hip_atomic_load(KN2 + b * 16 + h, __ATOMIC_RELAXED, __HIP_MEMORY_SCOPE_AGENT));
#pragma unroll
    for (int k = 0; k < 4; ++k) cumL[c.tid + 512 * k] = cv[k];
    FlashState s; s.o[0] = splat(0.f); s.o[1] = splat(0.f); s.mhat = 0.f; s.l = 0.f; s.started = false;
    const int wid = c.wid, hi = c.hi;
    float qn2 = 0.f;
#pragma unroll
    for (int d0 = 0; d0 < 4; ++d0)
#pragma unroll
        for (int j = 0; j < 8; ++j) { const float x = bf2f((unsigned short)qr[d0][j]); qn2 += x * x; }
    qn2 = swapsum(qn2);
    const float qkb = sqrtf(qn2 * kn2) * 1.0001f;
    auto cinit = [&](int) { return cq - s.mhat; };
    auto post = [&](int j, f32x16& p0, f32x16& p1) {
            const LAS f32x4* ck = (const LAS f32x4*)(cumL + 64 * j + 4 * hi);
#pragma unroll
            for (int k = 0; k < 4; ++k) { const f32x4 a = ck[2 * k];
#pragma unroll
                for (int i = 0; i < 4; ++i) p0[4 * k + i] -= a[i]; }
            SBAR();
#pragma unroll
            for (int k = 0; k < 4; ++k) { const f32x4 bq = ck[2 * k + 8];
#pragma unroll
                for (int i = 0; i < 4; ++i) p1[4 * k + i] -= bq[i]; }
            SBAR();
            const int jb = j - (NT - 4);
            if (jb >= 0) { const int kb = 64 * jb + 4 * hi;
#pragma unroll
                for (int r = 0; r < 16; ++r) { const int kv = kb + (r & 3) + 8 * (r >> 2); if (kv > qrel) p0[r] = -INFINITY; if (kv + 32 > qrel) p1[r] = -INFINITY; } }
        };
    auto skip = [&](int j) { const int jb = j - (NT - 4); return jb >= 0 && 64 * jb > 32 * wid + 31; };
    flash<false>(s, c, qr, Kb, Vb, (long)NPROJ, NT - 1, [&](int j) { return j > NT - 4 ? j - 1 : -1; }, cinit, post, skip, 0, true, Kb, Vb, NT > 4 ? NT - 5 : -1, NT - 6);
    if (NT > 4) {
        LAS float* wmx = (LAS float*)(c.shm + A_SC);
        const float ub = wave_max(qkb + cq - s.mhat);
        if (c.lane == 0) wmx[c.wid] = ub;
        __syncthreads();
        float A = wmx[0];
#pragma unroll
        for (int w = 1; w < 8; ++w) A = fmaxf(A, wmx[w]);
        A = __builtin_bit_cast(float, __builtin_amdgcn_readfirstlane(__builtin_bit_cast(int, A)));
        auto alive = [&](int j) { return j >= 0 && A - cumL[64 * j + 63] >= -FOX_CUT; };
        flash<false>(s, c, qr, Kb, Vb, (long)NPROJ, alive(NT - 5) ? NT - 5 : -1, [&](int j) { return alive(j - 1) ? j - 1 : -1; }, cinit, post, [](int) { return false; }, 0, true);
    }
    if (c.tid == 0) { unsigned z = 0u; asm volatile("" : "+v"(z)); pend = __hip_atomic_fetch_add(qhead + z, 1u, __ATOMIC_RELAXED, __HIP_MEMORY_SCOPE_AGENT); }
    const float lt = swapsum(s.l);
    f32x16 ot[2]; ot[0] = splat(0.f); ot[1] = splat(0.f);
    accum_branch(ot, s.o, 1.f / lt, c);
    store_o(ot, c, O + (rowbase + q0 + c.wid * 32) * 2048 + 1024 + h * 64, SSQ + (rowbase + q0 + c.wid * 32) * 32 + 16 + h);
    asm volatile("s_waitcnt lgkmcnt(0)\n\ts_barrier" ::: "memory");
}

__device__ __forceinline__ void nsa_unit(const Ctx& c, int b, int g, int qt, const bf16* PROJ, const bf16* KC, const bf16* VC, const float* rel, const float* GF, bf16* O, float* SSQ, unsigned* qhead, unsigned& pend) {
    const long rowbase = (long)b * 2048; const int t0 = 64 * qt;
    const int head = c.wid >> 1, a = 32 * (c.wid & 1) + c.r32;
    const int t = t0 + a, hi = c.hi;
    LAS float* pg = (LAS float*)(c.shm + A_PG); LAS float* sc = (LAS float*)(c.shm + A_SC); LAS unsigned* selm = (LAS unsigned*)(c.shm + A_SELM);
    LAS float* btab = (LAS float*)(c.shm + A_BTAB); LAS float* gate = (LAS float*)(c.shm + A_GATE);
    const bool two = qt >= 16;
    { const bf16* Kc = KC + ((size_t)b * 128 * 4 + g) * 64; const bf16* Vc = VC + ((size_t)b * 128 * 4 + g) * 64;
        dma_k(c, Kc, 256, 0); dma_v(c, Vc, 256, 0);
        if (two) { dma_k(c, Kc + 64 * 256, 256, 1); dma_v(c, Vc + 64 * 256, 256, 1); } }
    const bf16* Ks = PROJ + rowbase * NPROJ + C_KSLC + g * 64; const bf16* Vs = PROJ + rowbase * NPROJ + C_VSLC + g * 64;
    dma_k(c, Ks + (long)qt * 64 * NPROJ, NPROJ, 2); dma_v(c, Vs + (long)qt * 64 * NPROJ, NPROJ, 2);
    if (qt > 0) { dma_k(c, Ks + (long)(qt - 1) * 64 * NPROJ, NPROJ, 3); dma_v(c, Vs + (long)(qt - 1) * 64 * NPROJ, NPROJ, 3); }
    bf16x8 qr[4]; load_q(qr, PROJ + (rowbase + t) * NPROJ + C_NQ + (g * 4 + head) * 64, hi);
    { const int hh = c.tid >> 7, d = c.tid & 127; const int hq = g * 4 + hh; const float r31 = rel[31 * 16 + hq];
        const float rb = rel[t5_bucket(d) * 16 + hq];
        const int i1 = c.tid + 512, h0 = c.tid >> 8, h1 = i1 >> 8, d0 = (c.tid & 255) - 64, d1 = (i1 & 255) - 64;
        const float w0 = rel[t5_bucket(clamp127(d0)) * 16 + g * 4 + h0], w0r = rel[31 * 16 + g * 4 + h0], w1 = rel[t5_bucket(clamp127(d1)) * 16 + g * 4 + h1], w1r = rel[31 * 16 + g * 4 + h1];
        const int ga = c.tid, gb = c.tid < 256 ? c.tid + 512 : c.tid;
        const float gv0 = GF[(size_t)(rowbase + t0 + (ga % 192) / 3) * 64 + g * 12 + (ga / 192) * 3 + (ga % 192) % 3], gv1 = GF[(size_t)(rowbase + t0 + (gb % 192) / 3) * 64 + g * 12 + (gb / 192) * 3 + (gb % 192) % 3];
        btab[c.tid] = (rb - r31) * LOG2E;
        LAS float* bw = (LAS float*)(c.shm + A_BTW);
        bw[c.tid] = (d0 >= 0 && d0 < 127) ? (w0 - w0r) * LOG2E : 0.f; bw[i1] = (d1 >= 0 && d1 < 127) ? (w1 - w1r) * LOG2E : 0.f;
        gate[ga] = sigmoidf_(gv0); if (c.tid < 256) gate[gb] = sigmoidf_(gv1); }
    if (c.tid < 64) selm[c.tid] = 0u;
    f32x16 ot[2]; ot[0] = splat(0.f); ot[1] = splat(0.f);
    const LAS float* bt = btab + head * 128;
    __syncthreads();
    {
        WAIT_BAR0();
        f32x16 p0, p1, p2, p3;
        qkt(p0, p1, c, 0, qr, 0.f);
        if (two) qkt(p2, p3, c, 1, qr, 0.f); else { p2 = splat(-INFINITY); p3 = splat(-INFINITY); }
        const int cmax = t >= 31 ? (t - 31) >> 4 : -1;
        auto cmp_post = [&](f32x16& p, int cbase) {
#pragma unroll
            for (int q4 = 0; q4 < 4; ++q4) {
                float bv[4];
#pragma unroll
                for (int i = 0; i < 4; ++i) { const int c0 = crow(4 * q4 + i, hi) + cbase; bv[i] = bt[clamp127(t - 16 * c0 - 31)]; }
                asm volatile("" : "+v"(bv[0]), "+v"(bv[1]), "+v"(bv[2]), "+v"(bv[3]));
#pragma unroll
                for (int i = 0; i < 4; ++i) { const int r = 4 * q4 + i; const int c0 = crow(r, hi) + cbase; p[r] = (c0 <= cmax) ? p[r] + bv[i] : -INFINITY; }
            }
        };
        cmp_post(p0, 0); cmp_post(p1, 32);
        if (two) { cmp_post(p2, 64); cmp_post(p3, 96); }
        float rm = fmaxf(rowmax32(p0, p1), rowmax32(p2, p3)); if (!(rm > -INFINITY)) rm = 0.f;
        float sum = 0.f;
#pragma unroll
        for (int r = 0; r < 16; ++r) { p0[r] = __builtin_amdgcn_exp2f(p0[r] - rm); p1[r] = __builtin_amdgcn_exp2f(p1[r] - rm); p2[r] = __builtin_amdgcn_exp2f(p2[r] - rm); p3[r] = __builtin_amdgcn_exp2f(p3[r] - rm); sum += (p0[r] + p1[r]) + (p2[r] + p3[r]); }
        sum = swapsum(sum); const float inv = 1.f / fmaxf(sum, 1e-30f);
#pragma unroll
        for (int r = 0; r < 16; ++r) { p0[r] *= inv; p1[r] *= inv; p2[r] *= inv; p3[r] *= inv; }
        if (qt >= 16) {
#pragma unroll 1
            for (int hh = 0; hh < 4; ++hh) {
                if (head == hh) {
#pragma unroll
                    for (int r = 0; r < 16; ++r) { const int cc = crow(r, hi);
                        if (hh == 0) { pg[(cc) * 64 + a] = p0[r]; pg[(cc + 32) * 64 + a] = p1[r]; pg[(cc + 64) * 64 + a] = p2[r]; pg[(cc + 96) * 64 + a] = p3[r]; }
                        else { pg[(cc) * 64 + a] += p0[r]; pg[(cc + 32) * 64 + a] += p1[r]; pg[(cc + 64) * 64 + a] += p2[r]; pg[(cc + 96) * 64 + a] += p3[r]; } } }
                __syncthreads();
            }
        }
        { const float g0 = gate[(head * 64 + a) * 3 + 0];
#pragma unroll
            for (int r = 0; r < 16; ++r) { p0[r] *= g0; p1[r] *= g0; p2[r] *= g0; p3[r] *= g0; } }
        pv(ot, c, 0, p0, p1);
        if (two) pv(ot, c, 1, p2, p3);
        asm volatile("s_waitcnt lgkmcnt(0)\n\ts_barrier" ::: "memory");
    }
    unsigned mymask;
    if (qt >= 16) {
        const int tk = c.tid & 63, grp = c.tid >> 6; float sv[4];
#pragma unroll
        for (int i = 0; i < 4; ++i) { const int blk = 4 * grp + i, c0 = 4 * blk;
            const float imp = (c0 > 0 ? pg[(c0 - 1) * 64 + tk] : 0.f) + 2.f * (pg[c0 * 64 + tk] + pg[(c0 + 1) * 64 + tk] + pg[(c0 + 2) * 64 + tk]) + pg[(c0 + 3) * 64 + tk];
            const bool valid = blk <= qt, forced = (blk == 0) || (blk == qt) || (blk == qt - 1);
            sv[i] = valid ? imp + (forced ? 1e4f : 0.f) : -1e30f; sc[blk * 64 + tk] = sv[i]; }
        __syncthreads();
        int rk[4] = {0, 0, 0, 0};
#pragma unroll 8
        for (int j = 0; j < 32; ++j) { const float o = sc[j * 64 + tk];
#pragma unroll
            for (int i = 0; i < 4; ++i) rk[i] += (int)(o > sv[i]) + (int)((o == sv[i]) & (j < 4 * grp + i)); }
        unsigned bits = 0u;
#pragma unroll
        for (int i = 0; i < 4; ++i) if (rk[i] < 16 && 4 * grp + i <= qt) bits |= 1u << (4 * grp + i);
        if (bits) __hip_atomic_fetch_or(selm + tk, bits, __ATOMIC_RELAXED, __HIP_MEMORY_SCOPE_WORKGROUP);
        __syncthreads();
        mymask = selm[a];
    } else mymask = (qt == 31) ? 0xffffffffu : ((1u << (qt + 1)) - 1u);
    unsigned um = mymask;
    if (qt >= 16) { um = 0u; for (int i = 0; i < 64; ++i) um |= selm[i]; }
    um = (unsigned)__builtin_amdgcn_readfirstlane((int)um);
    const int awave = 32 * (c.wid & 1);
    const LAS float* bwin = (const LAS float*)(c.shm + A_BTW) + head * 256 + (a - 4 * hi + 5);
    auto near_post = [&](int delta, f32x16& p0, f32x16& p1) {
        const LAS float* tb = bwin + 64 * delta;
        const int lim2 = delta == 0 ? a - 4 * hi : 1000;
#pragma unroll
        for (int q4 = 0; q4 < 4; ++q4) {
            float b0[4], b1[4];
#pragma unroll
            for (int i = 0; i < 4; ++i) { b0[i] = tb[59 - 8 * q4 - i]; b1[i] = tb[27 - 8 * q4 - i]; }
            asm volatile("" : "+v"(b0[0]), "+v"(b0[1]), "+v"(b0[2]), "+v"(b0[3]), "+v"(b1[0]), "+v"(b1[1]), "+v"(b1[2]), "+v"(b1[3]));
#pragma unroll
            for (int i = 0; i < 4; ++i) { const int r = 4 * q4 + i, kv = 8 * q4 + i;
                p0[r] = (kv <= lim2) ? p0[r] + b0[i] : -INFINITY; p1[r] = (kv + 32 <= lim2) ? p1[r] + b1[i] : -INFINITY; }
        }
    };
    const bf16* Kw = PROJ + rowbase * NPROJ + C_KWIN + g * 64; const bf16* Vw = PROJ + rowbase * NPROJ + C_VWIN + g * 64;
    const int jlo = qt >= 8 ? qt - 8 : 0; int wpar;
    {
        FlashState s; s.o[0] = splat(0.f); s.o[1] = splat(0.f); s.mhat = 0.f; s.l = 0.f; s.started = false;
        wpar = flash<false>(s, c, qr, Ks, Vs, (long)NPROJ, qt,
            [&](int j) { const unsigned below = j > 0 ? (um & ((1u << j) - 1u)) : 0u; return below ? 31 - __builtin_clz(below) : -1; },
            [&](int j) { return ((mymask >> j) & 1u) ? -s.mhat : -INFINITY; },
            [&](int j, f32x16& p0, f32x16& p1) { const int delta = qt - j; if (delta < 3) near_post(delta, p0, p1); },
            [&](int j) { return qt - j == 0 && false; },
            1, true, Kw, Vw, qt, qt > jlo ? qt - 1 : -1);
        const float lt = swapsum(s.l);
        accum_branch(ot, s.o, gate[(head * 64 + a) * 3 + 1] / lt, c);
    }
    {
        FlashState s; s.o[0] = splat(0.f); s.o[1] = splat(0.f); s.mhat = 0.f; s.l = 0.f; s.started = false;
        flash<false>(s, c, qr, Kw, Vw, (long)NPROJ, qt,
            [&](int j) { return j > jlo ? j - 1 : -1; },
            [&](int) { return -s.mhat; },
            [&](int j, f32x16& p0, f32x16& p1) {
                const int delta = qt - j;
                if (delta < 3) near_post(delta, p0, p1);
                else if (delta == 8) {
#pragma unroll
                    for (int r = 0; r < 16; ++r) { const int kb = crow(r, hi); if (!(kb > a)) p0[r] = -INFINITY; if (!(kb + 32 > a)) p1[r] = -INFINITY; } }
            },
            [&](int j) { return qt - j == 8 && awave == 32 && false; }, wpar, true);
        if (c.tid == 0) { unsigned z = 0u; asm volatile("" : "+v"(z)); pend = __hip_atomic_fetch_add(qhead + z, 1u, __ATOMIC_RELAXED, __HIP_MEMORY_SCOPE_AGENT); }
        const float lt = swapsum(s.l);
        accum_branch(ot, s.o, gate[(head * 64 + a) * 3 + 2] / lt, c);
    }
    store_o(ot, c, O + (rowbase + t0 + awave) * 2048 + (g * 4 + head) * 64, SSQ + (rowbase + t0 + awave) * 32 + g * 4 + head);
    asm volatile("s_waitcnt lgkmcnt(0)\n\ts_barrier" ::: "memory");
}
#undef SBAR
#undef WAIT_BAR0
}

constexpr int NWAVES = 8;
constexpr int RING_BYTES = 131072;
constexpr int LDSCTL_OFF = 8 * WSCR, MISC_OFF = LDSCTL_OFF + 320;
constexpr int LDS_BYTES = 163840;
static_assert(LDSCTL_OFF >= RING_BYTES && MISC_OFF + 128 <= LDS_BYTES, "LDS map");
constexpr int CW_BAR = 4096;
constexpr int N_BAR_REGIONS = 12;
constexpr int CW_KN2 = 1024;
constexpr int CW_Q8 = 49152, CW_Q9 = 53248;
constexpr int CW_TMO2 = 57344;
constexpr int CW_RDY = 65536;
constexpr int CW_CQ = 58368, CW_DONE1 = 59392, CW_DONE3 = 60416;
constexpr int CW_NCNT = 81920;
constexpr int I_DLATE = 5632;
constexpr int CW_QUEUE = 2048;
static_assert((CW_BAR + N_BAR_REGIONS * XCD_BAR_WORDS) * 4 <= (int)CTL_ZERO_BYTES, "barrier words inside the memset region");

struct Args { const float* in[23]; float* out; unsigned char* ws; int ph_lo, ph_hi, li, pad; };

template <class ColOf, class RowOf, class ScaleOf>
__device__ __forceinline__ void tr_item(const float* W, size_t pitch, int k0, int n0, LAS float* scr, int lane, bf16* WT, int Kdst, const float* ks, ColOf colof, RowOf rowof, ScaleOf scaleof) {
    const int nl = lane & 31; const int sc = colof(n0 + nl);
#pragma unroll 8
    for (int i = 0; i < 32; ++i) { const int kk = 2 * i + (lane >> 5); scr[kk * 33 + nl] = W[(size_t)(k0 + kk) * pitch + sc]; }
    LDS_WAIT(); asm volatile("" ::: "memory");
    const int c = lane & 7; float kf[8];
#pragma unroll
    for (int j = 0; j < 8; ++j) kf[j] = ks ? ks[k0 + 8 * c + j] : 1.f;
#pragma unroll
    for (int j = 0; j < 4; ++j) { const int n = (lane >> 3) + 8 * j; const LAS float* s = scr + (8 * c) * 33 + n; const float cs = scaleof(n0 + n);
        v4u o; o.x = pk2(s[0 * 33] * kf[0] * cs, s[1 * 33] * kf[1] * cs); o.y = pk2(s[2 * 33] * kf[2] * cs, s[3 * 33] * kf[3] * cs);
        o.z = pk2(s[4 * 33] * kf[4] * cs, s[5 * 33] * kf[5] * cs); o.w = pk2(s[6 * 33] * kf[6] * cs, s[7 * 33] * kf[7] * cs);
        *(GAS v4u*)(WT + (size_t)rowof(n0 + n) * Kdst + k0 + 8 * c) = o; }
    LDS_WAIT(); asm volatile("" ::: "memory");
}
template <class DstOf>
__device__ __forceinline__ void tr_item_chunks(const float* W, size_t pitch, int k0, int n0, LAS float* scr, int lane, bf16* WT, DstOf dstof) {
    const int nl = lane & 31;
#pragma unroll 8
    for (int i = 0; i < 32; ++i) { const int kk = 2 * i + (lane >> 5); scr[kk * 33 + nl] = W[(size_t)(k0 + kk) * pitch + n0 + nl]; }
    LDS_WAIT(); asm volatile("" ::: "memory");
    const int c = lane & 7;
#pragma unroll
    for (int j = 0; j < 4; ++j) { const int n = (lane >> 3) + 8 * j; const LAS float* s = scr + (8 * c) * 33 + n;
        v4u o; o.x = pk2(s[0 * 33], s[1 * 33]); o.y = pk2(s[2 * 33], s[3 * 33]); o.z = pk2(s[4 * 33], s[5 * 33]); o.w = pk2(s[6 * 33], s[7 * 33]);
        *(GAS v4u*)(WT + dstof(n0 + n, k0 + 8 * c)) = o; }
    LDS_WAIT(); asm volatile("" ::: "memory");
}
__device__ __forceinline__ void tr8_load(f32x4 (&v)[8], const float* W, size_t pitch, int k0, int n0, int lane) {
    const int r8 = lane >> 3, c4 = (lane & 7) * 4;
#pragma unroll
    for (int i = 0; i < 8; ++i) v[i] = *(const GAS f32x4*)(W + (size_t)(k0 + 8 * i + r8) * pitch + n0 + c4);
}
template <class RowOf>
__device__ __forceinline__ void tr8_finish(const f32x4 (&v)[8], int k0, int n0, LAS float* scr, int lane, unsigned char* WT, int Kdst, const float* ks, RowOf rowof) {
    { const int r8 = lane >> 3, c4 = (lane & 7) * 4;
#pragma unroll
        for (int i = 0; i < 8; ++i) { LAS float* d = scr + (8 * i + r8) * 33 + c4; d[0] = v[i][0]; d[1] = v[i][1]; d[2] = v[i][2]; d[3] = v[i][3]; } }
    LDS_WAIT(); asm volatile("" ::: "memory");
    const int c = lane & 3; float kf[16];
#pragma unroll
    for (int j = 0; j < 16; ++j) kf[j] = (ks ? ks[k0 + 16 * c + j] : 1.f) * 64.f;
#pragma unroll
    for (int j = 0; j < 2; ++j) { const int n = (lane >> 2) + 16 * j; const LAS float* s = scr + (16 * c) * 33 + n;
        v4u o;
#define W8(i) __builtin_amdgcn_fmed3f(s[(i) * 33] * kf[i], -448.f, 448.f)
        o.x = pg8::pk_fp8x4(W8(0), W8(1), W8(2), W8(3)); o.y = pg8::pk_fp8x4(W8(4), W8(5), W8(6), W8(7));
        o.z = pg8::pk_fp8x4(W8(8), W8(9), W8(10), W8(11)); o.w = pg8::pk_fp8x4(W8(12), W8(13), W8(14), W8(15));
#undef W8
        *(GAS v4u*)(WT + (size_t)rowof(n0 + n) * Kdst + k0 + 16 * c) = o; }
    LDS_WAIT(); asm volatile("" ::: "memory");
}
template <class RowOf>
__device__ __forceinline__ void tr_item8(const float* W, size_t pitch, int k0, int n0, LAS float* scr, int lane, unsigned char* WT, int Kdst, const float* ks, RowOf rowof) {
    f32x4 v[8]; tr8_load(v, W, pitch, k0, n0, lane); tr8_finish(v, k0, n0, scr, lane, WT, Kdst, ks, rowof);
}
__device__ __forceinline__ void rms_row_load(f32x4 (&v)[8], const float* xrow, int lane) {
    const GAS f32x4* xr = (const GAS f32x4*)xrow + lane;
#pragma unroll
    for (int j = 0; j < 8; ++j) v[j] = xr[64 * j];
}
__device__ __forceinline__ void rms_row_finish(const f32x4 (&v)[8], const float* w, bf16* orow, int lane) {
    const GAS f32x4* wr = (const GAS f32x4*)w + lane; float s = 0.f;
#pragma unroll
    for (int j = 0; j < 8; ++j) s += (v[j].x * v[j].x + v[j].y * v[j].y) + (v[j].z * v[j].z + v[j].w * v[j].w);
    const float r = 1.f / sqrtf(wave_sum(s) * (1.f / 2048.f) + NORM_EPS);
    GAS unsigned long long* o8 = (GAS unsigned long long*)orow + lane;
#pragma unroll
    for (int j = 0; j < 8; ++j) { const f32x4 ww = wr[64 * j]; o8[64 * j] = (unsigned long long)pk2(v[j].x * r * ww.x, v[j].y * r * ww.y) | ((unsigned long long)pk2(v[j].z * r * ww.z, v[j].w * r * ww.w) << 32); }
}

constexpr int N_PHASES = 11;
#ifndef MK_N_LAUNCHES
#define MK_N_LAUNCHES 1
#endif

#ifndef CODE_PF_BYTES
#define CODE_PF_BYTES 139264
#endif
__device__ __forceinline__ void code_prefetch(unsigned long long pc0, int lane, unsigned lds_dummy) {
#if defined(__HIP_DEVICE_COMPILE__)
    const char* p = (const char*)(pc0 & ~127ull) + lane * 128;
    unsigned keep;
#pragma unroll 1
    for (int off = 0; off < CODE_PF_BYTES; off += 8192)
        asm volatile("s_mov_b32 %0, m0\n\ts_mov_b32 m0, %2\n\ts_nop 0\n\tglobal_load_lds_dword %1, off\n\ts_mov_b32 m0, %0" : "=&s"(keep) : "v"(p + off), "s"(lds_dummy) : "memory");
#endif
}
__global__ void __launch_bounds__(NWAVES * 64, 2) mk(Args args) {
    unsigned long long pc0 = 0;
#if defined(__HIP_DEVICE_COMPILE__)
    asm volatile("s_getpc_b64 %0" : "=s"(pc0));
#endif
    extern __shared__ __attribute__((aligned(16))) unsigned char lds[];
    LAS unsigned char* L = (LAS unsigned char*)lds;
    volatile LAS unsigned* MISC = (volatile LAS unsigned*)(L + MISC_OFF);
    const int tid = threadIdx.x, lane = tid & 63, wave = __builtin_amdgcn_readfirstlane(tid >> 6);
    const int G = gridDim.x; const int bx = blockIdx.x; const int vcu = (G % 8 == 0) ? (bx % 8) * (G / 8) + bx / 8 : bx;
    const int gw = vcu * NWAVES + wave, NGW = G * NWAVES;
    unsigned char* ws = args.ws;
    gu32* ctl = (gu32*)(ws + WS_CTL);
    for (int u = tid; u < (LDS_BYTES - LDSCTL_OFF) / 4; u += NWAVES * 64) ((LAS unsigned*)(L + LDSCTL_OFF))[u] = 0u;
    __syncthreads();
    XcdBarrier bar = xcd_barrier_post((unsigned*)(ctl + CW_BAR) + args.li * XCD_BAR_WORDS, MISC + 8);
    const int lo = args.ph_lo, hi = args.ph_hi;
#ifdef ONLY_PHASE
#define IN(k) ((k) == ONLY_PHASE && lo <= (k) && (k) < hi)
#else
#define IN(k) (lo <= (k) && (k) < hi)
#endif
#ifndef CODE_PF_ON
#define CODE_PF() do { } while (0)
#else
#define CODE_PF() do { if (wave == NWAVES - 1) code_prefetch(pc0, lane, (unsigned)__builtin_amdgcn_readfirstlane((unsigned)(unsigned long long)(L + LDSCTL_OFF + 15360))); } while (0)
#endif
    CODE_PF();
#define SEAM(k) do { if (IN(k) && IN((k) + 1)) { xcd_barrier(bar); CODE_PF(); } } while (0)
    bf16* WinT = (bf16*)(ws + WS_WIN_T); bf16* WoutT = (bf16*)(ws + WS_WOUT_T); bf16* WguT = (bf16*)(ws + WS_WGU_T); bf16* WdT = (bf16*)(ws + WS_WD_T);
    bf16* XN = (bf16*)(ws + WS_XN); bf16* PROJ = (bf16*)(ws + WS_PROJ); float* GF = (float*)(ws + WS_GF); bf16* HB = (bf16*)(ws + WS_HB);
    bf16* O = (bf16*)(ws + WS_XN); bf16* MIXED = (bf16*)(ws + WS_PROJ); bf16* XS = (bf16*)(ws + WS_PROJ); bf16* YS = (bf16*)(ws + WS_PROJ); bf16* HID = (bf16*)(ws + WS_XN);
    unsigned char* Wgu8 = ws + WS_WGU_T; unsigned char* Wd8 = ws + WS_WD_T; unsigned char* HB8 = ws + WS_WGU_T + 64 * MiB; unsigned char* HID8 = ws + WS_XN;
    bf16* WrT = (bf16*)(ws + WS_WRT); bf16* W1T = (bf16*)(ws + WS_W1T); float* B1 = (float*)(ws + WS_B1);
    bf16* KC = (bf16*)(ws + WS_KC); bf16* VC = (bf16*)(ws + WS_VC); float* CUM = (float*)(ws + WS_CUM);
    float* SSQ = (float*)(ws + WS_SSQ); float* HSSQ = (float*)(ws + WS_HSSQ);
    int* EID = (int*)(ws + WS_ROUTE); float* WT = (float*)(ws + WS_ROUTE + 131072); float* RSTD = (float*)(ws + WS_ROUTE + 262144); int* LRANK = (int*)(ws + WS_ROUTE + 393216);
    int* CNTW = (int*)(ws + WS_SORT + 2 * MiB);
    int* NTp = (int*)(ws + WS_SORT + 512); int* TEXP = (int*)(ws + WS_SORT + 1024);
    int* RDST = (int*)(ws + WS_SORT + 65536); float* RWT = (float*)(ws + WS_SORT + 262144); float* RSTDS = (float*)(ws + WS_SORT + 458752);
    LAS float* wscr = (LAS float*)(L + wave * WSCR);

    if (IN(0)) {
        LAS float* scr = wscr;
        const float* w_in = args.in[2]; const float* w_out = args.in[13]; const float* wgate = args.in[19]; const float* wup = args.in[20]; const float* wdown = args.in[21];
        const float* nsa_w = args.in[11]; const float* fox_w = args.in[12]; const float* ffn_w = args.in[14];
        constexpr int I_IN = 32 * 178, I_OUT = 32 * 64, I_GU = 32 * 32 * 16, I_D = 32 * 8 * 64;
        constexpr int NITEMS = I_IN + I_OUT + 2 * I_GU + I_D;
        for (int it = gw; it < NITEMS; it += NGW) {
            int r = it;
            if (r < 2 * I_GU) { const int up = r >= I_GU; if (up) r -= I_GU; const int e = r / 512, q = r % 512, kb = q / 16, nb = q % 16;
                const float* src = (up ? wup : wgate) + (size_t)e * 2048 * 512; const int rb = e * 1024 + (up ? 128 : 0);
                tr_item8(src, 512, 64 * kb, 32 * nb, scr, lane, Wgu8, 2048, ffn_w, [rb](int j) { return rb + (j >> 7) * 256 + (j & 127); });
                continue; } r -= 2 * I_GU;
            if (r < I_D) { if (G == 256 && r < I_DLATE) continue;
                const int e = r / 512, q = r % 512, kb = q / 64, nb = q % 64; const float* src = wdown + (size_t)e * 512 * 2048; const int rb = e * 2048;
                tr_item8(src, 2048, 64 * kb, 32 * nb, scr, lane, Wd8, 512, nullptr, [rb](int j) { return rb + j; });
                continue; } r -= I_D;
            if (r < I_OUT) { const int kb = r / 64, nb = r % 64; const float* ks = (kb < 16) ? nsa_w : fox_w - 1024;
                tr_item(w_out, 2048, 64 * kb, 32 * nb, scr, lane, WoutT, 2048, ks, [](int j) { return j; }, [](int j) { return j; }, [](int) { return 1.f; });
                continue; } r -= I_OUT;
            { const int kb = r / 178, nb = r % 178;
                tr_item(w_in, 5696, 64 * kb, 32 * nb, scr, lane, WinT, 2048, nullptr,
                        [](int j) { return j < 2560 ? j : (j < 5632 ? j + 48 : (j < 5680 ? j - 5632 + 2560 : j)); }, [](int j) { return j; },
                        [](int j) { return (j < 1024 || (j >= 2560 && j < 3584)) ? C2 : 1.f; }); }
        }
        for (int i = gw * 64 + lane; i < 192 * 256; i += NGW * 64) ((GAS v4u*)(WinT + (size_t)5696 * 2048))[i] = (v4u){0u, 0u, 0u, 0u};
        for (int it = gw; it < 2 * 128; it += NGW) { const int kvv = it >> 7, q = it & 127, kb = q >> 2, nb = q & 3; const float* src = kvv ? args.in[7] : args.in[5];
            tr_item_chunks(src, 128, 64 * kb, 32 * nb, scr, lane, W1T, [kvv](int n, int k) { return (size_t)(kvv * 8 + (k >> 8)) * 32768 + ((k >> 4) & 15) * 2048 + (n >> 5) * 512 + ((k >> 3) & 1) * 256 + (n & 31) * 8; }); }
        for (int it = gw; it < 2 * 128; it += NGW) { const int kvv = it >> 7, j = it & 127; const float* w1 = kvv ? args.in[7] : args.in[5]; const float* pe = kvv ? args.in[4] : args.in[3];
            float s = 0.f; for (int i = lane; i < 2048; i += 64) s += pe[i] * w1[(size_t)i * 128 + j];
            s = wave_sum(s); if (lane == 0) B1[it] = s; }
        for (int i = gw * 64 + lane; i < 64 * 2048; i += NGW * 64) { const int o = i >> 11, k = i & 2047;
            const float v = (o < 4 ? args.in[15][(size_t)k * 4 + o] : (o < 36 ? args.in[17][(size_t)k * 32 + (o - 4)] : 0.f)) * ffn_w[k];
            const int f = (((k >> 8) * 16 + ((k >> 4) & 15)) * 2 + (o >> 5)) * 512 + ((k >> 3) & 1) * 256 + (o & 31) * 8 + (k & 7);
            const unsigned short h = (unsigned short)f2bf(v); WrT[f] = h; WrT[64 * 2048 + f] = (unsigned short)f2bf(v - bf2f(h)); }
        for (int m = gw; m < NTOK; m += NGW) { f32x4 v[8]; rms_row_load(v, args.in[0] + (size_t)m * DM, lane); rms_row_finish(v, args.in[1], XN + (size_t)m * DM, lane); }
    }
    SEAM(0);
    if (IN(1)) {
        pg8::Gemm g{XN, WinT, NTOK, NPROJ_PAD, DM, DM}; pg8::StaticOrder S; S.init(NTOK, NPROJ_PAD, G, bx);
        pg8::EpiProj E{PROJ, GF};
        pg8::gemm_phase<pg8::EpiProj, pg8::StaticOrder, true, true>(L, g, S, E);
        if (G == 256 && bx >= 192) { const float* wdown = args.in[21];
            for (int r = (bx - 192) * NWAVES + wave; r < I_DLATE; r += 64 * NWAVES) { const int e = r / 512, q = r % 512, kb = q / 64, nb = q % 64; const float* src = wdown + (size_t)e * 512 * 2048; const int rb = e * 2048;
                tr_item8(src, 2048, 64 * kb, 32 * nb, wscr, lane, Wd8, 512, nullptr, [rb](int j) { return rb + j; }); } }
    }
    SEAM(1);
    if (IN(2)) {
#ifndef P2SKIP
#define P2SKIP 0
#endif
        if (!((P2SKIP & 1) && args.li == 1)) if (bx < 128) cumsum_wg(bx, wave, lane, GF, args.in[10], CUM, (LAS float*)(L + LDSCTL_OFF + 4096));
        if (!((P2SKIP & 2) && args.li == 1)) knorm_item(bx * 8 + wave, lane, PROJ, (unsigned*)(ctl + CW_KN2));
        if (!((P2SKIP & 4) && args.li == 1)) {
#ifdef COMPRESS_NAIVE
        for (int it = gw; it < 8 * 128 * 4 * 2; it += NGW) compress_item(it, lane, wscr, PROJ, args.in[3], args.in[4], args.in[5], args.in[6], args.in[7], args.in[8], KC, VC);
#else
        if (bx < 254) compress_mfma(bx, tid, lane, wave, (LAS float*)L, (LAS float*)(L + RING_BYTES), PROJ, W1T, B1, args.in[6], args.in[8], KC, VC);
        else if (tid < 256) { bf16* z = (bx == 254 ? KC : VC) + ((size_t)((tid >> 5) * 128 + 127) * 4) * 64 + (tid & 31) * 8; *(v4u*)z = (v4u){0u, 0u, 0u, 0u}; }
#endif
        }
    }
    SEAM(2);
    if (IN(3)) {
#ifdef ATTN_NAIVE
        for (int it = gw; it < NTOK * 4; it += NGW) nsa_item(it, lane, wscr, PROJ, KC, VC, args.in[9], GF, O, SSQ);
        for (int it = gw; it < NTOK * 16; it += NGW) fox_item(it, lane, wscr, PROJ, CUM, O, SSQ);
#else
        LAS int* qslot = (LAS int*)(L + att::A_QSLOT);
        unsigned* qhead = (unsigned*)(ctl + CW_QUEUE + 64 * args.li);
        int u = bx; unsigned pend = 0u;
        for (;; ) {
            if (u >= 2048) break;
            const int k = 7 - (u >> 8), off = u & 255;
            int tid_ = tid; asm volatile("" : "+v"(tid_));
            const att::Ctx c{tid_, tid_ & 63, tid_ & 31, (tid_ >> 5) & 1, wave, (LAS char*)L, (unsigned)(unsigned long)L};
#ifndef PROBE_ATT
#define PROBE_ATT 0
#endif
            bool claimed = true;
#ifndef DBG_NO_FOX
            if (off < 128) { if (!(PROBE_ATT == 2 && args.li == 1)) att::fox_unit(c, off >> 4, off & 15, k, PROJ, CUM, (const unsigned*)(ctl + CW_KN2), O, SSQ, qhead, pend); else claimed = false; }
#else
            if (off < 128) { claimed = false; }
#endif
#ifndef DBG_NO_NSA
            else if (!(PROBE_ATT == 1 && args.li == 1)) { const int o2 = off - 128; att::nsa_unit(c, (o2 & 31) >> 2, o2 & 3, 4 * k + 3 - (o2 >> 5), PROJ, KC, VC, args.in[9], GF, O, SSQ, qhead, pend); }
            else claimed = false;
#else
            else claimed = false;
#endif
            if (!claimed && tid == 0) pend = __hip_atomic_fetch_add(qhead, 1u, __ATOMIC_RELAXED, __HIP_MEMORY_SCOPE_AGENT);
            if (tid == 0) *qslot = (int)(pend + (unsigned)G);
            __syncthreads();
            u = __builtin_amdgcn_readfirstlane(*qslot);
        }
#endif
    }
    SEAM(3);
#ifdef NORM_PASS
    if (IN(4)) { for (int m = gw; m < NTOK; m += NGW) normalize_item((size_t)m, lane, O, SSQ, MIXED); }
#endif
#ifdef NORM_PASS
    SEAM(4);
#endif
    if (IN(5)) {
        pg8::Gemm g{O, WoutT, NTOK, DM, DM / 2, DM}; pg8::StaticOrder2 S; S.S.init(NTOK, DM, G, bx); S.khalf = DM / 2;
        LAS float* RT = (LAS float*)(L + RING_BYTES);
        pg8::Unit u0, u1; const bool h0 = S.S.next(0, u0), h1 = S.S.next(1, u1);
        { const pg8::Unit& ut = (tid < 256) ? u0 : u1; const bool hv = (tid < 256) ? h0 : h1;
            if (hv) { const float* sp = SSQ + ((size_t)ut.pm * 256 + (tid & 255)) * 32; float sa = 0.f, sf = 0.f;
#pragma unroll
                for (int i = 0; i < 4; ++i) { const f32x4 a4 = *(const f32x4*)(sp + 4 * i), f4 = *(const f32x4*)(sp + 16 + 4 * i); sa += (a4[0] + a4[1]) + (a4[2] + a4[3]); sf += (f4[0] + f4[1]) + (f4[2] + f4[3]); }
                const float ra = 1.f / sqrtf(sa * (1.f / 1024.f) + NORM_EPS), rf = 1.f / sqrtf(sf * (1.f / 1024.f) + NORM_EPS);
                RT[tid * 2] = ra / rf; RT[tid * 2 + 1] = rf; } }
        __syncthreads();
        pg8::EpiOut E{args.in[0], HB, HSSQ, SSQ, HB8, RT, u0.pm, u0.pn};
        pg8::gemm_phase<pg8::EpiOut, pg8::StaticOrder2, true, true>(L, g, S, E);
    }
    SEAM(5);
    const int TPW = NTOK / G;
    LAS int* elist = (LAS int*)(L + LDSCTL_OFF + 4096);
    if (IN(6)) {
#ifdef P6REP
#pragma unroll 1
      for (int rep6 = 0; rep6 < (args.li == 1 ? 2 : 1); ++rep6) { const int bx6 = rep6 ? ((bx + 128) & 255) : bx;
#else
      { const int bx6 = bx;
#endif
#ifdef P6WARM
        if (args.li == 1) { for (int i = tid; i < 256 * 1024 / 16; i += 512) { v4u v = ((const v4u*)(HB + (size_t)bx6 * 64 * 2048))[i]; asm volatile("" :: "v"(v.x)); }
            for (int i = tid; i < 512 * 1024 / 16; i += 512) { v4u v = ((const v4u*)WrT)[i]; asm volatile("" :: "v"(v.x)); }
            __syncthreads(); }
#endif
        LAS float* part = (LAS float*)L;
        const float bias_r = tid < 4 ? args.in[16][tid] : (tid < 36 ? args.in[18][tid - 4] : 0.f);
        const f32x4 hs4 = *(const f32x4*)(HSSQ + (size_t)bx6 * TPW * 32 + tid * 4);
#ifndef P6SKIP
#define P6SKIP 0
#endif
        if (!((P6SKIP & 1) && args.li == 1)) router_mfma(bx6, tid, lane, wave, part, HB, WrT);
        __syncthreads();
        if (!((P6SKIP & 2) && args.li == 1)) {
        LAS float* lgt = (LAS float*)(L + RING_BYTES);
        LAS float* ssl = lgt + TPW * 36;
        LAS float* bsl = ssl + TPW; if (tid < 36) bsl[tid] = bias_r;
        { float ss = (hs4[0] + hs4[1]) + (hs4[2] + hs4[3]); ss += __shfl_xor(ss, 1); ss += __shfl_xor(ss, 2); ss += __shfl_xor(ss, 4); if ((tid & 7) == 0) ssl[tid >> 3] = ss; }
        for (int i = tid; i < TPW * 36; i += NWAVES * 64) { const int tk = i / 36, o = i % 36; float s = 0.f;
#pragma unroll
            for (int w = 0; w < 8; ++w) s += part[w * 4096 + tk * 64 + o];
            lgt[i] = s; }
        __syncthreads();
        if (tid < TPW) { const size_t tok = (size_t)bx6 * TPW + tid; const LAS float* lg = lgt + tid * 36;
            const float ss = ssl[tid];
            const float rstd = 1.f / sqrtf(ss * (1.f / 2048.f) + NORM_EPS);
            const LAS float* bg = bsl; const LAS float* be = bsl + 4;
            float gl[4]; int gsel = 0;
#pragma unroll
            for (int i = 0; i < 4; ++i) gl[i] = lg[i] * rstd + bg[i];
            float gm = gl[0];
#pragma unroll
            for (int i = 1; i < 4; ++i) if (gl[i] > gm) { gm = gl[i]; gsel = i; }
            float den = 0.f;
#pragma unroll
            for (int i = 0; i < 4; ++i) den += expf(gl[i] - gm);
            const float pgs = 1.f / den;
            int i1 = 0, i2 = 0; float v1 = -INFINITY, v2 = -INFINITY;
            for (int j = 0; j < 8; ++j) { const float v = lg[4 + gsel * 8 + j] * rstd + be[gsel * 8 + j];
                if (v > v1) { v2 = v1; i2 = i1; v1 = v; i1 = j; } else if (v > v2) { v2 = v; i2 = j; } }
            const float ex = expf(v2 - v1), d2 = 1.f / (1.f + ex);
            const int e0 = gsel * 8 + i1, e1 = gsel * 8 + i2;
            EID[tok * 2] = e0; EID[tok * 2 + 1] = e1; WT[tok * 2] = d2 * pgs; WT[tok * 2 + 1] = ex * d2 * pgs; RSTD[tok] = rstd; elist[tid * 2] = e0; elist[tid * 2 + 1] = e1; }
        __syncthreads();
        LAS int* cntl = elist + 2 * TPW; int e = 0, rk = 0;
        if (tid < 2 * TPW) { e = elist[tid]; int cnt = 0;
#ifdef P6ROLL
#pragma unroll 1
#endif
            for (int ee = 0; ee < 32; ++ee) { const unsigned long long m = __ballot(e == ee); if (e == ee) rk = __popcll(m & ((1ull << lane) - 1ull)); if (lane == ee) cnt = __popcll(m); }
            if (lane < 32) cntl[wave * 32 + lane] = cnt; }
        __syncthreads();
        if (tid < 2 * TPW) LRANK[(size_t)bx6 * 2 * TPW + tid] = rk + (wave ? cntl[e] : 0);
        if (tid < 32) CNTW[bx6 * 32 + tid] = cntl[tid] + cntl[32 + tid];
        __syncthreads();
        }
      }
    }
    SEAM(6);
    if (IN(7)) {
        LAS int* cw = (LAS int*)L;
        LAS int* tot = (LAS int*)(L + 65536); LAS int* mine = tot + 32; LAS int* base = tot + 64; LAS int* rowof = tot + 128;
        int e7 = 0, lr7 = 0; float wt7 = 0.f, rs7 = 0.f;
        { int cv[16];
#pragma unroll
            for (int k = 0; k < 16; ++k) cv[k] = CNTW[tid + 512 * k];
            if (tid < 2 * TPW) { const int entry = bx * 2 * TPW + tid; e7 = EID[entry]; lr7 = LRANK[entry]; wt7 = WT[entry]; rs7 = RSTD[entry >> 1]; }
#pragma unroll
            for (int k = 0; k < 16; ++k) cw[tid + 512 * k] = cv[k]; }
        __syncthreads();
        if (tid < 32) { int t = 0, m = 0; for (int w = 0; w < G; ++w) { const int c = cw[w * 32 + tid]; t += c; m += (w < bx) ? c : 0; } tot[tid] = t; mine[tid] = m; }
        __syncthreads();
        if (tid == 0) { int acc = 0; for (int e = 0; e < 32; ++e) { base[e] = acc; acc += (tot[e] + 255) & ~255; } base[32] = acc; }
        __syncthreads();
        if (bx == 0) { if (tid == 0) NTp[0] = base[32] >> 8; if (tid < 32) for (int tl = base[tid] >> 8; tl < (base[tid + 1] >> 8); ++tl) TEXP[tl] = tid; }
        if (tid < 2 * TPW) { const int entry = bx * 2 * TPW + tid; const int row = base[e7] + mine[e7] + lr7;
            RDST[row] = entry; RWT[row] = wt7; RSTDS[row] = rs7; }
        if (bx < 32) { const int e = bx; for (int row = base[e] + tot[e] + tid; row < base[e + 1]; row += NWAVES * 64) { RDST[row] = -1; RWT[row] = 0.f; RSTDS[row] = 0.f; } }
        __syncthreads();
    }
    SEAM(7);
    LAS int* qsl = (LAS int*)(L + LDSCTL_OFF + 8192);
    unsigned* RDY = (unsigned*)(ctl + CW_RDY); unsigned* TMO2 = (unsigned*)(ctl + CW_TMO2);
    if (IN(8)) {
        const int nt = ld_i32(NTp);
        pg8::Gemm g{(const bf16*)HB8, (const bf16*)Wgu8, MAXROWS, 1024, DM / 2, DM / 2}; pg8::QueueOrder S{nt, 4, TEXP, RDST, (unsigned*)(ctl + CW_Q8 + 64 * args.li), qsl, nullptr, 0u, RDY, TMO2};
        pg8::EpiGateUp E{HID8, RSTDS};
        pg8::gemm_phase_g<pg8::EpiGateUp, pg8::QueueOrder, true, true, true>(L, g, S, E);
    }
    if (IN(9)) {
        const int nt = ld_i32(NTp);
        pg8::Gemm g{(const bf16*)HID8, (const bf16*)Wd8, MAXROWS, 2048, EFF / 2, EFF / 2}; pg8::QueueOrder S{nt, 8, TEXP, RDST, (unsigned*)(ctl + CW_Q9 + 64 * args.li), qsl + 4, RDY, 32u, nullptr, TMO2};
        pg8::EpiDown E{(unsigned char*)YS, RDST, RWT};
        pg8::gemm_phase<pg8::EpiDown, pg8::QueueOrder, true, true, true>(L, g, S, E);
    }
    SEAM(9);
    if (IN(10)) { for (int m = gw; m < NTOK; m += NGW) final_item((size_t)m, lane, HB, (const unsigned char*)YS, args.in[22], args.out); }
#undef IN
#undef SEAM
}

extern "C" void kernel_launch(void* const* d_in, const int* in_sizes, int n_in, void* d_out, int out_size, void* d_ws, size_t ws_size, hipStream_t stream) {
    static int grid = 0;
    if (grid == 0) {
        if (n_in != 23 || in_sizes[0] != NTOK * DM || out_size != NTOK * DM || ws_size < WS_END) { fprintf(stderr, "kernel_launch: unexpected shapes (n_in %d, in0 %d, out %d, ws %zu < %zu)\n", n_in, n_in > 0 ? in_sizes[0] : -1, out_size, ws_size, (size_t)WS_END); grid = -1; return; }
        int dev = 0, cus = 0;
        if (hipGetDevice(&dev) != hipSuccess || hipDeviceGetAttribute(&cus, hipDeviceAttributeMultiprocessorCount, dev) != hipSuccess) { grid = -1; return; }
        if (hipFuncSetAttribute((const void*)mk, hipFuncAttributeMaxDynamicSharedMemorySize, LDS_BYTES) != hipSuccess) { fprintf(stderr, "kernel_launch: hipFuncSetAttribute failed\n"); grid = -1; return; }
        int per_cu = 0;
        if (hipOccupancyMaxActiveBlocksPerMultiprocessor(&per_cu, (const void*)mk, NWAVES * 64, LDS_BYTES) != hipSuccess || per_cu < 1) fprintf(stderr, "kernel_launch: occupancy query says %d\n", per_cu);
        (void)hipGetLastError();
        if (cus != 256) { fprintf(stderr, "kernel_launch: built for a 256-CU device, found %d CUs; nothing launched\n", cus); grid = -1; return; }
        grid = cus;
    }
    if (grid < 0) return;
    unsigned char* ws = (unsigned char*)d_ws;
    (void)hipMemsetAsync(ws + WS_CTL, 0, CTL_ZERO_BYTES, stream);
    Args a{};
    for (int i = 0; i < 23; ++i) a.in[i] = (const float*)d_in[i];
    a.out = (float*)d_out; a.ws = ws;
#ifdef PROBE_PREFIX
    a.ph_lo = 0; a.ph_hi = N_PHASES; a.li = 0; hipLaunchKernelGGL(mk, dim3(grid), dim3(NWAVES * 64), LDS_BYTES, stream, a);
    a.ph_lo = 0; a.ph_hi = PROBE_PREFIX; a.li = 1; hipLaunchKernelGGL(mk, dim3(grid), dim3(NWAVES * 64), LDS_BYTES, stream, a);
#elif defined(PROBE_PHASE)
#ifndef PROBE_END
#define PROBE_END (PROBE_PHASE + 1)
#endif
    { const int cuts[4] = {0, PROBE_END, PROBE_END, N_PHASES}; const int los[3] = {0, PROBE_PHASE, PROBE_END};
      for (int i = 0; i < 3; ++i) { a.ph_lo = los[i]; a.ph_hi = cuts[i + 1] == PROBE_END && i == 0 ? PROBE_END : (i == 1 ? PROBE_END : N_PHASES); a.li = i; if (a.ph_lo < a.ph_hi) hipLaunchKernelGGL(mk, dim3(grid), dim3(NWAVES * 64), LDS_BYTES, stream, a); } }
#else
    if (MK_N_LAUNCHES == 1) { a.ph_lo = 0; a.ph_hi = N_PHASES; a.li = 0; hipLaunchKernelGGL(mk, dim3(grid), dim3(NWAVES * 64), LDS_BYTES, stream, a); }
    else for (int p = 0; p < N_PHASES; ++p) { a.ph_lo = p; a.ph_hi = p + 1; a.li = p; hipLaunchKernelGGL(mk, dim3(grid), dim3(NWAVES * 64), LDS_BYTES, stream, a); }
#endif
}
```
